# Optimizing an MI355X kernel written in HIP

```python
import jax, jax.numpy as jnp
from jax import lax
import numpy as np

D_MODEL = 2048
BATCH = 4
SEQ = 2048
DEPTH = 2

EPS = 1e-6
D_MIX = D_MODEL
D_CONV = D_MIX // 4
CONV_WIDTH = 31
D_GLA = D_MIX // 2
GLA_HEADS = 4
GLA_DK = D_GLA // 2 // GLA_HEADS
GLA_DV = D_GLA // GLA_HEADS
GLA_KEY = GLA_HEADS * GLA_DK
GLA_RANK = 16
GLA_GATE_NORMALIZER = 16.0
GLA_CHUNK = 64
D_FOX = D_MIX - D_CONV - D_GLA
FOX_HEADS = 4
FOX_DH = D_FOX // FOX_HEADS
FOX_BLOCK = 128
IN_SPLITS = (D_CONV, D_CONV, GLA_KEY, GLA_KEY, D_GLA, D_GLA, GLA_RANK, D_FOX, D_FOX, D_FOX, FOX_HEADS)
D_IN = 2 * D_CONV + 2 * GLA_KEY + 2 * D_GLA + GLA_RANK + 3 * D_FOX + FOX_HEADS
N_GROUPS = 4
EXPERTS_PER_GROUP = 8
D_EXPERT = D_MODEL // 4
TOP_K_INNER = 2

kernel_name = 'hymba_style_conv_gla_fox_hmoe'


def rmsnorm(x, g):
    xf = x.astype(jnp.float32)
    y = xf * lax.rsqrt(jnp.mean(xf * xf, axis=-1, keepdims=True) + EPS)
    return (y * g.astype(jnp.float32)).astype(x.dtype)


def conv_mixer(a, gate, w, b, ln_g, ln_b):
    u = a * jax.nn.sigmoid(gate)
    y = lax.conv_general_dilated(u, w[:, None, :], window_strides=(1,), padding=[(CONV_WIDTH - 1, 0)],
                                 dimension_numbers=('NWC', 'WIO', 'NWC'), feature_group_count=D_CONV) + b
    yf = y.astype(jnp.float32)
    mu = jnp.mean(yf, axis=-1, keepdims=True)
    var = jnp.mean(jnp.square(yf - mu), axis=-1, keepdims=True)
    yn = (yf - mu) * lax.rsqrt(var + EPS) * ln_g.astype(jnp.float32) + ln_b.astype(jnp.float32)
    return jax.nn.silu(yn).astype(a.dtype)


def gla_mixer(q, k, v, g, a_low, w2, b2, norm_g):
    B, S, _ = q.shape
    N = S // GLA_CHUNK

    def heads(t, d):
        return t.astype(jnp.float32).reshape(B, N, GLA_CHUNK, GLA_HEADS, d).transpose(0, 3, 1, 2, 4)

    log_a = jax.nn.log_sigmoid((a_low @ w2 + b2).astype(jnp.float32)) / GLA_GATE_NORMALIZER
    qh = heads(q, GLA_DK) * (GLA_DK ** -0.5)
    kh = heads(k, GLA_DK)
    vh = heads(v, GLA_DV)
    cum = jnp.cumsum(heads(log_a, GLA_DK), axis=3)
    last = cum[:, :, :, -1:, :]
    q_dec = qh * jnp.exp(cum)
    k_inv = kh * jnp.exp(-cum)
    k_end = kh * jnp.exp(last - cum)
    causal = jnp.tril(jnp.ones((GLA_CHUNK, GLA_CHUNK), dtype=bool))
    att = jnp.where(causal, jnp.einsum('bhncd,bhnsd->bhncs', q_dec, k_inv), 0.0)
    o_intra = jnp.einsum('bhncs,bhnse->bhnce', att, vh)
    kv = jnp.einsum('bhncd,bhnce->bhnde', k_end, vh)
    decay = jnp.exp(last[:, :, :, 0, :])

    def step(state, inp):
        dec, kv_n = inp
        return dec[..., None] * state + kv_n, state

    init = jnp.zeros((B, GLA_HEADS, GLA_DK, GLA_DV), jnp.float32)
    _, s_prev = lax.scan(step, init, (jnp.moveaxis(decay, 2, 0), jnp.moveaxis(kv, 2, 0)))
    o = o_intra + jnp.einsum('bhncd,nbhde->bhnce', q_dec, s_prev)
    o = o * lax.rsqrt(jnp.mean(o * o, axis=-1, keepdims=True) + EPS) * norm_g.astype(jnp.float32)
    o = o.transpose(0, 2, 3, 1, 4).reshape(B, S, D_GLA)
    return (o * jax.nn.silu(g.astype(jnp.float32))).astype(q.dtype)


def fox_mixer(q, k, v, f_logit, f_b):
    B, S, _ = q.shape

    def heads(t):
        return t.astype(jnp.float32).reshape(B, S, FOX_HEADS, FOX_DH).transpose(0, 2, 1, 3)

    qh = heads(q) * (FOX_DH ** -0.5)
    kh = heads(k)
    vh = heads(v)
    log_f = jax.nn.log_sigmoid(f_logit.astype(jnp.float32) + f_b.astype(jnp.float32))
    F = jnp.cumsum(log_f, axis=1).transpose(0, 2, 1)
    within = jnp.tril(jnp.ones((FOX_BLOCK, FOX_BLOCK), dtype=bool))
    outs = []
    for i in range(S // FOX_BLOCK):
        lo, hi = i * FOX_BLOCK, (i + 1) * FOX_BLOCK
        s = jnp.einsum('bhqd,bhkd->bhqk', qh[:, :, lo:hi], kh[:, :, :hi])
        s = s + F[:, :, lo:hi, None] - F[:, :, None, :hi]
        mask = jnp.concatenate([jnp.ones((FOX_BLOCK, lo), dtype=bool), within], axis=1)
        p = jax.nn.softmax(jnp.where(mask, s, -jnp.inf), axis=-1)
        outs.append(jnp.einsum('bhqk,bhkd->bhqd', p, vh[:, :, :hi]))
    o = jnp.concatenate(outs, axis=2)
    return o.transpose(0, 2, 1, 3).reshape(B, S, D_FOX).astype(q.dtype)


def hier_moe(x, wg, bg, we, be, w_gate, w_up, w_down):
    B, S, D = x.shape
    t = x.reshape(B * S, D)
    g_logits = (t @ wg + bg).astype(jnp.float32)
    g_prob = jax.nn.softmax(g_logits, axis=-1)
    g_top_v, g_top_i = lax.top_k(g_prob, 1)
    grp = g_top_i[:, 0]
    e_logits = (jnp.einsum('td,gde->tge', t, we) + be).astype(jnp.float32)
    e_sel = jnp.take_along_axis(e_logits, grp[:, None, None], axis=1)[:, 0]
    top_v, top_i = lax.top_k(e_sel, TOP_K_INNER)
    gate = g_top_v * jax.nn.softmax(top_v, axis=-1)
    e_w = jnp.sum(jax.nn.one_hot(top_i, EXPERTS_PER_GROUP, dtype=jnp.float32) * gate[:, :, None], axis=1)
    combine = (jax.nn.one_hot(grp, N_GROUPS, dtype=jnp.float32)[:, :, None] * e_w[:, None, :]).astype(t.dtype)
    y = jnp.zeros_like(t)
    for gi in range(N_GROUPS):
        h = jax.nn.silu(jnp.einsum('td,edf->tef', t, w_gate[gi])) * jnp.einsum('td,edf->tef', t, w_up[gi])
        y = y + jnp.einsum('tef,efd->td', h * combine[:, gi, :, None], w_down[gi])
    return y.reshape(B, S, D)


def setup_inputs(seed: int = 0) -> dict:
    key = jax.random.key(seed)
    ks = jax.random.split(key, 24)
    f32 = jnp.float32
    nrm = lambda k, shape, s: jax.random.normal(k, shape, f32) * s
    L = DEPTH
    return {
        'x': nrm(ks[0], (BATCH, SEQ, D_MODEL), 1.0),
        'norm1_g': 1.0 + nrm(ks[1], (L, D_MODEL), 0.02),
        'w_in': nrm(ks[2], (L, D_MODEL, D_IN), D_MODEL ** -0.5),
        'conv_w': nrm(ks[3], (L, CONV_WIDTH, D_CONV), CONV_WIDTH ** -0.5),
        'conv_b': nrm(ks[4], (L, D_CONV), 0.01),
        'conv_ln_g': 1.0 + nrm(ks[5], (L, D_CONV), 0.02),
        'conv_ln_b': nrm(ks[6], (L, D_CONV), 0.01),
        'gla_w2': nrm(ks[7], (L, GLA_RANK, GLA_KEY), GLA_RANK ** -0.5),
        'gla_b2': nrm(ks[8], (L, GLA_KEY), 0.01),
        'gla_norm_g': 1.0 + nrm(ks[9], (L, GLA_DV), 0.02),
        'fox_f_b': 2.0 + nrm(ks[10], (L, FOX_HEADS), 0.5),
        'w_out': nrm(ks[11], (L, D_MIX, D_MODEL), D_MIX ** -0.5),
        'norm2_g': 1.0 + nrm(ks[12], (L, D_MODEL), 0.02),
        'router_group_w': nrm(ks[13], (L, D_MODEL, N_GROUPS), D_MODEL ** -0.5),
        'router_group_b': nrm(ks[14], (L, N_GROUPS), 0.01),
        'router_expert_w': nrm(ks[15], (L, N_GROUPS, D_MODEL, EXPERTS_PER_GROUP), D_MODEL ** -0.5),
        'router_expert_b': nrm(ks[16], (L, N_GROUPS, EXPERTS_PER_GROUP), 0.01),
        'ffn_w_gate': nrm(ks[17], (L, N_GROUPS, EXPERTS_PER_GROUP, D_MODEL, D_EXPERT), D_MODEL ** -0.5),
        'ffn_w_up': nrm(ks[18], (L, N_GROUPS, EXPERTS_PER_GROUP, D_MODEL, D_EXPERT), D_MODEL ** -0.5),
        'ffn_w_down': nrm(ks[19], (L, N_GROUPS, EXPERTS_PER_GROUP, D_EXPERT, D_MODEL), D_EXPERT ** -0.5),
        'final_norm_g': 1.0 + nrm(ks[20], (D_MODEL,), 0.02),
    }


def reference(x, norm1_g, w_in, conv_w, conv_b, conv_ln_g, conv_ln_b, gla_w2, gla_b2, gla_norm_g, fox_f_b,
              w_out, norm2_g, router_group_w, router_group_b, router_expert_w, router_expert_b,
              ffn_w_gate, ffn_w_up, ffn_w_down, final_norm_g):
    split_points = [int(s) for s in np.cumsum(IN_SPLITS)[:-1]]
    for l in range(DEPTH):
        h = rmsnorm(x, norm1_g[l])
        (c_a, c_g, g_q, g_k, g_v, g_g, g_low, f_q, f_k, f_v, f_f) = jnp.split(h @ w_in[l], split_points, axis=-1)
        y_conv = conv_mixer(c_a, c_g, conv_w[l], conv_b[l], conv_ln_g[l], conv_ln_b[l])
        y_gla = gla_mixer(g_q, g_k, g_v, g_g, g_low, gla_w2[l], gla_b2[l], gla_norm_g[l])
        y_fox = fox_mixer(f_q, f_k, f_v, f_f, fox_f_b[l])
        mix = jnp.concatenate([y_conv, y_gla, y_fox], axis=-1)
        x = x + mix @ w_out[l]
        x = x + hier_moe(rmsnorm(x, norm2_g[l]), router_group_w[l], router_group_b[l], router_expert_w[l],
                         router_expert_b[l], ffn_w_gate[l], ffn_w_up[l], ffn_w_down[l])
    return rmsnorm(x, final_norm_g)
```

```cpp
#include <hip/hip_runtime.h>
#include <cstdio>
#include <cstdint>

#ifndef MK_PER_PHASE
#define MK_PER_PHASE 0
#endif

#define LAS __attribute__((address_space(3)))
#define GAS __attribute__((address_space(1)))
typedef unsigned short bf16_t;
typedef short bf16x8 __attribute__((ext_vector_type(8)));
typedef short s16x4 __attribute__((ext_vector_type(4)));
typedef short v4i16_t __attribute__((ext_vector_type(4)));
typedef float f32x4 __attribute__((ext_vector_type(4)));
typedef float f32x2 __attribute__((ext_vector_type(2)));
typedef unsigned u32x4 __attribute__((ext_vector_type(4)));
typedef unsigned u32x2 __attribute__((ext_vector_type(2)));

constexpr int NB = 4, SEQ = 2048, T = NB * SEQ, DM = 2048, DEPTH = 2;
constexpr int DIN = 5652, DINP = 5888;
constexpr int C_CA = 0, C_CG = 512, C_GQ = 1024, C_GK = 1536, C_GV = 2048, C_GG = 3072, C_GLOW = 4096, C_FQ = 4112, C_FK = 4624, C_FV = 5136, C_FF = 5648;
constexpr int M_CONV = 0, M_GLA = 512, M_FOX = 1536;
constexpr int NEX = 32, DE = 512, CAPE = 8192, HROWS = 16384 + 32 * 256;
constexpr float EPS = 1e-6f;
constexpr float LOG2E = 1.4426950408889634f;

constexpr size_t MiB = 1u << 20;
constexpr size_t WS_CTL = 0, CTL_ZERO_BYTES = 64 * 1024;
constexpr size_t WS_WIN = 1 * MiB;
constexpr size_t WS_WOUT = 48 * MiB;
constexpr size_t WS_WGU = 64 * MiB;
constexpr size_t WS_WD = 320 * MiB;
constexpr size_t WS_WR = 448 * MiB;
constexpr size_t WS_XA = 449 * MiB;
constexpr size_t WS_XB = 513 * MiB;
constexpr size_t WS_H = 577 * MiB;
constexpr size_t WS_P = 609 * MiB;
constexpr size_t WS_MIX = 701 * MiB;
constexpr size_t WS_KV = 733 * MiB;
constexpr size_t WS_DEC = 765 * MiB;
constexpr size_t WS_CUM = 64 * MiB;
constexpr size_t WS_LIST = 766 * MiB;
constexpr size_t WS_GW = 767 * MiB;
constexpr size_t WS_HB = 768 * MiB;
constexpr size_t WS_Y = 792 * MiB;
constexpr size_t WS_END = 920 * MiB;
constexpr int CW_BAR = 0;
constexpr int CW_CNT = 4096;

constexpr int LDS_BYTES = 163840, MISC_OFF = LDS_BYTES - 1024;
constexpr int NWAVES = 8, NTHR = 512;

typedef __bf16 bf2_t __attribute__((ext_vector_type(2)));
__device__ __forceinline__ unsigned cvt_pk_bf16(float lo, float hi) { const f32x2 v = {lo, hi}; return __builtin_bit_cast(unsigned, __builtin_convertvector(v, bf2_t)); }
__device__ __forceinline__ bf16_t f2bf(float f) { return __builtin_bit_cast(bf16_t, (__bf16)f); }
__device__ __forceinline__ float bf2f(bf16_t b) { return __uint_as_float(((unsigned)b) << 16); }
__device__ __forceinline__ float bflo(unsigned w) { return __uint_as_float(w << 16); }
__device__ __forceinline__ float bfhi(unsigned w) { return __uint_as_float(w & 0xffff0000u); }
__device__ __forceinline__ float wave_sum(float v) {
#pragma unroll
    for (int o = 1; o < 64; o <<= 1) v += __shfl_xor(v, o);
    return v;
}
__device__ __forceinline__ float log_sigmoid(float x) { return fminf(x, 0.f) - __logf(1.f + __expf(-fabsf(x))); }
__device__ __forceinline__ float silu(float x) { return x * __builtin_amdgcn_rcpf(1.f + __expf(-x)); }
__device__ __forceinline__ s16x4 vtr(const LAS void* p) { return __builtin_bit_cast(s16x4, __builtin_amdgcn_ds_read_tr16_b64_v4i16((LAS v4i16_t*)p)); }
__device__ __forceinline__ bf16x8 cat8(s16x4 a, s16x4 b) { bf16x8 r; r[0] = a[0]; r[1] = a[1]; r[2] = a[2]; r[3] = a[3]; r[4] = b[0]; r[5] = b[1]; r[6] = b[2]; r[7] = b[3]; return r; }
__device__ __forceinline__ f32x4 mfma16(bf16x8 a, bf16x8 b, f32x4 c) { return __builtin_amdgcn_mfma_f32_16x16x32_bf16(a, b, c, 0, 0, 0); }
__device__ __forceinline__ int opaque_tid() { int t = threadIdx.x; asm volatile("" : "+v"(t)); return t; }
#define LDS_WAIT() asm volatile("s_waitcnt lgkmcnt(0)" ::: "memory")
#define VM_WAIT() asm volatile("s_waitcnt vmcnt(0)" ::: "memory")

#define XB_TMO      128
#define XB_XCNT(j)  (256  + 64 * (j))
#define XB_XSUB(j)  (1280 + 64 * (j))
#define XB_XGEN(j)  (2304 + 64 * (j))
#define XB_TOP      3328
#define XB_TOPGEN   3392
#define XCD_BAR_WORDS 3456
#define XB_SPIN_CAP (1u << 18)
__device__ __forceinline__ unsigned xb_ld(unsigned* p)              { return __hip_atomic_load(p, __ATOMIC_RELAXED, __HIP_MEMORY_SCOPE_AGENT); }
__device__ __forceinline__ unsigned xb_add(unsigned* p, unsigned v) { return __hip_atomic_fetch_add(p, v, __ATOMIC_RELAXED, __HIP_MEMORY_SCOPE_AGENT); }
__device__ __forceinline__ unsigned xb_xcc_id() { return (unsigned)__builtin_amdgcn_s_getreg((3 << 11) | 20) & 0xFu; }
#define XB_SPIN(cond, bar) do { unsigned _sp = 0; while (cond) { __builtin_amdgcn_s_sleep(1); \
    if ((++_sp & 255u) == 0u) { if (xb_ld(&(bar)[XB_TMO])) break; if (_sp > XB_SPIN_CAP) { atomicAdd(&(bar)[XB_TMO], 1u); break; } } } } while (0)
struct XcdBarrier { unsigned* bar; unsigned x; volatile LAS unsigned* st; };
__device__ __forceinline__ XcdBarrier xcd_barrier_post(unsigned* bar, volatile LAS unsigned* st) {
    XcdBarrier b; b.bar = bar; b.x = xb_xcc_id(); b.st = st;
    if (threadIdx.x == 0) (void)xb_add(&bar[XB_XCNT(b.x)], 1u);
    return b;
}
__device__ __forceinline__ void xcd_barrier_complete(unsigned* bar, unsigned x, unsigned& nloc, unsigned& nx) {
    const unsigned G = gridDim.x * gridDim.y * gridDim.z;
    unsigned sum, cnt, mine, sp = 0u;
    for (;;) {
        sum = 0u; cnt = 0u; mine = 0u;
#pragma unroll
        for (unsigned j = 0; j < 16; ++j) { const unsigned c = xb_ld(&bar[XB_XCNT(j)]); sum += c; cnt += (c > 0u) ? 1u : 0u; mine = (j == x) ? c : mine; }
        if (sum == G) break;
        __builtin_amdgcn_s_sleep(1);
        if ((++sp & 255u) == 0u) { if (xb_ld(&bar[XB_TMO])) break; if (sp > XB_SPIN_CAP) { atomicAdd(&bar[XB_TMO], 1u); break; } }
    }
    nloc = mine > 0u ? mine : 1u; nx = cnt > 0u ? cnt : 1u;
}
__device__ __forceinline__ void xcd_barrier(const XcdBarrier& b) {
    asm volatile("s_waitcnt vmcnt(0)" ::: "memory");
    __syncthreads();
    if (threadIdx.x == 0) {
        unsigned* bar = b.bar;
        __builtin_amdgcn_s_waitcnt(0);
        unsigned nloc = b.st[0], nx = b.st[1];
        if (nloc == 0u) { xcd_barrier_complete(bar, b.x, nloc, nx); b.st[0] = nloc; b.st[1] = nx; }
        const unsigned old = xb_add(&bar[XB_XSUB(b.x)], 1u);
        const unsigned gen = old / nloc;
        if (old + 1u == (gen + 1u) * nloc) {
            __builtin_amdgcn_fence(__ATOMIC_RELEASE, "agent");
            asm volatile("s_waitcnt vmcnt(0)" ::: "memory");
            const unsigned og = xb_add(&bar[XB_TOP], 1u);
            const unsigned tg = og / nx;
            if (og + 1u == (tg + 1u) * nx) xb_add(&bar[XB_TOPGEN], 1u);
            else XB_SPIN(xb_ld(&bar[XB_TOPGEN]) == tg, bar);
            __builtin_amdgcn_fence(__ATOMIC_ACQUIRE, "agent");
            xb_add(&bar[XB_XGEN(b.x)], 1u);
            asm volatile("s_waitcnt vmcnt(0)" ::: "memory");
        } else {
            XB_SPIN(xb_ld(&bar[XB_XGEN(b.x)]) == gen, bar);
            __builtin_amdgcn_fence(__ATOMIC_ACQUIRE, "agent");
            asm volatile("s_waitcnt vmcnt(0)" ::: "memory");
        }
    }
    __syncthreads();
}

namespace pg {
constexpr int BM = 256, BK = 64, HALF = 128, HTB = HALF * BK * 2, STAGE_BYTES = 8 * HTB;
__host__ __device__ __forceinline__ int lds_byte(int r, int c) { const int st = (r >> 4) * 2 + (c >> 5), rr = r & 15, cc = c & 31, ob = rr * 64 + cc * 2; return st * 1024 + (ob ^ (((ob >> 9) & 1) << 5)); }
__host__ __device__ __forceinline__ void stage_rc(int b, int& R, int& C) { const int st = b / 1024, sb = b % 1024, swz = sb ^ (((sb >> 9) & 1) << 5); R = (st >> 1) * 16 + swz / 64; C = (st & 1) * 32 + (swz % 64) / 2; }
__host__ __device__ __forceinline__ int perm32(int rho) { const int n = rho >> 4, i = rho & 15; return 8 * (i >> 2) + 4 * n + (i & 3); }

template <int K, class Epi, class Sched>
__device__ __forceinline__ void gemm_phase(LAS unsigned char* lds, const char* Abase, const Sched& S, const Epi& E) {
    typedef typename Sched::Unit Unit;
    const int tid = opaque_tid(), wid = __builtin_amdgcn_readfirstlane(tid >> 6), lane = tid & 63, wr = wid >> 2, wc = wid & 3, fr = lane & 15, fq = lane >> 4;
    constexpr int nt = K / BK;
    unsigned voffB[2]; int Rr[2], Cb;
#pragma unroll
    for (int i = 0; i < 2; ++i) { int R, C; stage_rc(tid * 16 + i * 8192, R, C); const int Rb = Epi::PERM ? ((R & ~31) + perm32(R & 31)) : R;
        Rr[i] = R; Cb = C * 2; voffB[i] = (unsigned)(Rb * K + C) * 2u; }
    constexpr size_t kstep = (size_t)(BK * 2);
    constexpr size_t hstep = (size_t)HALF * K * 2;
    const unsigned ldsw = (unsigned)wid * 1024u;
    const int aoff = lds_byte(wr * 64 + fr, fq * 8), boff = lds_byte(wc * 32 + fr, fq * 8);
#define PG_SA(b, h) (((b) * 2 + (h)) * HTB)
#define PG_SB(b, h) ((4 + (b) * 2 + (h)) * HTB)
#define PG_STAGE(bufoff, gbase, voff) do { _Pragma("unroll") for (int _i = 0; _i < 2; ++_i) \
        __builtin_amdgcn_global_load_lds((const unsigned*)((const char*)(gbase) + (voff)[_i]), (LAS unsigned*)(lds + (bufoff) + ldsw + _i * 8192), 16, 0, 0); } while (0)
#define PG_LDA(dst, b, h) do { _Pragma("unroll") for (int m = 0; m < 4; ++m) _Pragma("unroll") for (int k = 0; k < 2; ++k) dst[m][k] = *(const LAS bf16x8*)(lds + PG_SA(b, h) + aoff + m * 2048 + k * 1024); } while (0)
#define PG_LDB(dst, b, h) do { _Pragma("unroll") for (int n = 0; n < 2; ++n) _Pragma("unroll") for (int k = 0; k < 2; ++k) dst[n][k] = *(const LAS bf16x8*)(lds + PG_SB(b, h) + boff + n * 2048 + k * 1024); } while (0)
#define PG_MMA(ai, bj, At, Bt) do { __builtin_amdgcn_s_setprio(1); _Pragma("unroll") for (int m = 0; m < 4; ++m) _Pragma("unroll") for (int n = 0; n < 2; ++n) _Pragma("unroll") for (int k = 0; k < 2; ++k) \
        acc[ai][bj][m][n] = __builtin_amdgcn_mfma_f32_16x16x32_bf16(Bt[n][k], At[m][k], acc[ai][bj][m][n], 0, 0, 0); __builtin_amdgcn_s_setprio(0); } while (0)
#define PG_WAIT_V(n) asm volatile("s_waitcnt vmcnt(" #n ")" ::: "memory")
#define PG_WAIT_L(n) asm volatile("s_waitcnt lgkmcnt(" #n ")" ::: "memory")
#define PG_BAR __builtin_amdgcn_s_barrier()
#define PG_SCHED __builtin_amdgcn_sched_barrier(0)
    Unit cur, nxt; int ui = 0;
    if (!S.next(0, cur)) return;
    f32x4 acc[2][2][4][2];
#pragma unroll
    for (int a = 0; a < 2; ++a)
#pragma unroll
        for (int b = 0; b < 2; ++b)
#pragma unroll
            for (int m = 0; m < 4; ++m)
#pragma unroll
                for (int n = 0; n < 2; ++n) acc[a][b][m][n] = (f32x4){0.f, 0.f, 0.f, 0.f};
    bf16x8 At[4][2], B0[2][2], B1[2][2];
    unsigned cOff[2][2], nOff[2][2];
    S.aoff(cur, Rr[0], Rr[1], Cb, cOff);
    const char* cB = S.bptr(cur);
    PG_STAGE(PG_SB(0, 0), cB, voffB); PG_STAGE(PG_SB(0, 1), cB + hstep, voffB); PG_STAGE(PG_SA(0, 0), Abase, cOff[0]); PG_STAGE(PG_SA(0, 1), Abase, cOff[1]);
    if (wr == 1) PG_BAR;
    PG_WAIT_V(2); PG_BAR;
    PG_STAGE(PG_SB(1, 0), cB + kstep, voffB); PG_STAGE(PG_SA(1, 0), Abase + kstep, cOff[0]); PG_STAGE(PG_SB(1, 1), cB + hstep + kstep, voffB);
    PG_WAIT_V(6); PG_BAR;
    for (;;) {
        const bool has_next = S.next(ui + 1, nxt);
        const char* nB = cB;
        if (has_next) { S.aoff(nxt, Rr[0], Rr[1], Cb, nOff); nB = S.bptr(nxt); }
        else { nOff[0][0] = cOff[0][0]; nOff[0][1] = cOff[0][1]; nOff[1][0] = cOff[1][0]; nOff[1][1] = cOff[1][1]; }
        for (int t = 0; t < nt; t += 2) {
            const bool last = (t == nt - 2);
            const char* a1 = Abase + (size_t)(t + 1) * kstep;
            const char* a2 = last ? Abase : Abase + (size_t)(t + 2) * kstep; const char* b2 = last ? nB : cB + (size_t)(t + 2) * kstep;
            const char* a3 = a2 + kstep; const char* b3 = b2 + kstep;
            unsigned o2[2][2];
            o2[0][0] = last ? nOff[0][0] : cOff[0][0]; o2[0][1] = last ? nOff[0][1] : cOff[0][1]; o2[1][0] = last ? nOff[1][0] : cOff[1][0]; o2[1][1] = last ? nOff[1][1] : cOff[1][1];
            PG_LDB(B0, 0, 0); PG_LDB(B1, 0, 1); PG_SCHED; PG_LDA(At, 0, 0); PG_STAGE(PG_SA(1, 1), a1, cOff[1]);
            PG_WAIT_V(8); PG_WAIT_L(0); PG_BAR; PG_MMA(0, 0, At, B0); PG_MMA(0, 1, At, B1); PG_BAR; PG_SCHED;
            PG_LDA(At, 0, 1); PG_STAGE(PG_SB(0, 0), b2, voffB); PG_STAGE(PG_SB(0, 1), b2 + hstep, voffB); PG_STAGE(PG_SA(0, 0), a2, o2[0]);
            PG_WAIT_V(8); PG_WAIT_L(0); PG_BAR; PG_MMA(1, 0, At, B0); PG_MMA(1, 1, At, B1); PG_BAR; PG_SCHED;
            PG_LDB(B0, 1, 0); PG_LDB(B1, 1, 1); PG_SCHED; PG_LDA(At, 1, 0); PG_STAGE(PG_SA(0, 1), a2, o2[1]);
            PG_WAIT_V(8); PG_WAIT_L(0); PG_BAR; PG_MMA(0, 0, At, B0); PG_MMA(0, 1, At, B1); PG_BAR; PG_SCHED;
            PG_LDA(At, 1, 1); PG_STAGE(PG_SB(1, 0), b3, voffB); PG_STAGE(PG_SB(1, 1), b3 + hstep, voffB); PG_STAGE(PG_SA(1, 0), a3, o2[0]);
            PG_WAIT_V(8); PG_WAIT_L(0); PG_BAR; PG_MMA(1, 0, At, B0); PG_MMA(1, 1, At, B1); PG_BAR; PG_SCHED;
        }
        if (wr == 0) PG_BAR;
        E(acc, cur, wr, wc, fr, fq);
        if (!has_next) break;
#pragma unroll
        for (int a = 0; a < 2; ++a)
#pragma unroll
            for (int b = 0; b < 2; ++b)
#pragma unroll
                for (int m = 0; m < 4; ++m)
#pragma unroll
                    for (int n = 0; n < 2; ++n) acc[a][b][m][n] = (f32x4){0.f, 0.f, 0.f, 0.f};
        cur = nxt; cB = nB; ++ui;
        cOff[0][0] = nOff[0][0]; cOff[0][1] = nOff[0][1]; cOff[1][0] = nOff[1][0]; cOff[1][1] = nOff[1][1];
        if (wr == 1) PG_BAR;
    }
    PG_WAIT_V(0);
    PG_BAR;
#undef PG_SA
#undef PG_SB
#undef PG_STAGE
#undef PG_LDA
#undef PG_LDB
#undef PG_MMA
#undef PG_WAIT_V
#undef PG_WAIT_L
#undef PG_BAR
#undef PG_SCHED
}

struct DUnit { int pm, pn; };
template <int K> struct DenseSched {
    typedef DUnit Unit;
    const char* Bt; int nM, nN, nwg, G, c;
    __device__ __forceinline__ void init(const void* Bt_, int M, int N, int G_, int c_) { Bt = (const char*)Bt_; nM = M / BM; nN = N / BM; nwg = nM * nN; G = G_; c = c_; }
    __device__ __forceinline__ bool next(int i, Unit& u) const {
        const long L = (long)i * G + c; if (L >= nwg) return false;
        int wgid = (int)L; { const int q = nwg / 8, r = nwg % 8, xcd = wgid % 8, off = wgid / 8; wgid = (xcd < r ? xcd * (q + 1) : r * (q + 1) + (xcd - r) * q) + off; }
        const int nig = 8 * nN, gid = wgid / nig, fm = gid * 8, gsz = (nM - fm) < 8 ? (nM - fm) : 8;
        u.pm = fm + ((wgid % nig) % gsz); u.pn = (wgid % nig) / gsz; return true;
    }
    __device__ __forceinline__ const char* bptr(const Unit& u) const { return Bt + (size_t)u.pn * BM * K * 2; }
    __device__ __forceinline__ void aoff(const Unit& u, int R0, int R1, int Cb, unsigned (&o)[2][2]) const {
#pragma unroll
        for (int h = 0; h < 2; ++h) { o[h][0] = (unsigned)((u.pm * BM + h * HALF + R0) * K) * 2u + Cb; o[h][1] = (unsigned)((u.pm * BM + h * HALF + R1) * K) * 2u + Cb; }
    }
};
struct MUnit { int E, mt, pn, cnt, rowbase; };
template <int K, int NT, bool GATHER> struct MoeSched {
    typedef MUnit Unit;
    const char* W; const LAS int* tab; const int* list; int G, c;
    __device__ __forceinline__ bool next(int i, Unit& u) const {
        const int L = i * G + c; const int total = tab[32] * NT; if (L >= total) return false;
        const int mg = L / NT; u.pn = L % NT;
        int E = 0;
#pragma unroll 1
        for (int e = 1; e < 32; ++e) E = (tab[e] <= mg) ? e : E;
        E = __builtin_amdgcn_readfirstlane(E);
        u.E = E; u.mt = mg - tab[E]; u.cnt = tab[33 + E]; u.rowbase = tab[65 + E]; return true;
    }
    __device__ __forceinline__ const char* bptr(const Unit& u) const { return W + ((size_t)u.E * NT + u.pn) * BM * K * 2; }
    __device__ __forceinline__ void aoff(const Unit& u, int R0, int R1, int Cb, unsigned (&o)[2][2]) const {
#pragma unroll
        for (int h = 0; h < 2; ++h)
#pragma unroll
            for (int i = 0; i < 2; ++i) { const int slot = u.mt * BM + h * HALF + (i ? R1 : R0);
                if (GATHER) { const int tok = slot < u.cnt ? (list[u.E * CAPE + slot] >> 1) : 0; o[h][i] = (unsigned)(tok * K) * 2u + Cb; }
                else o[h][i] = (unsigned)((u.rowbase + slot) * K) * 2u + Cb; }
    }
};

struct EpiBf16 {
    static constexpr bool PERM = true;
    bf16_t* O; int ldc;
    __device__ __forceinline__ void operator()(const f32x4 (&acc)[2][2][4][2], const DUnit& u, int wr, int wc, int fr, int fq) const {
        const int row0 = u.pm * BM + wr * 64 + fr, col0 = u.pn * BM + wc * 32 + 8 * fq;
#pragma unroll
        for (int ai = 0; ai < 2; ++ai)
#pragma unroll
            for (int m = 0; m < 4; ++m) { bf16_t* rowp = O + (size_t)(row0 + ai * HALF + m * 16) * ldc + col0;
#pragma unroll
                for (int bj = 0; bj < 2; ++bj) { const f32x4 v0 = acc[ai][bj][m][0], v1 = acc[ai][bj][m][1];
                    u32x4 w; w.x = cvt_pk_bf16(v0[0], v0[1]); w.y = cvt_pk_bf16(v0[2], v0[3]); w.z = cvt_pk_bf16(v1[0], v1[1]); w.w = cvt_pk_bf16(v1[2], v1[3]);
                    *(u32x4*)(rowp + bj * HALF) = w; } }
    }
};
struct EpiRes {
    static constexpr bool PERM = true;
    const bf16_t* res; bf16_t* C; int ldc;
    __device__ __forceinline__ void operator()(const f32x4 (&acc)[2][2][4][2], const DUnit& u, int wr, int wc, int fr, int fq) const {
        const int row0 = u.pm * BM + wr * 64 + fr, col0 = u.pn * BM + wc * 32 + 8 * fq;
#pragma unroll
        for (int ai = 0; ai < 2; ++ai)
#pragma unroll
            for (int m = 0; m < 4; ++m) { const size_t off = (size_t)(row0 + ai * HALF + m * 16) * ldc + col0;
#pragma unroll
                for (int bj = 0; bj < 2; ++bj) { const u32x4 r = *(const u32x4*)(res + off + bj * HALF); const f32x4 v0 = acc[ai][bj][m][0], v1 = acc[ai][bj][m][1];
                    u32x4 w; w.x = cvt_pk_bf16(bflo(r.x) + v0[0], bfhi(r.x) + v0[1]); w.y = cvt_pk_bf16(bflo(r.y) + v0[2], bfhi(r.y) + v0[3]);
                    w.z = cvt_pk_bf16(bflo(r.z) + v1[0], bfhi(r.z) + v1[1]); w.w = cvt_pk_bf16(bflo(r.w) + v1[2], bfhi(r.w) + v1[3]);
                    *(u32x4*)(C + off + bj * HALF) = w; } }
    }
};
struct EpiGateUp {
    static constexpr bool PERM = true;
    bf16_t* H; const float* gw;
    __device__ __forceinline__ void operator()(const f32x4 (&acc)[2][2][4][2], const MUnit& u, int wr, int wc, int fr, int fq) const {
        const int col0 = u.pn * HALF + wc * 32 + 8 * fq;
#pragma unroll
        for (int ai = 0; ai < 2; ++ai)
#pragma unroll
            for (int m = 0; m < 4; ++m) { const int slot = u.mt * BM + ai * HALF + wr * 64 + m * 16 + fr;
                const float w = slot < u.cnt ? gw[u.E * CAPE + slot] : 0.f;
                const f32x4 g0 = acc[ai][0][m][0], g1 = acc[ai][0][m][1], u0 = acc[ai][1][m][0], u1 = acc[ai][1][m][1];
                float h[8];
#pragma unroll
                for (int j = 0; j < 4; ++j) { h[j] = silu(g0[j]) * u0[j] * w; h[4 + j] = silu(g1[j]) * u1[j] * w; }
                u32x4 o; o.x = cvt_pk_bf16(h[0], h[1]); o.y = cvt_pk_bf16(h[2], h[3]); o.z = cvt_pk_bf16(h[4], h[5]); o.w = cvt_pk_bf16(h[6], h[7]);
                *(u32x4*)(H + (size_t)(u.rowbase + slot) * DE + col0) = o; }
    }
};
struct EpiDown {
    static constexpr bool PERM = true;
    bf16_t* Y; const int* list;
    __device__ __forceinline__ void operator()(const f32x4 (&acc)[2][2][4][2], const MUnit& u, int wr, int wc, int fr, int fq) const {
        const int col0 = u.pn * BM + wc * 32 + 8 * fq;
#pragma unroll
        for (int ai = 0; ai < 2; ++ai)
#pragma unroll
            for (int m = 0; m < 4; ++m) { const int slot = u.mt * BM + ai * HALF + wr * 64 + m * 16 + fr;
                if (slot < u.cnt) { const int ent = list[u.E * CAPE + slot]; bf16_t* rowp = Y + (size_t)ent * DM + col0;
#pragma unroll
                    for (int bj = 0; bj < 2; ++bj) { const f32x4 v0 = acc[ai][bj][m][0], v1 = acc[ai][bj][m][1];
                        u32x4 w; w.x = cvt_pk_bf16(v0[0], v0[1]); w.y = cvt_pk_bf16(v0[2], v0[3]); w.z = cvt_pk_bf16(v1[0], v1[1]); w.w = cvt_pk_bf16(v1[2], v1[3]);
                        *(u32x4*)(rowp + bj * HALF) = w; } } }
    }
};

template <int K, int LDB, class Epi, class Sched>
__device__ __forceinline__ void gemm_rb(LAS unsigned char* lds, const char* Abase, const Sched& S, const Epi& E) {
    typedef typename Sched::Unit Unit;
    const int tid = opaque_tid(), wid = __builtin_amdgcn_readfirstlane(tid >> 6), lane = tid & 63, wr = wid >> 2, wc = wid & 3, fr = lane & 15, fq = lane >> 4;
    constexpr int nt = K / BK;
    int Rr[2], Cb;
#pragma unroll
    for (int i = 0; i < 2; ++i) { int R, C; stage_rc(tid * 16 + i * 8192, R, C); Rr[i] = R; Cb = C * 2; }
    const unsigned ldsw = (unsigned)wid * 1024u;
    const int aoff = lds_byte(wr * 64 + fr, fq * 8);
    const int k4 = tid >> 5, n4 = tid & 31;
    int bw[4];
#pragma unroll
    for (int q = 0; q < 4; ++q) bw[q] = (4 * n4 + q) * 128 + (((k4 >> 1) ^ (n4 & 7)) * 16) + (k4 & 1) * 8;
    int brd[2][2];
#pragma unroll
    for (int n = 0; n < 2; ++n)
#pragma unroll
        for (int k = 0; k < 2; ++k) { const int r = wc * 32 + n * 16 + fr; brd[n][k] = r * 128 + (((k * 4 + fq) ^ ((r >> 2) & 7)) * 16); }
#define RB_SB(b) (98304 + (b) * HTB)
#define RB_STAGE_A(sa, kt, OFF) do { _Pragma("unroll") for (int _h = 0; _h < 2; ++_h) _Pragma("unroll") for (int _i = 0; _i < 2; ++_i) \
        __builtin_amdgcn_global_load_lds((const unsigned*)(Abase + (size_t)(kt) * (BK * 2) + OFF[_h][_i]), (LAS unsigned*)(lds + (sa) * 32768 + _h * HTB + ldsw + _i * 8192), 16, 0, 0); } while (0)
#define RB_LOAD_B(r0, r1, r2, r3, kt, BP) do { const float* _p = BP + (size_t)(kt) * BK * LDB; \
        asm volatile("global_load_dwordx4 %0, %4, off\n\tglobal_load_dwordx4 %1, %5, off\n\tglobal_load_dwordx4 %2, %6, off\n\tglobal_load_dwordx4 %3, %7, off" \
            : "=&v"(r0), "=&v"(r1), "=&v"(r2), "=&v"(r3) : "v"(_p), "v"(_p + LDB), "v"(_p + 2 * LDB), "v"(_p + 3 * LDB) : "memory"); } while (0)
#define RB_WAIT8(r0, r1, r2, r3) asm volatile("s_waitcnt vmcnt(8)" : "+v"(r0), "+v"(r1), "+v"(r2), "+v"(r3) :: "memory")
#define RB_WRITE_B(b, r0, r1, r2, r3) do { _Pragma("unroll") for (int _q = 0; _q < 4; ++_q) { u32x2 _w; _w.x = cvt_pk_bf16(r0[_q], r1[_q]); _w.y = cvt_pk_bf16(r2[_q], r3[_q]); \
        *(LAS u32x2*)(lds + RB_SB(b) + bw[_q]) = _w; } } while (0)
#define RB_COMPUTE(sa, b) do { bf16x8 Bf[2][2]; _Pragma("unroll") for (int n = 0; n < 2; ++n) _Pragma("unroll") for (int k = 0; k < 2; ++k) Bf[n][k] = *(const LAS bf16x8*)(lds + RB_SB(b) + brd[n][k]); \
        _Pragma("unroll") for (int ai = 0; ai < 2; ++ai) { bf16x8 At[4][2]; _Pragma("unroll") for (int m = 0; m < 4; ++m) _Pragma("unroll") for (int k = 0; k < 2; ++k) At[m][k] = *(const LAS bf16x8*)(lds + (sa) * 32768 + ai * HTB + aoff + m * 2048 + k * 1024); \
            __builtin_amdgcn_s_setprio(1); _Pragma("unroll") for (int m = 0; m < 4; ++m) _Pragma("unroll") for (int n = 0; n < 2; ++n) _Pragma("unroll") for (int k = 0; k < 2; ++k) acc[ai][m][n] = __builtin_amdgcn_mfma_f32_16x16x32_bf16(Bf[n][k], At[m][k], acc[ai][m][n], 0, 0, 0); __builtin_amdgcn_s_setprio(0); } } while (0)
#define RB_SYNC() do { asm volatile("s_waitcnt lgkmcnt(0)" ::: "memory"); __builtin_amdgcn_s_barrier(); asm volatile("" ::: "memory"); sa = sa == 2 ? 0 : sa + 1; } while (0)
#define RB_STEP(b, kt2, OFF, BP, c0, c1, c2, c3, n0, n1, n2, n3) do { const int _s2 = sa >= 1 ? sa - 1 : 2; RB_STAGE_A(_s2, kt2, OFF); RB_LOAD_B(c0, c1, c2, c3, kt2, BP); \
        RB_COMPUTE(sa, b); RB_WAIT8(n0, n1, n2, n3); RB_WRITE_B((b) ^ 1, n0, n1, n2, n3); RB_SYNC(); } while (0)
    Unit u, un;
    if (!S.next(0, u)) return;
    unsigned cOff[2][2], nOff[2][2]; S.aoff(u, Rr[0], Rr[1], Cb, cOff);
    const float* bp = S.bsrc(u, 4 * n4) + (size_t)(4 * k4) * LDB; const float* nbp = bp;
    f32x4 e0, e1, e2, e3, o0, o1, o2, o3;
    asm volatile("s_waitcnt vmcnt(0)" ::: "memory");
    RB_STAGE_A(0, 0, cOff); RB_LOAD_B(e0, e1, e2, e3, 0, bp);
    RB_STAGE_A(1, 1, cOff); RB_LOAD_B(o0, o1, o2, o3, 1, bp);
    RB_WAIT8(e0, e1, e2, e3); RB_WRITE_B(0, e0, e1, e2, e3);
    asm volatile("s_waitcnt lgkmcnt(0)" ::: "memory"); __builtin_amdgcn_s_barrier(); asm volatile("" ::: "memory");
    int sa = 0;
    for (int ui = 0;; ++ui) {
        const bool has_next = S.next(ui + 1, un);
        if (has_next) { S.aoff(un, Rr[0], Rr[1], Cb, nOff); nbp = S.bsrc(un, 4 * n4) + (size_t)(4 * k4) * LDB; }
        else { nOff[0][0] = cOff[0][0]; nOff[0][1] = cOff[0][1]; nOff[1][0] = cOff[1][0]; nOff[1][1] = cOff[1][1]; nbp = bp; }
        f32x4 acc[2][4][2];
#pragma unroll
        for (int a = 0; a < 2; ++a)
#pragma unroll
            for (int m = 0; m < 4; ++m)
#pragma unroll
                for (int n = 0; n < 2; ++n) acc[a][m][n] = (f32x4){0.f, 0.f, 0.f, 0.f};
        unsigned pv[2][4]; E.pre(u, wr, fr, pv);
#pragma unroll 1
        for (int t = 0; t < nt - 2; t += 2) { RB_STEP(0, t + 2, cOff, bp, e0, e1, e2, e3, o0, o1, o2, o3); RB_STEP(1, t + 3, cOff, bp, o0, o1, o2, o3, e0, e1, e2, e3); }
        RB_STEP(0, 0, nOff, nbp, e0, e1, e2, e3, o0, o1, o2, o3); RB_STEP(1, 1, nOff, nbp, o0, o1, o2, o3, e0, e1, e2, e3);
        E(acc, u, wr, wc, fr, fq, pv);
        if (!has_next) break;
        u = un; bp = nbp; cOff[0][0] = nOff[0][0]; cOff[0][1] = nOff[0][1]; cOff[1][0] = nOff[1][0]; cOff[1][1] = nOff[1][1];
    }
    asm volatile("s_waitcnt vmcnt(0)" ::: "memory"); __builtin_amdgcn_s_barrier();
#undef RB_SB
#undef RB_STAGE_A
#undef RB_LOAD_B
#undef RB_WAIT8
#undef RB_WRITE_B
#undef RB_COMPUTE
#undef RB_STEP
#undef RB_SYNC
}
template <int K, int NT, bool GATHER> struct MoeSchedRB {
    typedef MUnit Unit;
    const float* W0; const float* W1; const LAS int* tab; const int* list; int G, c;
    __device__ __forceinline__ bool next(int i, Unit& u) const {
        const int L = i * G + c; const int total = tab[32] * NT; if (L >= total) return false;
        const int mg = L / NT;
        int E = 0;
#pragma unroll 1
        for (int e = 1; e < 32; ++e) E = (tab[e] <= mg) ? e : E;
        E = __builtin_amdgcn_readfirstlane(E);
#ifndef ORDER_MT_FAST
#define ORDER_MT_FAST 1
#endif
        if (ORDER_MT_FAST) { const int nte = tab[E + 1] - tab[E], loc = L - tab[E] * NT; u.pn = loc / nte; u.mt = loc - u.pn * nte; }
        else { u.pn = L % NT; u.mt = mg - tab[E]; }
        u.E = E; u.cnt = tab[33 + E]; u.rowbase = tab[65 + E]; return true;
    }
    __device__ __forceinline__ const float* bsrc(const Unit& u, int c4) const {
        if (GATHER) { const long dW = ((c4 >> 4) & 1) ? (long)(W1 - W0) : 0l; return W0 + dW + (size_t)u.E * DM * DE + 64 * u.pn + 16 * (c4 >> 5) + (c4 & 15); }
        else return W0 + (size_t)u.E * DE * DM + 128 * u.pn + c4;
    }
    __device__ __forceinline__ void aoff(const Unit& u, int R0, int R1, int Cb, unsigned (&o)[2][2]) const {
#pragma unroll
        for (int h = 0; h < 2; ++h)
#pragma unroll
            for (int i = 0; i < 2; ++i) { const int slot = u.mt * BM + h * HALF + (i ? R1 : R0);
                if (GATHER) { const int ent = list[u.E * CAPE + slot]; const int tok = slot < u.cnt ? (ent >> 1) : 0; o[h][i] = (unsigned)(tok * K) * 2u + Cb; }
                else o[h][i] = (unsigned)((u.rowbase + slot) * K) * 2u + Cb; }
    }
};
struct EpiGateUpRB {
    bf16_t* H; const float* gw;
    __device__ __forceinline__ void pre(const MUnit& u, int wr, int fr, unsigned (&pv)[2][4]) const {
#pragma unroll
        for (int ai = 0; ai < 2; ++ai)
#pragma unroll
            for (int m = 0; m < 4; ++m) pv[ai][m] = __float_as_uint(gw[u.E * CAPE + u.mt * BM + ai * HALF + wr * 64 + m * 16 + fr]);
    }
    __device__ __forceinline__ void operator()(const f32x4 (&acc)[2][4][2], const MUnit& u, int wr, int wc, int fr, int fq, const unsigned (&pv)[2][4]) const {
        const int col0 = u.pn * 64 + wc * 16 + 4 * fq;
#pragma unroll
        for (int ai = 0; ai < 2; ++ai)
#pragma unroll
            for (int m = 0; m < 4; ++m) { const int slot = u.mt * BM + ai * HALF + wr * 64 + m * 16 + fr;
                const float w = slot < u.cnt ? __uint_as_float(pv[ai][m]) : 0.f;
                const f32x4 g = acc[ai][m][0], up = acc[ai][m][1];
                u32x2 o; o.x = cvt_pk_bf16(silu(g[0]) * up[0] * w, silu(g[1]) * up[1] * w); o.y = cvt_pk_bf16(silu(g[2]) * up[2] * w, silu(g[3]) * up[3] * w);
                *(u32x2*)(H + (size_t)(u.rowbase + slot) * DE + col0) = o; }
    }
};
struct EpiDownRB {
    bf16_t* Y; const int* list;
    __device__ __forceinline__ void pre(const MUnit& u, int wr, int fr, unsigned (&pv)[2][4]) const {
#pragma unroll
        for (int ai = 0; ai < 2; ++ai)
#pragma unroll
            for (int m = 0; m < 4; ++m) pv[ai][m] = (unsigned)list[u.E * CAPE + u.mt * BM + ai * HALF + wr * 64 + m * 16 + fr];
    }
    __device__ __forceinline__ void operator()(const f32x4 (&acc)[2][4][2], const MUnit& u, int wr, int wc, int fr, int fq, const unsigned (&pv)[2][4]) const {
        const int col0 = u.pn * HALF + wc * 32 + 4 * fq;
#pragma unroll
        for (int ai = 0; ai < 2; ++ai)
#pragma unroll
            for (int m = 0; m < 4; ++m) { const int slot = u.mt * BM + ai * HALF + wr * 64 + m * 16 + fr;
                if (slot < u.cnt) { bf16_t* rowp = Y + (size_t)pv[ai][m] * DM + col0;
#pragma unroll
                    for (int n = 0; n < 2; ++n) { const f32x4 v = acc[ai][m][n]; u32x2 o; o.x = cvt_pk_bf16(v[0], v[1]); o.y = cvt_pk_bf16(v[2], v[3]); *(u32x2*)(rowp + n * 16) = o; } } }
    }
};
}

struct Args { const float* in[21]; float* out; unsigned char* ws; int ph_lo, ph_hi; };
#define CAS __attribute__((address_space(4)))
typedef const CAS Args* ArgP;
__device__ __forceinline__ ArgP kargs() { ArgP p = (ArgP)__builtin_amdgcn_kernarg_segment_ptr(); asm volatile("" : "+s"(p)); return p; }

enum { I_X = 0, I_N1G, I_WIN, I_CONVW, I_CONVB, I_CLNG, I_CLNB, I_GW2, I_GB2, I_GNG, I_FFB, I_WOUT, I_N2G, I_RGW, I_RGB, I_REW, I_REB, I_WG, I_WU, I_WD, I_FNG };

template <int MAP  >
__device__ __forceinline__ void cvt_item(const float* W, int K, int N, int nblk, bf16_t* WT, LAS float* scr, int item, int lane) {
    const int kb = item / nblk, nb = item % nblk, k0 = 64 * kb, n0 = 32 * nb;
    const int n4 = lane & 7, kr = lane >> 3;
    const bool nok = (n0 + 4 * n4) < N;
    f32x4 v[8];
#pragma unroll
    for (int i = 0; i < 8; ++i) v[i] = nok ? *(const f32x4*)(W + (size_t)(k0 + 8 * i + kr) * N + n0 + 4 * n4) : (f32x4){0.f, 0.f, 0.f, 0.f};
#pragma unroll
    for (int i = 0; i < 8; ++i) { LAS float* d = scr + (8 * i + kr) * 33 + 4 * n4; d[0] = v[i].x; d[1] = v[i].y; d[2] = v[i].z; d[3] = v[i].w; }
    LDS_WAIT(); asm volatile("" ::: "memory");
    const int c = lane & 7;
#pragma unroll
    for (int j = 0; j < 4; ++j) { const int n = (lane >> 3) + 8 * j; const LAS float* s = scr + (8 * c) * 33 + n;
        u32x4 o; o.x = cvt_pk_bf16(s[0 * 33], s[1 * 33]); o.y = cvt_pk_bf16(s[2 * 33], s[3 * 33]); o.z = cvt_pk_bf16(s[4 * 33], s[5 * 33]); o.w = cvt_pk_bf16(s[6 * 33], s[7 * 33]);
        const int nn = n0 + n; const int row = MAP == 0 ? nn : ((nn >> 7) * 256 + (nn & 127) + (MAP == 2 ? 128 : 0));
        *(u32x4*)(WT + (size_t)row * K + k0 + 8 * c) = o; }
    LDS_WAIT(); asm volatile("" ::: "memory");
}
constexpr int CV_I_IN = 32 * 184, CV_I_OUT = 32 * 64, CV_N_IN = 2 * CV_I_IN;
__device__ __forceinline__ void cvt_range(ArgP a, LAS unsigned char* lds, int first, int count, int rank, int nranks) {
    const int tid = opaque_tid(), lane = tid & 63, wave = tid >> 6;
    LAS float* scr = (LAS float*)(lds + wave * 16384);
    for (int it = first + rank * NWAVES + wave; it < first + count; it += nranks * NWAVES) {
        int r = it;
        if (r < CV_N_IN) { const int l = r / CV_I_IN; cvt_item<0>(a->in[I_WIN] + (size_t)l * DM * DIN, DM, DIN, 184, (bf16_t*)(a->ws + WS_WIN) + (size_t)l * DINP * DM, scr, r % CV_I_IN, lane); continue; } r -= CV_N_IN;
        { const int l = r / CV_I_OUT; cvt_item<0>(a->in[I_WOUT] + (size_t)l * DM * DM, DM, DM, 64, (bf16_t*)(a->ws + WS_WOUT) + (size_t)l * DM * DM, scr, r % CV_I_OUT, lane); }
    }
}
__device__ __forceinline__ void idle_rank(int nunits, int G, int c, int& rank, int& nranks) {
    const int maxu = (nunits + G - 1) / G, nidle = maxu * G - nunits, first = nunits - (maxu - 1) * G;
    if (nidle >= 16) { nranks = nidle; rank = c >= first ? c - first : -1; } else { nranks = G; rank = c; }
}
__device__ __forceinline__ void p0_prologue(ArgP a, LAS unsigned char* lds) {
    const int tid = opaque_tid(), lane = tid & 63, wave = tid >> 6;
    LAS float* scr = (LAS float*)(lds + wave * 16384);
    const int gw = blockIdx.x * NWAVES + wave, NGW = gridDim.x * NWAVES;
    constexpr int I_IN = CV_I_IN;
    cvt_range(a, lds, 0, I_IN, blockIdx.x, gridDim.x);
    for (int idx = blockIdx.x * NTHR + tid; idx < DEPTH * 48 * DM; idx += gridDim.x * NTHR) {
        const int k = idx % DM, c = (idx / DM) % 48, l = idx / (DM * 48);
        float w = 0.f;
        if (c < 4) w = a->in[I_RGW][((size_t)l * DM + k) * 4 + c];
        else if (c < 36) w = a->in[I_REW][(((size_t)l * 4 + ((c - 4) >> 3)) * DM + k) * 8 + ((c - 4) & 7)];
        w *= a->in[I_N2G][l * DM + k];
        const bf16_t hi = f2bf(w), lo = f2bf(w - bf2f(hi));
        bf16_t* wr = (bf16_t*)(a->ws + WS_WR);
        wr[((size_t)(l * 2 + 0) * 48 + c) * DM + k] = hi; wr[((size_t)(l * 2 + 1) * 48 + c) * DM + k] = lo;
    }
    const float* g = a->in[I_N1G];
    f32x4 nx[8];
    if (gw < T) {
#pragma unroll
        for (int j = 0; j < 8; ++j) nx[j] = ((const f32x4*)(a->in[I_X] + (size_t)gw * DM) + lane)[64 * j]; }
    for (int m = gw; m < T; m += NGW) {
        f32x4 v[8]; float s = 0.f;
#pragma unroll
        for (int j = 0; j < 8; ++j) { v[j] = nx[j]; s += (v[j].x * v[j].x + v[j].y * v[j].y) + (v[j].z * v[j].z + v[j].w * v[j].w); }
        if (m + NGW < T) {
#pragma unroll
            for (int j = 0; j < 8; ++j) nx[j] = ((const f32x4*)(a->in[I_X] + (size_t)(m + NGW) * DM) + lane)[64 * j]; }
        const float rstd = rsqrtf(wave_sum(s) * (1.f / DM) + EPS);
        u32x2* o = (u32x2*)((bf16_t*)(a->ws + WS_H) + (size_t)m * DM) + lane; u32x2* xb = (u32x2*)((bf16_t*)(a->ws + WS_XB) + (size_t)m * DM) + lane;
#pragma unroll
        for (int j = 0; j < 8; ++j) { const f32x4 gg = ((const f32x4*)g)[lane + 64 * j]; u32x2 w; w.x = cvt_pk_bf16(v[j].x * rstd * gg.x, v[j].y * rstd * gg.y); w.y = cvt_pk_bf16(v[j].z * rstd * gg.z, v[j].w * rstd * gg.w); o[64 * j] = w;
            u32x2 xw; xw.x = cvt_pk_bf16(v[j].x, v[j].y); xw.y = cvt_pk_bf16(v[j].z, v[j].w); xb[64 * j] = xw; }
    }
}

__device__ __forceinline__ void conv_phase(ArgP a, LAS unsigned char* lds, int l) {
    const int tid = opaque_tid(), lane = tid & 63, wave = tid >> 6, cp = tid & 255, th = tid >> 8;
    const bf16_t* P = (const bf16_t*)(a->ws + WS_P); bf16_t* mix = (bf16_t*)(a->ws + WS_MIX);
    LAS float* ut = (LAS float*)lds;
    for (int item = blockIdx.x; item < NB * (SEQ / 32); item += gridDim.x) {
        const int b = item / (SEQ / 32), s0 = (item % (SEQ / 32)) * 32;
        __syncthreads();
#pragma unroll
        for (int i = 0; i < 8; ++i) { const int idx = tid + i * 512, r = idx >> 6, c8 = idx & 63, sq = s0 - 30 + r;
            if (r < 62) { f32x4 u0 = {0.f, 0.f, 0.f, 0.f}, u1 = {0.f, 0.f, 0.f, 0.f};
                if (sq >= 0) { const bf16_t* row = P + (size_t)(b * SEQ + sq) * DINP + c8 * 8; const u32x4 av = *(const u32x4*)(row + C_CA), gv = *(const u32x4*)(row + C_CG);
                    u0.x = bflo(av.x) * __builtin_amdgcn_rcpf(1.f + __expf(-bflo(gv.x))); u0.y = bfhi(av.x) * __builtin_amdgcn_rcpf(1.f + __expf(-bfhi(gv.x)));
                    u0.z = bflo(av.y) * __builtin_amdgcn_rcpf(1.f + __expf(-bflo(gv.y))); u0.w = bfhi(av.y) * __builtin_amdgcn_rcpf(1.f + __expf(-bfhi(gv.y)));
                    u1.x = bflo(av.z) * __builtin_amdgcn_rcpf(1.f + __expf(-bflo(gv.z))); u1.y = bfhi(av.z) * __builtin_amdgcn_rcpf(1.f + __expf(-bfhi(gv.z)));
                    u1.z = bflo(av.w) * __builtin_amdgcn_rcpf(1.f + __expf(-bflo(gv.w))); u1.w = bfhi(av.w) * __builtin_amdgcn_rcpf(1.f + __expf(-bfhi(gv.w))); }
                *(LAS f32x4*)(ut + r * 512 + c8 * 8) = u0; *(LAS f32x4*)(ut + r * 512 + c8 * 8 + 4) = u1; } }
        f32x2 w[31];
#pragma unroll
        for (int j = 0; j < 31; ++j) w[j] = *(const f32x2*)(a->in[I_CONVW] + ((size_t)l * 31 + j) * 512 + 2 * cp);
        const f32x2 cb = *(const f32x2*)(a->in[I_CONVB] + l * 512 + 2 * cp);
        __syncthreads();
        f32x2 y[16];
#pragma unroll
        for (int t = 0; t < 16; ++t) y[t] = cb;
#pragma unroll
        for (int r = 0; r < 46; ++r) { const f32x2 u = *(const LAS f32x2*)(ut + (th * 16 + r) * 512 + 2 * cp);
#pragma unroll
            for (int t = 0; t < 16; ++t) { const int j = r - t; if (j >= 0 && j < 31) y[t] += w[j] * u; } }
        __syncthreads();
#pragma unroll
        for (int t = 0; t < 16; ++t) *(LAS f32x2*)(ut + (th * 16 + t) * 512 + 2 * cp) = y[t];
        __syncthreads();
#pragma unroll
        for (int q = 0; q < 4; ++q) { const int t = wave * 4 + q;
            const f32x4 y0 = *(const LAS f32x4*)(ut + t * 512 + lane * 8), y1 = *(const LAS f32x4*)(ut + t * 512 + lane * 8 + 4);
            const float mu = wave_sum((y0.x + y0.y) + (y0.z + y0.w) + (y1.x + y1.y) + (y1.z + y1.w)) * (1.f / 512.f);
            const f32x4 d0 = y0 - mu, d1 = y1 - mu;
            const float var = wave_sum((d0.x * d0.x + d0.y * d0.y) + (d0.z * d0.z + d0.w * d0.w) + (d1.x * d1.x + d1.y * d1.y) + (d1.z * d1.z + d1.w * d1.w)) * (1.f / 512.f);
            const float rstd = rsqrtf(var + EPS);
            const f32x4 g0 = *(const f32x4*)(a->in[I_CLNG] + l * 512 + lane * 8), g1 = *(const f32x4*)(a->in[I_CLNG] + l * 512 + lane * 8 + 4);
            const f32x4 b0 = *(const f32x4*)(a->in[I_CLNB] + l * 512 + lane * 8), b1 = *(const f32x4*)(a->in[I_CLNB] + l * 512 + lane * 8 + 4);
            float o[8];
#pragma unroll
            for (int j = 0; j < 4; ++j) { o[j] = silu(d0[j] * rstd * g0[j] + b0[j]); o[4 + j] = silu(d1[j] * rstd * g1[j] + b1[j]); }
            u32x4 pk; pk.x = cvt_pk_bf16(o[0], o[1]); pk.y = cvt_pk_bf16(o[2], o[3]); pk.z = cvt_pk_bf16(o[4], o[5]); pk.w = cvt_pk_bf16(o[6], o[7]);
            *(u32x4*)(mix + (size_t)(b * SEQ + s0 + t) * DM + M_CONV + lane * 8) = pk; }
    }
    __syncthreads();
}

constexpr int GL_ALOW = 0, GL_TOT = 5120, GL_END0 = 5120 + 2048;
__device__ __forceinline__ void gla_cum(ArgP a, LAS unsigned char* lds, int l, int h, int t0, float (&cum)[16], float& last) {
    const int tid = opaque_tid(), d = tid & 127, cg = tid >> 7;
    const bf16_t* P = (const bf16_t*)(a->ws + WS_P);
    LAS float* alow = (LAS float*)(lds + GL_ALOW); LAS float* tot = (LAS float*)(lds + GL_TOT);
#pragma unroll
    for (int i = 0; i < 2; ++i) { const int idx = tid + i * 512, c = idx >> 4, r = idx & 15; alow[c * 20 + r] = bf2f(P[(size_t)(t0 + c) * DINP + C_GLOW + r]); }
    float w2[16];
#pragma unroll
    for (int r = 0; r < 16; ++r) w2[r] = a->in[I_GW2][((size_t)l * 16 + r) * 512 + h * 128 + d];
    const float b2 = a->in[I_GB2][l * 512 + h * 128 + d];
    __syncthreads();
    float run = 0.f;
#pragma unroll
    for (int j = 0; j < 16; ++j) { const int c = cg * 16 + j; float z = b2;
#pragma unroll
        for (int q = 0; q < 4; ++q) { const f32x4 av = *(const LAS f32x4*)(alow + c * 20 + q * 4); z += av.x * w2[q * 4] + av.y * w2[q * 4 + 1] + av.z * w2[q * 4 + 2] + av.w * w2[q * 4 + 3]; }
        run += log_sigmoid(z) * (1.f / 16.f); cum[j] = run; }
    tot[cg * 128 + d] = run;
    __syncthreads();
    float pre = 0.f, all = 0.f;
#pragma unroll
    for (int q = 0; q < 4; ++q) { const float tv = tot[q * 128 + d]; pre += (q < cg) ? tv : 0.f; all += tv; }
#pragma unroll
    for (int j = 0; j < 16; ++j) cum[j] += pre;
    last = all;
}
constexpr int GA_KT = GL_END0, GA_V = GA_KT + 128 * 144, GA_OUT = GA_V + 64 * 528, GA_END = GA_OUT + 256 * 256;
static_assert(GA_END <= MISC_OFF, "GLA-A LDS");
__device__ __forceinline__ void gla_a_phase(ArgP a, LAS unsigned char* lds, int l) {
    const int tid = opaque_tid(), lane = tid & 63, wave = tid >> 6, d = tid & 127, cg = tid >> 7, g = lane >> 4, li = lane & 15;
    const bf16_t* P = (const bf16_t*)(a->ws + WS_P);
    for (int item = blockIdx.x; item < 512; item += gridDim.x) {
        const int n = item & 31, h = (item >> 5) & 3, b = item >> 7, t0 = b * SEQ + n * 64;
        float cum[16], last;
        bf16_t kraw[16]; u32x4 vraw[4];
#pragma unroll
        for (int j = 0; j < 16; ++j) kraw[j] = P[(size_t)(t0 + cg * 16 + j) * DINP + C_GK + h * 128 + d];
#pragma unroll
        for (int i = 0; i < 4; ++i) { const int idx = tid + i * 512, c = idx >> 5, e8 = idx & 31; vraw[i] = *(const u32x4*)(P + (size_t)(t0 + c) * DINP + C_GV + h * 256 + e8 * 8); }
        __syncthreads();
        gla_cum(a, lds, l, h, t0, cum, last);
        { float* cg_ = (float*)(a->ws + WS_CUM) + (size_t)(t0 + cg * 16) * 512 + h * 128 + d;
#pragma unroll
          for (int j = 0; j < 16; ++j) cg_[j * 512] = cum[j]; }
        { unsigned pk[8];
#pragma unroll
          for (int j = 0; j < 16; j += 2) { const float k0 = bf2f(kraw[j]), k1 = bf2f(kraw[j + 1]);
              pk[j >> 1] = cvt_pk_bf16(k0 * __expf(last - cum[j]), k1 * __expf(last - cum[j + 1])); }
          LAS u32x4* dst = (LAS u32x4*)(lds + GA_KT + d * 144 + cg * 32);
          dst[0] = (u32x4){pk[0], pk[1], pk[2], pk[3]}; dst[1] = (u32x4){pk[4], pk[5], pk[6], pk[7]}; }
        if (cg == 0) ((float*)(a->ws + WS_DEC))[item * 128 + d] = __expf(last);
#pragma unroll
        for (int i = 0; i < 4; ++i) { const int idx = tid + i * 512, c = idx >> 5, e8 = idx & 31;
            *(LAS u32x4*)(lds + GA_V + c * 528 + e8 * 16) = vraw[i]; }
        __syncthreads();
        f32x4 acc[2][8];
#pragma unroll
        for (int i = 0; i < 2; ++i)
#pragma unroll
            for (int j = 0; j < 8; ++j) acc[i][j] = (f32x4){0.f, 0.f, 0.f, 0.f};
#pragma unroll
        for (int kk = 0; kk < 2; ++kk) {
            bf16x8 af[2], bfr[8];
#pragma unroll
            for (int i = 0; i < 2; ++i) { const LAS unsigned char* p = lds + GA_V + (kk * 32 + 8 * g + (li >> 2)) * 528 + ((wave * 2 + i) * 16 + 4 * (li & 3)) * 2;
                af[i] = cat8(vtr(p), vtr(p + 4 * 528)); }
#pragma unroll
            for (int j = 0; j < 8; ++j) bfr[j] = *(const LAS bf16x8*)(lds + GA_KT + (j * 16 + li) * 144 + (kk * 32 + 8 * g) * 2);
#pragma unroll
            for (int i = 0; i < 2; ++i)
#pragma unroll
                for (int j = 0; j < 8; ++j) acc[i][j] = mfma16(af[i], bfr[j], acc[i][j]);
        }
#pragma unroll
        for (int i = 0; i < 2; ++i)
#pragma unroll
            for (int j = 0; j < 8; ++j)
#pragma unroll
                for (int r = 0; r < 4; ++r) *(LAS bf16_t*)(lds + GA_OUT + (((wave * 2 + i) * 16 + 4 * g + r) * 128 + j * 16 + li) * 2) = f2bf(acc[i][j][r]);
        __syncthreads();
        bf16_t* kv = (bf16_t*)(a->ws + WS_KV) + (size_t)item * 32768;
#pragma unroll
        for (int i = 0; i < 8; ++i) { const int idx = tid + i * 512; *(u32x4*)(kv + idx * 8) = *(const LAS u32x4*)(lds + GA_OUT + idx * 16); }
    }
    __syncthreads();
}
__device__ __forceinline__ void gla_b_phase(ArgP a) {
    bf16_t* kvb = (bf16_t*)(a->ws + WS_KV); const float* dec = (const float*)(a->ws + WS_DEC);
    const int tid0 = opaque_tid();
    for (int idx = blockIdx.x * NTHR + tid0; idx < 16 * 8192; idx += gridDim.x * NTHR) {
        const int bh = idx >> 13, off = (idx & 8191) * 4, d0 = off & 127;
        float st[4] = {0.f, 0.f, 0.f, 0.f};
#pragma unroll 1
        for (int n0 = 0; n0 < 32; n0 += 8) {
            u32x2 kvv[8]; f32x4 dc[8];
#pragma unroll
            for (int q = 0; q < 8; ++q) { const int ch = bh * 32 + n0 + q; kvv[q] = *(const u32x2*)(kvb + (size_t)ch * 32768 + off); dc[q] = *(const f32x4*)(dec + ch * 128 + d0); }
#pragma unroll
            for (int q = 0; q < 8; ++q) { const int ch = bh * 32 + n0 + q;
                u32x2 o; o.x = cvt_pk_bf16(st[0], st[1]); o.y = cvt_pk_bf16(st[2], st[3]);
                *(u32x2*)(kvb + (size_t)ch * 32768 + off) = o;
                st[0] = dc[q].x * st[0] + bflo(kvv[q].x); st[1] = dc[q].y * st[1] + bfhi(kvv[q].x); st[2] = dc[q].z * st[2] + bflo(kvv[q].y); st[3] = dc[q].w * st[3] + bfhi(kvv[q].y); }
        }
    }
}
constexpr int GC_QD = GL_END0, GC_KI = GC_QD + 64 * 272, GC_ATT = GC_KI + 64 * 272, GC_V = GC_ATT + 64 * 144, GC_SS = GC_V + 64 * 528, GC_END = GC_SS + 64 * 8 * 4;
constexpr int GC_OST = GL_END0;
static_assert(GC_END <= MISC_OFF && GC_OST + 64 * 260 * 4 <= GC_SS, "GLA-C LDS");
__device__ __forceinline__ void gla_c_phase(ArgP a, LAS unsigned char* lds, int l) {
    const int tid = opaque_tid(), lane = tid & 63, wave = tid >> 6, d = tid & 127, cg = tid >> 7, g = lane >> 4, li = lane & 15;
    const bf16_t* P = (const bf16_t*)(a->ws + WS_P); bf16_t* mix = (bf16_t*)(a->ws + WS_MIX);
    for (int item = blockIdx.x; item < 512; item += gridDim.x) {
        const int n = item & 31, h = (item >> 5) & 3, b = item >> 7, t0 = b * SEQ + n * 64;
        float cum[16];
        { const float* cg_ = (const float*)(a->ws + WS_CUM) + (size_t)(t0 + cg * 16) * 512 + h * 128 + d;
#pragma unroll
          for (int j = 0; j < 16; ++j) cum[j] = cg_[j * 512]; }
        bf16_t qraw[16], kraw[16]; u32x4 vraw[4];
#pragma unroll
        for (int j = 0; j < 16; ++j) { const bf16_t* row = P + (size_t)(t0 + cg * 16 + j) * DINP + h * 128 + d; qraw[j] = row[C_GQ]; kraw[j] = row[C_GK]; }
#pragma unroll
        for (int i = 0; i < 4; ++i) { const int idx = tid + i * 512, c = idx >> 5, e8 = idx & 31; vraw[i] = *(const u32x4*)(P + (size_t)(t0 + c) * DINP + C_GV + h * 256 + e8 * 8); }
        __syncthreads();
        const bf16_t* ST = (const bf16_t*)(a->ws + WS_KV) + (size_t)item * 32768;
        bf16x8 sf[2][4];
#pragma unroll
        for (int i = 0; i < 2; ++i)
#pragma unroll
            for (int ks = 0; ks < 4; ++ks) sf[i][ks] = *(const bf16x8*)(ST + ((wave * 2 + i) * 16 + li) * 128 + ks * 32 + 8 * g);
#pragma unroll
        for (int j = 0; j < 16; ++j) { const int c = cg * 16 + j;
            const float qv = bf2f(qraw[j]) * 0.08838834764831845f * __expf(cum[j]), kv = bf2f(kraw[j]) * __expf(-cum[j]);
            *(LAS bf16_t*)(lds + GC_QD + c * 272 + d * 2) = f2bf(qv); *(LAS bf16_t*)(lds + GC_KI + c * 272 + d * 2) = f2bf(kv); }
#pragma unroll
        for (int i = 0; i < 4; ++i) { const int idx = tid + i * 512, c = idx >> 5, e8 = idx & 31;
            *(LAS u32x4*)(lds + GC_V + c * 528 + e8 * 16) = vraw[i]; }
        __syncthreads();
        { const int cb = wave >> 1;
#pragma unroll
          for (int i = 0; i < 2; ++i) { const int sb = 2 * (wave & 1) + i; f32x4 s = (f32x4){0.f, 0.f, 0.f, 0.f};
              if (sb <= cb) {
#pragma unroll
                  for (int ks = 0; ks < 4; ++ks) { const bf16x8 qa = *(const LAS bf16x8*)(lds + GC_QD + (cb * 16 + li) * 272 + (ks * 32 + 8 * g) * 2), kb = *(const LAS bf16x8*)(lds + GC_KI + (sb * 16 + li) * 272 + (ks * 32 + 8 * g) * 2);
                      s = mfma16(qa, kb, s); } }
#pragma unroll
              for (int r = 0; r < 4; ++r) { const int c = cb * 16 + 4 * g + r, sc = sb * 16 + li; *(LAS bf16_t*)(lds + GC_ATT + c * 144 + sc * 2) = f2bf(sc <= c ? s[r] : 0.f); } } }
        __syncthreads();
        f32x4 acc[4][2];
#pragma unroll
        for (int cb = 0; cb < 4; ++cb)
#pragma unroll
            for (int i = 0; i < 2; ++i) acc[cb][i] = (f32x4){0.f, 0.f, 0.f, 0.f};
#pragma unroll
        for (int ks = 0; ks < 2; ++ks) { bf16x8 vf[2];
#pragma unroll
            for (int i = 0; i < 2; ++i) { const LAS unsigned char* p = lds + GC_V + (ks * 32 + 8 * g + (li >> 2)) * 528 + ((wave * 2 + i) * 16 + 4 * (li & 3)) * 2; vf[i] = cat8(vtr(p), vtr(p + 4 * 528)); }
#pragma unroll
            for (int cb = 0; cb < 4; ++cb) { const bf16x8 af = *(const LAS bf16x8*)(lds + GC_ATT + (cb * 16 + li) * 144 + (ks * 32 + 8 * g) * 2);
#pragma unroll
                for (int i = 0; i < 2; ++i) acc[cb][i] = mfma16(af, vf[i], acc[cb][i]); } }
#pragma unroll
        for (int ks = 0; ks < 4; ++ks)
#pragma unroll
            for (int cb = 0; cb < 4; ++cb) { const bf16x8 qa = *(const LAS bf16x8*)(lds + GC_QD + (cb * 16 + li) * 272 + (ks * 32 + 8 * g) * 2);
#pragma unroll
                for (int i = 0; i < 2; ++i) acc[cb][i] = mfma16(qa, sf[i][ks], acc[cb][i]); }
        LAS float* ss = (LAS float*)(lds + GC_SS);
#pragma unroll
        for (int cb = 0; cb < 4; ++cb)
#pragma unroll
            for (int r = 0; r < 4; ++r) { float q = acc[cb][0][r] * acc[cb][0][r] + acc[cb][1][r] * acc[cb][1][r];
                q += __shfl_xor(q, 1); q += __shfl_xor(q, 2); q += __shfl_xor(q, 4); q += __shfl_xor(q, 8);
                if (li == 0) ss[(cb * 16 + 4 * g + r) * 8 + wave] = q; }
        __syncthreads();
        LAS float* ost = (LAS float*)(lds + GC_OST);
#pragma unroll
        for (int cb = 0; cb < 4; ++cb)
#pragma unroll
            for (int r = 0; r < 4; ++r) { const int c = cb * 16 + 4 * g + r; const f32x4 s0 = *(const LAS f32x4*)(ss + c * 8), s1 = *(const LAS f32x4*)(ss + c * 8 + 4);
                const float rstd = rsqrtf(((s0.x + s0.y) + (s0.z + s0.w) + (s1.x + s1.y) + (s1.z + s1.w)) * (1.f / 256.f) + EPS);
#pragma unroll
                for (int i = 0; i < 2; ++i) ost[c * 260 + (wave * 2 + i) * 16 + li] = acc[cb][i][r] * rstd; }
        __syncthreads();
        const float* ng = a->in[I_GNG] + l * 256;
#pragma unroll
        for (int i = 0; i < 4; ++i) { const int idx = tid + i * 512, c = idx >> 5, e8 = idx & 31;
            const f32x4 o0 = *(const LAS f32x4*)(ost + c * 260 + e8 * 8), o1 = *(const LAS f32x4*)(ost + c * 260 + e8 * 8 + 4);
            const f32x4 n0 = *(const f32x4*)(ng + e8 * 8), n1 = *(const f32x4*)(ng + e8 * 8 + 4);
            const u32x4 gg = *(const u32x4*)(P + (size_t)(t0 + c) * DINP + C_GG + h * 256 + e8 * 8);
            u32x4 pk;
            pk.x = cvt_pk_bf16(o0.x * n0.x * silu(bflo(gg.x)), o0.y * n0.y * silu(bfhi(gg.x))); pk.y = cvt_pk_bf16(o0.z * n0.z * silu(bflo(gg.y)), o0.w * n0.w * silu(bfhi(gg.y)));
            pk.z = cvt_pk_bf16(o1.x * n1.x * silu(bflo(gg.z)), o1.y * n1.y * silu(bfhi(gg.z))); pk.w = cvt_pk_bf16(o1.z * n1.z * silu(bflo(gg.w)), o1.w * n1.w * silu(bfhi(gg.w)));
            *(u32x4*)(mix + (size_t)(t0 + c) * DM + M_GLA + h * 256 + e8 * 8) = pk; }
    }
    __syncthreads();
}

constexpr int FX_F = 0, FX_K = 8192, FX_V = FX_K + 128 * 272, FX_BUF = 2 * 128 * 272, FX_MG = FX_K + FX_BUF  , FX_WS = FX_K + 2 * FX_BUF, FX_END = FX_WS + 64;
static_assert(FX_END <= MISC_OFF, "FoX LDS");
__device__ __forceinline__ void fox_phase(ArgP a, LAS unsigned char* lds, int l) {
    const int tid = opaque_tid(), lane = tid & 63, wave = tid >> 6, g = lane >> 4, li = lane & 15, gk = wave >> 2, qw = wave & 3;
    const bf16_t* P = (const bf16_t*)(a->ws + WS_P); bf16_t* mix = (bf16_t*)(a->ws + WS_MIX);
    LAS float* Fs = (LAS float*)(lds + FX_F); LAS float* wsum = (LAS float*)(lds + FX_WS);
    constexpr float C1 = 0.08838834764831845f * LOG2E;
    for (int pr = blockIdx.x; pr < 256; pr += gridDim.x) {
        const int bh = pr & 15, b = bh >> 2, h = bh & 3, rr = pr >> 4;
        __syncthreads();
        { const float fb = a->in[I_FFB][l * 4 + h]; float v[4]; float run = 0.f;
#pragma unroll
          for (int j = 0; j < 4; ++j) { run += log_sigmoid(bf2f(P[(size_t)(b * SEQ + tid * 4 + j) * DINP + C_FF + h]) + fb); v[j] = run; }
          float inc = run;
#pragma unroll
          for (int o = 1; o < 64; o <<= 1) { const float t = __shfl_up(inc, o); if (lane >= o) inc += t; }
          if (lane == 63) wsum[wave] = inc;
          __syncthreads();
          float pre = inc - run;
#pragma unroll
          for (int q = 0; q < 8; ++q) pre += (q < wave) ? wsum[q] : 0.f;
          *(LAS f32x4*)(Fs + tid * 4) = (f32x4){(v[0] + pre) * LOG2E, (v[1] + pre) * LOG2E, (v[2] + pre) * LOG2E, (v[3] + pre) * LOG2E}; }
        __syncthreads();
#pragma unroll 1
        for (int half = 0; half < 2; ++half) {
            const int qb = half == 0 ? 31 - rr : rr, q0 = qb * 64, qrow = q0 + qw * 16 + li, nsteps = (qb + 2) >> 1;
            bf16x8 qf[4];
#pragma unroll
            for (int ks = 0; ks < 4; ++ks) qf[ks] = *(const bf16x8*)(P + (size_t)(b * SEQ + qrow) * DINP + C_FQ + h * 128 + ks * 32 + 8 * g);
            const float Fq = Fs[qrow];
            float m = -1e30f, lsum = 0.f; f32x4 O[8];
#pragma unroll
            for (int j = 0; j < 8; ++j) O[j] = (f32x4){0.f, 0.f, 0.f, 0.f};
            u32x4 kreg[4], vreg[4];
#pragma unroll
            for (int i = 0; i < 4; ++i) { const int idx = tid + i * 512, key = idx >> 4, d8 = idx & 15; const bf16_t* src = P + (size_t)(b * SEQ + key) * DINP + h * 128 + d8 * 8;
                kreg[i] = *(const u32x4*)(src + C_FK); vreg[i] = *(const u32x4*)(src + C_FV); }
            __syncthreads();
#pragma unroll
            for (int i = 0; i < 4; ++i) { const int idx = tid + i * 512, key = idx >> 4, d8 = idx & 15;
                *(LAS u32x4*)(lds + FX_K + key * 272 + d8 * 16) = kreg[i]; *(LAS u32x4*)(lds + FX_V + key * 272 + d8 * 16) = vreg[i]; }
            __syncthreads();
            if (1 < nsteps) {
#pragma unroll
                for (int i = 0; i < 4; ++i) { const int idx = tid + i * 512, key = idx >> 4, d8 = idx & 15; const bf16_t* src = P + (size_t)(b * SEQ + 128 + key) * DINP + h * 128 + d8 * 8;
                    kreg[i] = *(const u32x4*)(src + C_FK); vreg[i] = *(const u32x4*)(src + C_FV); } }
#pragma unroll 1
            for (int st = 0; st < nsteps; ++st) {
                const int kb0 = st * 128, bo = (st & 1) * FX_BUF;
                const int kw0 = kb0 + 64 * gk;
                if (kw0 <= q0 + qw * 16 + 15) {
                    f32x4 s[4];
#pragma unroll
                    for (int kb = 0; kb < 4; ++kb) { s[kb] = (f32x4){0.f, 0.f, 0.f, 0.f};
#pragma unroll
                        for (int ks = 0; ks < 4; ++ks) { const bf16x8 kf = *(const LAS bf16x8*)(lds + bo + FX_K + (64 * gk + kb * 16 + li) * 272 + (ks * 32 + 8 * g) * 2); s[kb] = mfma16(kf, qf[ks], s[kb]); } }
                    const bool diag = (kw0 + 63 > q0 + qw * 16);
                    float mx = -__builtin_inff();
#pragma unroll
                    for (int kb = 0; kb < 4; ++kb) { const int key0 = kw0 + kb * 16 + 4 * g; const f32x4 fk = *(const LAS f32x4*)(Fs + key0);
#pragma unroll
                        for (int r = 0; r < 4; ++r) s[kb][r] = s[kb][r] * C1 + (Fq - fk[r]); }
                    if (diag) {
#pragma unroll
                        for (int kb = 0; kb < 4; ++kb)
#pragma unroll
                            for (int r = 0; r < 4; ++r) if (kw0 + kb * 16 + 4 * g + r > qrow) s[kb][r] = -__builtin_inff(); }
#pragma unroll
                    for (int kb = 0; kb < 4; ++kb) mx = fmaxf(mx, fmaxf(fmaxf(s[kb][0], s[kb][1]), fmaxf(s[kb][2], s[kb][3])));
                    mx = fmaxf(mx, __shfl_xor(mx, 16)); mx = fmaxf(mx, __shfl_xor(mx, 32));
                    const float mn = fmaxf(m, mx), alpha = __builtin_amdgcn_exp2f(m - mn); m = mn;
                    const bool resc = !__all(alpha == 1.f);
                    float ps = 0.f; bf16x8 pf[2];
#pragma unroll
                    for (int kk = 0; kk < 2; ++kk) { float p[8];
#pragma unroll
                        for (int r = 0; r < 4; ++r) { p[r] = __builtin_amdgcn_exp2f(s[2 * kk][r] - mn); p[4 + r] = __builtin_amdgcn_exp2f(s[2 * kk + 1][r] - mn); }
#pragma unroll
                        for (int r = 0; r < 8; ++r) ps += p[r];
                        u32x4 w; w.x = cvt_pk_bf16(p[0], p[1]); w.y = cvt_pk_bf16(p[2], p[3]); w.z = cvt_pk_bf16(p[4], p[5]); w.w = cvt_pk_bf16(p[6], p[7]); pf[kk] = __builtin_bit_cast(bf16x8, w); }
                    lsum = lsum * alpha + ps;
                    if (resc) {
#pragma unroll
                        for (int db = 0; db < 8; ++db) O[db] = O[db] * alpha; }
#pragma unroll
                    for (int db = 0; db < 8; ++db) {
#pragma unroll
                        for (int kk = 0; kk < 2; ++kk) { const LAS unsigned char* p = lds + bo + FX_V + (64 * gk + kk * 32 + 4 * g + (li >> 2)) * 272 + (db * 16 + 4 * (li & 3)) * 2;
                            O[db] = mfma16(cat8(vtr(p), vtr(p + 16 * 272)), pf[kk], O[db]); } }
                }
                if (st + 1 < nsteps) { const int bn = ((st + 1) & 1) * FX_BUF;
#pragma unroll
                    for (int i = 0; i < 4; ++i) { const int idx = tid + i * 512, key = idx >> 4, d8 = idx & 15;
                        *(LAS u32x4*)(lds + bn + FX_K + key * 272 + d8 * 16) = kreg[i]; *(LAS u32x4*)(lds + bn + FX_V + key * 272 + d8 * 16) = vreg[i]; } }
                __syncthreads();
                if (st + 2 < nsteps) {
#pragma unroll
                    for (int i = 0; i < 4; ++i) { const int idx = tid + i * 512, key = idx >> 4, d8 = idx & 15; const bf16_t* src = P + (size_t)(b * SEQ + kb0 + 256 + key) * DINP + h * 128 + d8 * 8;
                        kreg[i] = *(const u32x4*)(src + C_FK); vreg[i] = *(const u32x4*)(src + C_FV); } }
            }
            lsum += __shfl_xor(lsum, 16); lsum += __shfl_xor(lsum, 32);
            LAS float* mg = (LAS float*)(lds + FX_MG) + (qw * 64 + lane) * 34;
            __syncthreads();
            if (gk == 1) { mg[0] = m; mg[1] = lsum;
#pragma unroll
                for (int db = 0; db < 8; ++db)
#pragma unroll
                    for (int r = 0; r < 4; ++r) mg[2 + db * 4 + r] = O[db][r]; }
            __syncthreads();
            if (gk == 0) { const float m1 = mg[0], l1 = mg[1], mn = fmaxf(m, m1), a0 = __builtin_amdgcn_exp2f(m - mn), a1 = __builtin_amdgcn_exp2f(m1 - mn); const float inv = 1.f / (lsum * a0 + l1 * a1);
                bf16_t* orow = mix + (size_t)(b * SEQ + qrow) * DM + M_FOX + h * 128 + 4 * g;
#pragma unroll
                for (int db = 0; db < 8; ++db) { float o[4];
#pragma unroll
                    for (int r = 0; r < 4; ++r) o[r] = (O[db][r] * a0 + mg[2 + db * 4 + r] * a1) * inv;
                    u32x2 w; w.x = cvt_pk_bf16(o[0], o[1]); w.y = cvt_pk_bf16(o[2], o[3]); *(u32x2*)(orow + db * 16) = w; } }
        }
    }
    __syncthreads();
}

constexpr int RT_RS = 0, RT_PART = 256, RT_END = RT_PART + 8 * 32 * 48 * 4;
__device__ __forceinline__ void router_phase(ArgP a, LAS unsigned char* lds, int l, const bf16_t* x1) {
    const int tid = opaque_tid(), lane = tid & 63, wave = tid >> 6, g = lane >> 4, li = lane & 15;
    LAS float* rsd = (LAS float*)(lds + RT_RS); LAS float* part = (LAS float*)(lds + RT_PART);
    const float* g2 = a->in[I_N2G] + l * DM; bf16_t* h2 = (bf16_t*)(a->ws + WS_H);
    const bf16_t* wr = (const bf16_t*)(a->ws + WS_WR) + (size_t)l * 2 * 48 * DM;
    unsigned* cnt = (unsigned*)(a->ws + WS_CTL) + CW_CNT + l * 32 * 64; int* list = (int*)(a->ws + WS_LIST); float* gwb = (float*)(a->ws + WS_GW);
    for (int item = blockIdx.x; item < T / 32; item += gridDim.x) {
        const int tk0 = item * 32;
        __syncthreads();
        { u32x4 q[4][4];
#pragma unroll
          for (int r = 0; r < 4; ++r)
#pragma unroll
              for (int j = 0; j < 4; ++j) q[r][j] = ((const u32x4*)(x1 + (size_t)(tk0 + wave * 4 + r) * DM) + lane)[64 * j];
          f32x4 ga[4], gb[4];
#pragma unroll
          for (int j = 0; j < 4; ++j) { ga[j] = ((const f32x4*)g2)[2 * (lane + 64 * j)]; gb[j] = ((const f32x4*)g2)[2 * (lane + 64 * j) + 1]; }
#pragma unroll
          for (int r = 0; r < 4; ++r) { const int row = wave * 4 + r; float s = 0.f;
#pragma unroll
              for (int j = 0; j < 4; ++j) { const u32x4 w = q[r][j]; s += (bflo(w.x) * bflo(w.x) + bfhi(w.x) * bfhi(w.x)) + (bflo(w.y) * bflo(w.y) + bfhi(w.y) * bfhi(w.y)) + (bflo(w.z) * bflo(w.z) + bfhi(w.z) * bfhi(w.z)) + (bflo(w.w) * bflo(w.w) + bfhi(w.w) * bfhi(w.w)); }
              const float rstd = rsqrtf(wave_sum(s) * (1.f / DM) + EPS);
              if (lane == 0) rsd[row] = rstd;
              u32x4* o = (u32x4*)(h2 + (size_t)(tk0 + row) * DM) + lane;
#pragma unroll
              for (int j = 0; j < 4; ++j) { const u32x4 x = q[r][j]; u32x4 w;
                  w.x = cvt_pk_bf16(bflo(x.x) * rstd * ga[j].x, bfhi(x.x) * rstd * ga[j].y); w.y = cvt_pk_bf16(bflo(x.y) * rstd * ga[j].z, bfhi(x.y) * rstd * ga[j].w);
                  w.z = cvt_pk_bf16(bflo(x.z) * rstd * gb[j].x, bfhi(x.z) * rstd * gb[j].y); w.w = cvt_pk_bf16(bflo(x.w) * rstd * gb[j].z, bfhi(x.w) * rstd * gb[j].w); o[64 * j] = w; } } }
        __syncthreads();
        { const int kq = wave;
          f32x4 acc[2][3];
#pragma unroll
          for (int mb = 0; mb < 2; ++mb)
#pragma unroll
              for (int cb = 0; cb < 3; ++cb) acc[mb][cb] = (f32x4){0.f, 0.f, 0.f, 0.f};
          const bf16_t* xrow = x1 + (size_t)(tk0 + li) * DM + kq * 256 + 8 * g; const bf16_t* wq = wr + kq * 256 + 8 * g;
#pragma unroll 2
          for (int ks = 0; ks < 8; ++ks) {
              const bf16x8 ax0 = *(const bf16x8*)(xrow + ks * 32), ax1 = *(const bf16x8*)(xrow + (size_t)16 * DM + ks * 32);
#pragma unroll
              for (int cb = 0; cb < 3; ++cb) { const bf16x8 wh = *(const bf16x8*)(wq + (size_t)(cb * 16 + li) * DM + ks * 32), wl = *(const bf16x8*)(wq + (size_t)(48 + cb * 16 + li) * DM + ks * 32);
                  acc[0][cb] = mfma16(ax0, wh, acc[0][cb]); acc[0][cb] = mfma16(ax0, wl, acc[0][cb]); acc[1][cb] = mfma16(ax1, wh, acc[1][cb]); acc[1][cb] = mfma16(ax1, wl, acc[1][cb]); }
          }
#pragma unroll
          for (int mb = 0; mb < 2; ++mb)
#pragma unroll
              for (int cb = 0; cb < 3; ++cb)
#pragma unroll
                  for (int r = 0; r < 4; ++r) part[(kq * 32 + mb * 16 + 4 * g + r) * 48 + cb * 16 + li] = acc[mb][cb][r] * rsd[mb * 16 + 4 * g + r]; }
        __syncthreads();
        if (tid < 32) {
            const int tok = tk0 + tid; float lg[36];
#pragma unroll
            for (int c = 0; c < 36; ++c) lg[c] = 0.f;
#pragma unroll 1
            for (int q = 0; q < 8; ++q) {
#pragma unroll
                for (int c = 0; c < 36; ++c) lg[c] += part[(q * 32 + tid) * 48 + c]; }
            float gl[4]; int grp = 0; float gmx;
#pragma unroll
            for (int c = 0; c < 4; ++c) gl[c] = lg[c] + a->in[I_RGB][l * 4 + c];
            gmx = gl[0];
#pragma unroll
            for (int c = 1; c < 4; ++c) if (gl[c] > gmx) { gmx = gl[c]; grp = c; }
            float den = 0.f;
#pragma unroll
            for (int c = 0; c < 4; ++c) den += __expf(gl[c] - gmx);
            const float ptop = 1.f / den;
            float v1 = -__builtin_inff(), v2 = -__builtin_inff(); int i1 = 0, i2 = 0;
#pragma unroll
            for (int e = 0; e < 8; ++e) { float ev = 0.f;
#pragma unroll
                for (int q = 0; q < 4; ++q) ev = (grp == q) ? lg[4 + q * 8 + e] : ev;
                const float v = ev + a->in[I_REB][(l * 4 + grp) * 8 + e];
                if (v > v1) { v2 = v1; i2 = i1; v1 = v; i1 = e; } else if (v > v2) { v2 = v; i2 = e; } }
            const float w1 = ptop / (1.f + __expf(v2 - v1)), w2 = ptop - w1;
            const int E1 = grp * 8 + i1, E2 = grp * 8 + i2;
            const unsigned s1 = atomicAdd(cnt + E1 * 64, 1u), s2 = atomicAdd(cnt + E2 * 64, 1u);
            list[E1 * CAPE + s1] = tok * 2; gwb[E1 * CAPE + s1] = w1;
            list[E2 * CAPE + s2] = tok * 2 + 1; gwb[E2 * CAPE + s2] = w2;
        }
    }
    __syncthreads();
}
__device__ __forceinline__ void moe_setup(ArgP a, LAS int* tab, int l) {
    __syncthreads();
    if (threadIdx.x < 32) { unsigned* cnt = (unsigned*)(a->ws + WS_CTL) + CW_CNT + l * 32 * 64; tab[33 + threadIdx.x] = (int)__hip_atomic_load(cnt + threadIdx.x * 64, __ATOMIC_RELAXED, __HIP_MEMORY_SCOPE_AGENT); }
    __syncthreads();
    if (threadIdx.x == 0) { int ts = 0; for (int e = 0; e < 32; ++e) { tab[e] = ts; tab[65 + e] = ts * 256; ts += (tab[33 + e] + 255) >> 8; } tab[32] = ts; }
    __syncthreads();
}
__device__ __forceinline__ void combine_phase(ArgP a, int l, const bf16_t* x1, bf16_t* x2) {
    const int tid = opaque_tid(), lane = tid & 63, wave = tid >> 6;
    const int gw = blockIdx.x * NWAVES + wave, NGW = gridDim.x * NWAVES;
    const bf16_t* Y = (const bf16_t*)(a->ws + WS_Y);
    const float* g = (l + 1 < DEPTH) ? a->in[I_N1G] + (l + 1) * DM : a->in[I_FNG];
    u32x2 rx[8], ry0[8], ry1[8];
#define CB_LOAD(m_) do { const u32x2* xr = (const u32x2*)(x1 + (size_t)(m_) * DM) + lane; const u32x2* y0 = (const u32x2*)(Y + (size_t)(2 * (m_)) * DM) + lane; const u32x2* y1 = (const u32x2*)(Y + (size_t)(2 * (m_) + 1) * DM) + lane; \
        _Pragma("unroll") for (int j = 0; j < 8; ++j) { rx[j] = xr[64 * j]; ry0[j] = y0[64 * j]; ry1[j] = y1[64 * j]; } } while (0)
    if (gw < T) CB_LOAD(gw);
    for (int m = gw; m < T; m += NGW) {
        f32x4 v[8]; float s = 0.f;
#pragma unroll
        for (int j = 0; j < 8; ++j) { const u32x2 xx = rx[j], a0 = ry0[j], a1 = ry1[j];
            v[j] = (f32x4){bflo(xx.x) + (bflo(a0.x) + bflo(a1.x)), bfhi(xx.x) + (bfhi(a0.x) + bfhi(a1.x)), bflo(xx.y) + (bflo(a0.y) + bflo(a1.y)), bfhi(xx.y) + (bfhi(a0.y) + bfhi(a1.y))};
            s += (v[j].x * v[j].x + v[j].y * v[j].y) + (v[j].z * v[j].z + v[j].w * v[j].w); }
        if (m + NGW < T) CB_LOAD(m + NGW);
        const float rstd = rsqrtf(wave_sum(s) * (1.f / DM) + EPS);
        if (l + 1 < DEPTH) {
            u32x2* xo = (u32x2*)(x2 + (size_t)m * DM) + lane; u32x2* o = (u32x2*)((bf16_t*)(a->ws + WS_H) + (size_t)m * DM) + lane;
#pragma unroll
            for (int j = 0; j < 8; ++j) { u32x2 xw; xw.x = cvt_pk_bf16(v[j].x, v[j].y); xw.y = cvt_pk_bf16(v[j].z, v[j].w); xo[64 * j] = xw;
                const f32x4 gg = ((const f32x4*)g)[lane + 64 * j]; u32x2 w; w.x = cvt_pk_bf16(v[j].x * rstd * gg.x, v[j].y * rstd * gg.y); w.y = cvt_pk_bf16(v[j].z * rstd * gg.z, v[j].w * rstd * gg.w); o[64 * j] = w; }
        } else {
            f32x4* oo = (f32x4*)(a->out + (size_t)m * DM) + lane;
#pragma unroll
            for (int j = 0; j < 8; ++j) { const f32x4 gg = ((const f32x4*)g)[lane + 64 * j]; oo[64 * j] = (f32x4){v[j].x * rstd * gg.x, v[j].y * rstd * gg.y, v[j].z * rstd * gg.z, v[j].w * rstd * gg.w}; }
        }
    }
}

constexpr int PH_PER_LAYER = 9, N_PHASES = 1 + DEPTH * PH_PER_LAYER;
#ifndef PH_MASK
#define PH_MASK 0x3ff
#endif
__global__ void __launch_bounds__(NTHR, 2) fwd(Args) {
    extern __shared__ __attribute__((aligned(16))) unsigned char lds_raw[];
    LAS unsigned char* lds = (LAS unsigned char*)lds_raw;
    volatile LAS unsigned* MISC = (volatile LAS unsigned*)(lds + MISC_OFF);
    LAS int* tab = (LAS int*)(lds + MISC_OFF + 64);
    if (threadIdx.x < 256) MISC[threadIdx.x] = 0u;
    __syncthreads();
    int lo, hi; XcdBarrier bar;
    { ArgP a = kargs(); lo = a->ph_lo; hi = a->ph_hi; bar.bar = (unsigned*)(a->ws + WS_CTL) + CW_BAR; bar.x = 0; bar.st = nullptr;
      if (!MK_PER_PHASE) bar = xcd_barrier_post((unsigned*)(a->ws + WS_CTL) + CW_BAR, MISC); }
#define IN(k) (lo <= (k) && (k) < hi)
#define EN(j) ((PH_MASK >> (j)) & 1)
#ifndef REP_MASK
#define REP_MASK 0
#endif
#define REP(j) for (int _rep = 0; _rep < 1 + ((REP_MASK >> (j)) & 1); ++_rep)
#define SEAM(k) do { if (!MK_PER_PHASE && IN(k) && IN((k) + 1)) xcd_barrier(bar); } while (0)
    if (EN(0) && IN(0)) REP(0) { p0_prologue(kargs(), lds); __syncthreads(); }
    SEAM(0);
#pragma unroll 1
    for (int l = 0; l < DEPTH; ++l) {
        const int p0 = 1 + l * PH_PER_LAYER;
        if (EN(1) && IN(p0 + 0)) REP(1) { ArgP a = kargs();
            pg::DenseSched<DM> S; S.init((const bf16_t*)(a->ws + WS_WIN) + (size_t)l * DINP * DM, T, DINP, gridDim.x, blockIdx.x);
            pg::EpiBf16 E{(bf16_t*)(a->ws + WS_P), DINP};
            pg::gemm_phase<DM, pg::EpiBf16, pg::DenseSched<DM>>(lds, (const char*)(a->ws + WS_H), S, E);
            if (l == 0) { int rk, nr; idle_rank((T / 256) * (DINP / 256), gridDim.x, blockIdx.x, rk, nr); if (rk >= 0) cvt_range(kargs(), lds, CV_N_IN, CV_I_OUT, rk, nr); __syncthreads(); }
        }
        SEAM(p0 + 0);
        if (EN(2) && IN(p0 + 1)) { REP(2) conv_phase(kargs(), lds, l); REP(10) gla_a_phase(kargs(), lds, l); }
        SEAM(p0 + 1);
        if (EN(3) && IN(p0 + 2)) { gla_b_phase(kargs()); REP(3) fox_phase(kargs(), lds, l); }
        SEAM(p0 + 2);
        if (EN(4) && IN(p0 + 3)) REP(4) { gla_c_phase(kargs(), lds, l); }
        SEAM(p0 + 3);
        if (EN(5) && IN(p0 + 4)) REP(5) { ArgP a = kargs();
            pg::DenseSched<DM> S; S.init((const bf16_t*)(a->ws + WS_WOUT) + (size_t)l * DM * DM, T, DM, gridDim.x, blockIdx.x);
            pg::EpiRes E{(const bf16_t*)(a->ws + WS_XB), (bf16_t*)(a->ws + WS_XA), DM};
            pg::gemm_phase<DM, pg::EpiRes, pg::DenseSched<DM>>(lds, (const char*)(a->ws + WS_MIX), S, E);
        }
        SEAM(p0 + 4);
        if (EN(6) && IN(p0 + 5)) { ArgP a = kargs(); router_phase(a, lds, l, (const bf16_t*)(a->ws + WS_XA)); }
        SEAM(p0 + 5);
        if (EN(7) && IN(p0 + 6)) REP(7) { ArgP a = kargs();
            moe_setup(a, tab, l);
            const int vcu = (gridDim.x % 8 == 0) ? (int)((blockIdx.x % 8) * (gridDim.x / 8) + blockIdx.x / 8) : (int)blockIdx.x;
            pg::MoeSchedRB<DM, 8, true> S{a->in[I_WG] + (size_t)l * NEX * DM * DE, a->in[I_WU] + (size_t)l * NEX * DM * DE, tab, (const int*)(a->ws + WS_LIST), (int)gridDim.x, vcu};
#ifndef RBP
#define RBP 0
#endif
            pg::EpiGateUpRB E{(bf16_t*)(a->ws + (_rep ? WS_WGU : WS_HB)), (const float*)(a->ws + WS_GW)};
            pg::gemm_rb<DM, DE, pg::EpiGateUpRB, pg::MoeSchedRB<DM, 8, true>>(lds, (const char*)(a->ws + WS_H), S, E);
            if (l == 0) { int rk, nr; idle_rank(tab[32] * 8, gridDim.x, vcu, rk, nr); if (rk >= 0) { cvt_range(kargs(), lds, CV_I_IN, CV_I_IN, rk, nr); cvt_range(kargs(), lds, CV_N_IN + CV_I_OUT, CV_I_OUT, rk, nr); } __syncthreads(); }
        }
        SEAM(p0 + 6);
        if (EN(8) && IN(p0 + 7)) REP(8) { ArgP a = kargs();
            moe_setup(a, tab, l);
            const int vcu = (gridDim.x % 8 == 0) ? (int)((blockIdx.x % 8) * (gridDim.x / 8) + blockIdx.x / 8) : (int)blockIdx.x;
            pg::MoeSchedRB<DE, 16, false> S{a->in[I_WD] + (size_t)l * NEX * DE * DM, nullptr, tab, (const int*)(a->ws + WS_LIST), (int)gridDim.x, vcu};
            pg::EpiDownRB E{(bf16_t*)(a->ws + WS_Y), (const int*)(a->ws + WS_LIST)};
            pg::gemm_rb<DE, DM, pg::EpiDownRB, pg::MoeSchedRB<DE, 16, false>>(lds, (const char*)(a->ws + WS_HB), S, E);
        }
        SEAM(p0 + 7);
        if (EN(9) && IN(p0 + 8)) REP(9) { ArgP a = kargs(); combine_phase(a, l, (const bf16_t*)(a->ws + WS_XA), (bf16_t*)(a->ws + WS_XB)); }
        SEAM(p0 + 8);
    }
#undef IN
#undef EN
#undef SEAM
}

#ifdef DBG_STAGE
__global__ void dbg_dump(const unsigned char* ws, float* out, int kind) {
    for (size_t i = (size_t)blockIdx.x * blockDim.x + threadIdx.x; i < (size_t)T * DM; i += (size_t)gridDim.x * blockDim.x) {
        const size_t r = i / DM, c = i % DM; float v = 0.f;
        if (kind == 1) v = bf2f(((const bf16_t*)(ws + WS_P))[r * DINP + 2048 + c]);
        else if (kind == 2) v = bf2f(((const bf16_t*)(ws + WS_MIX))[i]);
        else if (kind == 7) v = c < 512 ? bf2f(((const bf16_t*)(ws + WS_MIX))[i]) : 0.f;
        else if (kind == 8) v = (c >= 512 && c < 1536) ? bf2f(((const bf16_t*)(ws + WS_MIX))[i]) : 0.f;
        else if (kind == 9) v = c >= 1536 ? bf2f(((const bf16_t*)(ws + WS_MIX))[i]) : 0.f;
        else if (kind == 10 || kind == 11) v = bf2f(((const bf16_t*)(ws + WS_KV))[i]);
        else if (kind == 12) v = ((const float*)(ws + WS_DEC))[i & 65535];
        else if (kind == 13) v = bf2f(((const bf16_t*)(ws + WS_P))[r * DINP + c]);
        else if (kind == 14) v = bf2f(((const bf16_t*)(ws + WS_P))[r * DINP + 3840 + c]);
        else if (kind == 3) v = bf2f(((const bf16_t*)(ws + WS_XA))[i]);
        else if (kind == 4) v = bf2f(((const bf16_t*)(ws + WS_XB))[i]);
        else if (kind == 5) v = bf2f(((const bf16_t*)(ws + WS_H))[i]);
        else if (kind == 6) v = ((const float*)(ws + WS_Y))[i] + ((const float*)(ws + WS_Y))[i + (size_t)T * DM];
        out[i] = v; }
}
#endif
extern "C" void kernel_launch(void* const* d_in, const int* in_sizes, int n_in, void* d_out, int out_size, void* d_ws, size_t ws_size, hipStream_t stream) {
    static int grid = 0;
    if (grid == 0) {
        if (n_in != 21 || ws_size < WS_END) { fprintf(stderr, "kernel_launch: need 21 inputs and %zu bytes of workspace (got %d, %zu)\n", (size_t)WS_END, n_in, ws_size); grid = -1; return; }
        int dev = 0, cus = 0, per_cu = 0;
        if (hipGetDevice(&dev) != hipSuccess || hipDeviceGetAttribute(&cus, hipDeviceAttributeMultiprocessorCount, dev) != hipSuccess) { grid = -1; return; }
        if (hipFuncSetAttribute((const void*)fwd, hipFuncAttributeMaxDynamicSharedMemorySize, LDS_BYTES) != hipSuccess) { fprintf(stderr, "kernel_launch: hipFuncSetAttribute failed\n"); grid = -1; return; }
        if (hipOccupancyMaxActiveBlocksPerMultiprocessor(&per_cu, (const void*)fwd, NTHR, LDS_BYTES) != hipSuccess || per_cu < 1) { fprintf(stderr, "kernel_launch: occupancy query says %d\n", per_cu); per_cu = 1; }
        (void)hipGetLastError();
        grid = cus;
    }
    if (grid < 0) return;
    (void)hipMemsetAsync((char*)d_ws + WS_CTL, 0, CTL_ZERO_BYTES, stream);
    Args a{};
    for (int i = 0; i < 21; ++i) a.in[i] = (const float*)d_in[i];
    a.out = (float*)d_out; a.ws = (unsigned char*)d_ws;
#ifdef DBG_STAGE
    { const int last[15] = {0, 1, 4, 5, 9, 6, 8, 4, 4, 4, 2, 3, 2, 1, 1}; for (int p = 0; p <= last[DBG_STAGE]; ++p) { a.ph_lo = p; a.ph_hi = p + 1; hipLaunchKernelGGL(fwd, dim3(grid), dim3(NTHR), LDS_BYTES, stream, a); }
      hipLaunchKernelGGL(dbg_dump, dim3(2048), dim3(256), 0, stream, (const unsigned char*)d_ws, (float*)d_out, DBG_STAGE); }
#elif MK_PER_PHASE
    for (int p = 0; p < N_PHASES; ++p) { a.ph_lo = p; a.ph_hi = p + 1; hipLaunchKernelGGL(fwd, dim3(grid), dim3(NTHR), LDS_BYTES, stream, a); }
#else
    a.ph_lo = 0; a.ph_hi = N_PHASES; hipLaunchKernelGGL(fwd, dim3(grid), dim3(NTHR), LDS_BYTES, stream, a);
#endif
}
```

```cpp
#include <hip/hip_runtime.h>
#include <cstdio>
#include <cstdint>

#ifndef MK_PER_PHASE
#define MK_PER_PHASE 0
#endif

#define LAS __attribute__((address_space(3)))
#define GAS __attribute__((address_space(1)))
typedef unsigned short bf16_t;
typedef short bf16x8 __attribute__((ext_vector_type(8)));
typedef short s16x4 __attribute__((ext_vector_type(4)));
typedef short v4i16_t __attribute__((ext_vector_type(4)));
typedef float f32x4 __attribute__((ext_vector_type(4)));
typedef float f32x2 __attribute__((ext_vector_type(2)));
typedef unsigned u32x4 __attribute__((ext_vector_type(4)));
typedef unsigned u32x2 __attribute__((ext_vector_type(2)));

constexpr int NB = 4, SEQ = 2048, T = NB * SEQ, DM = 2048, DEPTH = 2;
constexpr int DIN = 5652, DINP = 5888;
constexpr int C_CA = 0, C_CG = 512, C_GQ = 1024, C_GK = 1536, C_GV = 2048, C_GG = 3072, C_GLOW = 4096, C_FQ = 4112, C_FK = 4624, C_FV = 5136, C_FF = 5648;
constexpr int M_CONV = 0, M_GLA = 512, M_FOX = 1536;
constexpr int NEX = 32, DE = 512, CAPE = 8192, HROWS = 16384 + 32 * 256;
constexpr float EPS = 1e-6f;
constexpr float LOG2E = 1.4426950408889634f;

constexpr size_t MiB = 1u << 20;
constexpr size_t WS_CTL = 0, CTL_ZERO_BYTES = 64 * 1024;
constexpr size_t WS_WIN = 1 * MiB;
constexpr size_t WS_WOUT = 48 * MiB;
constexpr size_t WS_WGU = 64 * MiB;
constexpr size_t WS_WD = 320 * MiB;
constexpr size_t WS_WR = 448 * MiB;
constexpr size_t WS_XA = 449 * MiB;
constexpr size_t WS_XB = 513 * MiB;
constexpr size_t WS_H = 577 * MiB;
constexpr size_t WS_P = 609 * MiB;
constexpr size_t WS_MIX = 701 * MiB;
constexpr size_t WS_KV = 733 * MiB;
constexpr size_t WS_DEC = 765 * MiB;
constexpr size_t WS_CUM = 64 * MiB;
constexpr size_t WS_LIST = 766 * MiB;
constexpr size_t WS_GW = 767 * MiB;
constexpr size_t WS_HB = 768 * MiB;
constexpr size_t WS_Y = 792 * MiB;
constexpr size_t WS_END = 920 * MiB;
constexpr int CW_BAR = 0;
constexpr int CW_CNT = 4096;

constexpr int LDS_BYTES = 163840, MISC_OFF = LDS_BYTES - 1024;
constexpr int NWAVES = 8, NTHR = 512;

typedef __bf16 bf2_t __attribute__((ext_vector_type(2)));
__device__ __forceinline__ unsigned cvt_pk_bf16(float lo, float hi) { const f32x2 v = {lo, hi}; return __builtin_bit_cast(unsigned, __builtin_convertvector(v, bf2_t)); }
__device__ __forceinline__ bf16_t f2bf(float f) { return __builtin_bit_cast(bf16_t, (__bf16)f); }
__device__ __forceinline__ float bf2f(bf16_t b) { return __uint_as_float(((unsigned)b) << 16); }
__device__ __forceinline__ float bflo(unsigned w) { return __uint_as_float(w << 16); }
__device__ __forceinline__ float bfhi(unsigned w) { return __uint_as_float(w & 0xffff0000u); }
__device__ __forceinline__ float wave_sum(float v) {
#pragma unroll
    for (int o = 1; o < 64; o <<= 1) v += __shfl_xor(v, o);
    return v;
}
__device__ __forceinline__ float log_sigmoid(float x) { return fminf(x, 0.f) - __logf(1.f + __expf(-fabsf(x))); }
__device__ __forceinline__ float silu(float x) { return x * __builtin_amdgcn_rcpf(1.f + __expf(-x)); }
__device__ __forceinline__ s16x4 vtr(const LAS void* p) { return __builtin_bit_cast(s16x4, __builtin_amdgcn_ds_read_tr16_b64_v4i16((LAS v4i16_t*)p)); }
__device__ __forceinline__ bf16x8 cat8(s16x4 a, s16x4 b) { bf16x8 r; r[0] = a[0]; r[1] = a[1]; r[2] = a[2]; r[3] = a[3]; r[4] = b[0]; r[5] = b[1]; r[6] = b[2]; r[7] = b[3]; return r; }
__device__ __forceinline__ f32x4 mfma16(bf16x8 a, bf16x8 b, f32x4 c) { return __builtin_amdgcn_mfma_f32_16x16x32_bf16(a, b, c, 0, 0, 0); }
__device__ __forceinline__ int opaque_tid() { int t = threadIdx.x; asm volatile("" : "+v"(t)); return t; }
#define LDS_WAIT() asm volatile("s_waitcnt lgkmcnt(0)" ::: "memory")
#define VM_WAIT() asm volatile("s_waitcnt vmcnt(0)" ::: "memory")

#define XB_TMO      128
#define XB_XCNT(j)  (256  + 64 * (j))
#define XB_XSUB(j)  (1280 + 64 * (j))
#define XB_XGEN(j)  (2304 + 64 * (j))
#define XB_TOP      3328
#define XB_TOPGEN   3392
#define XCD_BAR_WORDS 3456
#define XB_SPIN_CAP (1u << 18)
__device__ __forceinline__ unsigned xb_ld(unsigned* p)              { return __hip_atomic_load(p, __ATOMIC_RELAXED, __HIP_MEMORY_SCOPE_AGENT); }
__device__ __forceinline__ unsigned xb_add(unsigned* p, unsigned v) { return __hip_atomic_fetch_add(p, v, __ATOMIC_RELAXED, __HIP_MEMORY_SCOPE_AGENT); }
__device__ __forceinline__ unsigned xb_xcc_id() { return (unsigned)__builtin_amdgcn_s_getreg((3 << 11) | 20) & 0xFu; }
#define XB_SPIN(cond, bar) do { unsigned _sp = 0; while (cond) { __builtin_amdgcn_s_sleep(1); \
    if ((++_sp & 255u) == 0u) { if (xb_ld(&(bar)[XB_TMO])) break; if (_sp > XB_SPIN_CAP) { atomicAdd(&(bar)[XB_TMO], 1u); break; } } } } while (0)
struct XcdBarrier { unsigned* bar; unsigned x; volatile LAS unsigned* st; };
__device__ __forceinline__ XcdBarrier xcd_barrier_post(unsigned* bar, volatile LAS unsigned* st) {
    XcdBarrier b; b.bar = bar; b.x = xb_xcc_id(); b.st = st;
    if (threadIdx.x == 0) (void)xb_add(&bar[XB_XCNT(b.x)], 1u);
    return b;
}
__device__ __forceinline__ void xcd_barrier_complete(unsigned* bar, unsigned x, unsigned& nloc, unsigned& nx) {
    const unsigned G = gridDim.x * gridDim.y * gridDim.z;
    unsigned sum, cnt, mine, sp = 0u;
    for (;;) {
        sum = 0u; cnt = 0u; mine = 0u;
#pragma unroll
        for (unsigned j = 0; j < 16; ++j) { const unsigned c = xb_ld(&bar[XB_XCNT(j)]); sum += c; cnt += (c > 0u) ? 1u : 0u; mine = (j == x) ? c : mine; }
        if (sum == G) break;
        __builtin_amdgcn_s_sleep(1);
        if ((++sp & 255u) == 0u) { if (xb_ld(&bar[XB_TMO])) break; if (sp > XB_SPIN_CAP) { atomicAdd(&bar[XB_TMO], 1u); break; } }
    }
    nloc = mine > 0u ? mine : 1u; nx = cnt > 0u ? cnt : 1u;
}
__device__ __forceinline__ void xcd_barrier(const XcdBarrier& b) {
    asm volatile("s_waitcnt vmcnt(0)" ::: "memory");
    __syncthreads();
    if (threadIdx.x == 0) {
        unsigned* bar = b.bar;
        __builtin_amdgcn_s_waitcnt(0);
        unsigned nloc = b.st[0], nx = b.st[1];
        if (nloc == 0u) { xcd_barrier_complete(bar, b.x, nloc, nx); b.st[0] = nloc; b.st[1] = nx; }
        const unsigned old = xb_add(&bar[XB_XSUB(b.x)], 1u);
        const unsigned gen = old / nloc;
        if (old + 1u == (gen + 1u) * nloc) {
            __builtin_amdgcn_fence(__ATOMIC_RELEASE, "agent");
            asm volatile("s_waitcnt vmcnt(0)" ::: "memory");
            const unsigned og = xb_add(&bar[XB_TOP], 1u);
            const unsigned tg = og / nx;
            if (og + 1u == (tg + 1u) * nx) xb_add(&bar[XB_TOPGEN], 1u);
            else XB_SPIN(xb_ld(&bar[XB_TOPGEN]) == tg, bar);
            __builtin_amdgcn_fence(__ATOMIC_ACQUIRE, "agent");
            xb_add(&bar[XB_XGEN(b.x)], 1u);
            asm volatile("s_waitcnt vmcnt(0)" ::: "memory");
        } else {
            XB_SPIN(xb_ld(&bar[XB_XGEN(b.x)]) == gen, bar);
            __builtin_amdgcn_fence(__ATOMIC_ACQUIRE, "agent");
            asm volatile("s_waitcnt vmcnt(0)" ::: "memory");
        }
    }
    __syncthreads();
}

namespace pg {
constexpr int BM = 256, BK = 64, HALF = 128, HTB = HALF * BK * 2, STAGE_BYTES = 8 * HTB;
__host__ __device__ __forceinline__ int lds_byte(int r, int c) { const int st = (r >> 4) * 2 + (c >> 5), rr = r & 15, cc = c & 31, ob = rr * 64 + cc * 2; return st * 1024 + (ob ^ (((ob >> 9) & 1) << 5)); }
__host__ __device__ __forceinline__ void stage_rc(int b, int& R, int& C) { const int st = b / 1024, sb = b % 1024, swz = sb ^ (((sb >> 9) & 1) << 5); R = (st >> 1) * 16 + swz / 64; C = (st & 1) * 32 + (swz % 64) / 2; }
__host__ __device__ __forceinline__ int perm32(int rho) { const int n = rho >> 4, i = rho & 15; return 8 * (i >> 2) + 4 * n + (i & 3); }

template <int K, class Epi, class Sched>
__device__ __forceinline__ void gemm_phase(LAS unsigned char* lds, const char* Abase, const Sched& S, const Epi& E) {
    typedef typename Sched::Unit Unit;
    const int tid = opaque_tid(), wid = __builtin_amdgcn_readfirstlane(tid >> 6), lane = tid & 63, wr = wid >> 2, wc = wid & 3, fr = lane & 15, fq = lane >> 4;
    constexpr int nt = K / BK;
    unsigned voffB[2]; int Rr[2], Cb;
#pragma unroll
    for (int i = 0; i < 2; ++i) { int R, C; stage_rc(tid * 16 + i * 8192, R, C); const int Rb = Epi::PERM ? ((R & ~31) + perm32(R & 31)) : R;
        Rr[i] = R; Cb = C * 2; voffB[i] = (unsigned)(Rb * K + C) * 2u; }
    constexpr size_t kstep = (size_t)(BK * 2);
    constexpr size_t hstep = (size_t)HALF * K * 2;
    const unsigned ldsw = (unsigned)wid * 1024u;
    const int aoff = lds_byte(wr * 64 + fr, fq * 8), boff = lds_byte(wc * 32 + fr, fq * 8);
#define PG_SA(b, h) (((b) * 2 + (h)) * HTB)
#define PG_SB(b, h) ((4 + (b) * 2 + (h)) * HTB)
#define PG_STAGE(bufoff, gbase, voff) do { _Pragma("unroll") for (int _i = 0; _i < 2; ++_i) \
        __builtin_amdgcn_global_load_lds((const unsigned*)((const char*)(gbase) + (voff)[_i]), (LAS unsigned*)(lds + (bufoff) + ldsw + _i * 8192), 16, 0, 0); } while (0)
#define PG_LDA(dst, b, h) do { _Pragma("unroll") for (int m = 0; m < 4; ++m) _Pragma("unroll") for (int k = 0; k < 2; ++k) dst[m][k] = *(const LAS bf16x8*)(lds + PG_SA(b, h) + aoff + m * 2048 + k * 1024); } while (0)
#define PG_LDB(dst, b, h) do { _Pragma("unroll") for (int n = 0; n < 2; ++n) _Pragma("unroll") for (int k = 0; k < 2; ++k) dst[n][k] = *(const LAS bf16x8*)(lds + PG_SB(b, h) + boff + n * 2048 + k * 1024); } while (0)
#define PG_MMA(ai, bj, At, Bt) do { __builtin_amdgcn_s_setprio(1); _Pragma("unroll") for (int m = 0; m < 4; ++m) _Pragma("unroll") for (int n = 0; n < 2; ++n) _Pragma("unroll") for (int k = 0; k < 2; ++k) \
        acc[ai][bj][m][n] = __builtin_amdgcn_mfma_f32_16x16x32_bf16(Bt[n][k], At[m][k], acc[ai][bj][m][n], 0, 0, 0); __builtin_amdgcn_s_setprio(0); } while (0)
#define PG_WAIT_V(n) asm volatile("s_waitcnt vmcnt(" #n ")" ::: "memory")
#define PG_WAIT_L(n) asm volatile("s_waitcnt lgkmcnt(" #n ")" ::: "memory")
#define PG_BAR __builtin_amdgcn_s_barrier()
#define PG_SCHED __builtin_amdgcn_sched_barrier(0)
    Unit cur, nxt; int ui = 0;
    if (!S.next(0, cur)) return;
    f32x4 acc[2][2][4][2];
#pragma unroll
    for (int a = 0; a < 2; ++a)
#pragma unroll
        for (int b = 0; b < 2; ++b)
#pragma unroll
            for (int m = 0; m < 4; ++m)
#pragma unroll
                for (int n = 0; n < 2; ++n) acc[a][b][m][n] = (f32x4){0.f, 0.f, 0.f, 0.f};
    bf16x8 At[4][2], B0[2][2], B1[2][2];
    unsigned cOff[2][2], nOff[2][2];
    S.aoff(cur, Rr[0], Rr[1], Cb, cOff);
    const char* cB = S.bptr(cur);
    PG_STAGE(PG_SB(0, 0), cB, voffB); PG_STAGE(PG_SB(0, 1), cB + hstep, voffB); PG_STAGE(PG_SA(0, 0), Abase, cOff[0]); PG_STAGE(PG_SA(0, 1), Abase, cOff[1]);
    if (wr == 1) PG_BAR;
    PG_WAIT_V(2); PG_BAR;
    PG_STAGE(PG_SB(1, 0), cB + kstep, voffB); PG_STAGE(PG_SA(1, 0), Abase + kstep, cOff[0]); PG_STAGE(PG_SB(1, 1), cB + hstep + kstep, voffB);
    PG_WAIT_V(6); PG_BAR;
    for (;;) {
        const bool has_next = S.next(ui + 1, nxt);
        const char* nB = cB;
        if (has_next) { S.aoff(nxt, Rr[0], Rr[1], Cb, nOff); nB = S.bptr(nxt); }
        else { nOff[0][0] = cOff[0][0]; nOff[0][1] = cOff[0][1]; nOff[1][0] = cOff[1][0]; nOff[1][1] = cOff[1][1]; }
        for (int t = 0; t < nt; t += 2) {
            const bool last = (t == nt - 2);
            const char* a1 = Abase + (size_t)(t + 1) * kstep;
            const char* a2 = last ? Abase : Abase + (size_t)(t + 2) * kstep; const char* b2 = last ? nB : cB + (size_t)(t + 2) * kstep;
            const char* a3 = a2 + kstep; const char* b3 = b2 + kstep;
            unsigned o2[2][2];
            o2[0][0] = last ? nOff[0][0] : cOff[0][0]; o2[0][1] = last ? nOff[0][1] : cOff[0][1]; o2[1][0] = last ? nOff[1][0] : cOff[1][0]; o2[1][1] = last ? nOff[1][1] : cOff[1][1];
            PG_LDB(B0, 0, 0); PG_LDB(B1, 0, 1); PG_SCHED; PG_LDA(At, 0, 0); PG_STAGE(PG_SA(1, 1), a1, cOff[1]);
            PG_WAIT_V(8); PG_WAIT_L(0); PG_BAR; PG_MMA(0, 0, At, B0); PG_MMA(0, 1, At, B1); PG_BAR; PG_SCHED;
            PG_LDA(At, 0, 1); PG_STAGE(PG_SB(0, 0), b2, voffB); PG_STAGE(PG_SB(0, 1), b2 + hstep, voffB); PG_STAGE(PG_SA(0, 0), a2, o2[0]);
            PG_WAIT_V(8); PG_WAIT_L(0); PG_BAR; PG_MMA(1, 0, At, B0); PG_MMA(1, 1, At, B1); PG_BAR; PG_SCHED;
            PG_LDB(B0, 1, 0); PG_LDB(B1, 1, 1); PG_SCHED; PG_LDA(At, 1, 0); PG_STAGE(PG_SA(0, 1), a2, o2[1]);
            PG_WAIT_V(8); PG_WAIT_L(0); PG_BAR; PG_MMA(0, 0, At, B0); PG_MMA(0, 1, At, B1); PG_BAR; PG_SCHED;
            PG_LDA(At, 1, 1); PG_STAGE(PG_SB(1, 0), b3, voffB); PG_STAGE(PG_SB(1, 1), b3 + hstep, voffB); PG_STAGE(PG_SA(1, 0), a3, o2[0]);
            PG_WAIT_V(8); PG_WAIT_L(0); PG_BAR; PG_MMA(1, 0, At, B0); PG_MMA(1, 1, At, B1); PG_BAR; PG_SCHED;
        }
        if (wr == 0) PG_BAR;
        E(acc, cur, wr, wc, fr, fq);
        if (!has_next) break;
#pragma unroll
        for (int a = 0; a < 2; ++a)
#pragma unroll
            for (int b = 0; b < 2; ++b)
#pragma unroll
                for (int m = 0; m < 4; ++m)
#pragma unroll
                    for (int n = 0; n < 2; ++n) acc[a][b][m][n] = (f32x4){0.f, 0.f, 0.f, 0.f};
        cur = nxt; cB = nB; ++ui;
        cOff[0][0] = nOff[0][0]; cOff[0][1] = nOff[0][1]; cOff[1][0] = nOff[1][0]; cOff[1][1] = nOff[1][1];
        if (wr == 1) PG_BAR;
    }
    PG_WAIT_V(0);
    PG_BAR;
#undef PG_SA
#undef PG_SB
#undef PG_STAGE
#undef PG_LDA
#undef PG_LDB
#undef PG_MMA
#undef PG_WAIT_V
#undef PG_WAIT_L
#undef PG_BAR
#undef PG_SCHED
}

struct DUnit { int pm, pn; };
template <int K> struct DenseSched {
    typedef DUnit Unit;
    const char* Bt; int nM, nN, nwg, G, c;
    __device__ __forceinline__ void init(const void* Bt_, int M, int N, int G_, int c_) { Bt = (const char*)Bt_; nM = M / BM; nN = N / BM; nwg = nM * nN; G = G_; c = c_; }
    __device__ __forceinline__ bool next(int i, Unit& u) const {
        const long L = (long)i * G + c; if (L >= nwg) return false;
        int wgid = (int)L; { const int q = nwg / 8, r = nwg % 8, xcd = wgid % 8, off = wgid / 8; wgid = (xcd < r ? xcd * (q + 1) : r * (q + 1) + (xcd - r) * q) + off; }
        const int nig = 8 * nN, gid = wgid / nig, fm = gid * 8, gsz = (nM - fm) < 8 ? (nM - fm) : 8;
        u.pm = fm + ((wgid % nig) % gsz); u.pn = (wgid % nig) / gsz; return true;
    }
    __device__ __forceinline__ const char* bptr(const Unit& u) const { return Bt + (size_t)u.pn * BM * K * 2; }
    __device__ __forceinline__ void aoff(const Unit& u, int R0, int R1, int Cb, unsigned (&o)[2][2]) const {
#pragma unroll
        for (int h = 0; h < 2; ++h) { o[h][0] = (unsigned)((u.pm * BM + h * HALF + R0) * K) * 2u + Cb; o[h][1] = (unsigned)((u.pm * BM + h * HALF + R1) * K) * 2u + Cb; }
    }
};
struct MUnit { int E, mt, pn, cnt, rowbase; };
template <int K, int NT, bool GATHER> struct MoeSched {
    typedef MUnit Unit;
    const char* W; const LAS int* tab; const int* list; int G, c;
    __device__ __forceinline__ bool next(int i, Unit& u) const {
        const int L = i * G + c; const int total = tab[32] * NT; if (L >= total) return false;
        const int mg = L / NT; u.pn = L % NT;
        int E = 0;
#pragma unroll 1
        for (int e = 1; e < 32; ++e) E = (tab[e] <= mg) ? e : E;
        E = __builtin_amdgcn_readfirstlane(E);
        u.E = E; u.mt = mg - tab[E]; u.cnt = tab[33 + E]; u.rowbase = tab[65 + E]; return true;
    }
    __device__ __forceinline__ const char* bptr(const Unit& u) const { return W + ((size_t)u.E * NT + u.pn) * BM * K * 2; }
    __device__ __forceinline__ void aoff(const Unit& u, int R0, int R1, int Cb, unsigned (&o)[2][2]) const {
#pragma unroll
        for (int h = 0; h < 2; ++h)
#pragma unroll
            for (int i = 0; i < 2; ++i) { const int slot = u.mt * BM + h * HALF + (i ? R1 : R0);
                if (GATHER) { const int tok = slot < u.cnt ? (list[u.E * CAPE + slot] >> 1) : 0; o[h][i] = (unsigned)(tok * K) * 2u + Cb; }
                else o[h][i] = (unsigned)((u.rowbase + slot) * K) * 2u + Cb; }
    }
};

struct EpiBf16 {
    static constexpr bool PERM = true;
    bf16_t* O; int ldc;
    __device__ __forceinline__ void operator()(const f32x4 (&acc)[2][2][4][2], const DUnit& u, int wr, int wc, int fr, int fq) const {
        const int row0 = u.pm * BM + wr * 64 + fr, col0 = u.pn * BM + wc * 32 + 8 * fq;
#pragma unroll
        for (int ai = 0; ai < 2; ++ai)
#pragma unroll
            for (int m = 0; m < 4; ++m) { bf16_t* rowp = O + (size_t)(row0 + ai * HALF + m * 16) * ldc + col0;
#pragma unroll
                for (int bj = 0; bj < 2; ++bj) { const f32x4 v0 = acc[ai][bj][m][0], v1 = acc[ai][bj][m][1];
                    u32x4 w; w.x = cvt_pk_bf16(v0[0], v0[1]); w.y = cvt_pk_bf16(v0[2], v0[3]); w.z = cvt_pk_bf16(v1[0], v1[1]); w.w = cvt_pk_bf16(v1[2], v1[3]);
                    *(u32x4*)(rowp + bj * HALF) = w; } }
    }
};
struct EpiRes {
    static constexpr bool PERM = true;
    const bf16_t* res; bf16_t* C; int ldc;
    __device__ __forceinline__ void operator()(const f32x4 (&acc)[2][2][4][2], const DUnit& u, int wr, int wc, int fr, int fq) const {
        const int row0 = u.pm * BM + wr * 64 + fr, col0 = u.pn * BM + wc * 32 + 8 * fq;
#pragma unroll
        for (int ai = 0; ai < 2; ++ai)
#pragma unroll
            for (int m = 0; m < 4; ++m) { const size_t off = (size_t)(row0 + ai * HALF + m * 16) * ldc + col0;
#pragma unroll
                for (int bj = 0; bj < 2; ++bj) { const u32x4 r = *(const u32x4*)(res + off + bj * HALF); const f32x4 v0 = acc[ai][bj][m][0], v1 = acc[ai][bj][m][1];
                    u32x4 w; w.x = cvt_pk_bf16(bflo(r.x) + v0[0], bfhi(r.x) + v0[1]); w.y = cvt_pk_bf16(bflo(r.y) + v0[2], bfhi(r.y) + v0[3]);
                    w.z = cvt_pk_bf16(bflo(r.z) + v1[0], bfhi(r.z) + v1[1]); w.w = cvt_pk_bf16(bflo(r.w) + v1[2], bfhi(r.w) + v1[3]);
                    *(u32x4*)(C + off + bj * HALF) = w; } }
    }
};
struct EpiGateUp {
    static constexpr bool PERM = true;
    bf16_t* H; const float* gw;
    __device__ __forceinline__ void operator()(const f32x4 (&acc)[2][2][4][2], const MUnit& u, int wr, int wc, int fr, int fq) const {
        const int col0 = u.pn * HALF + wc * 32 + 8 * fq;
#pragma unroll
        for (int ai = 0; ai < 2; ++ai)
#pragma unroll
            for (int m = 0; m < 4; ++m) { const int slot = u.mt * BM + ai * HALF + wr * 64 + m * 16 + fr;
                const float w = slot < u.cnt ? gw[u.E * CAPE + slot] : 0.f;
                const f32x4 g0 = acc[ai][0][m][0], g1 = acc[ai][0][m][1], u0 = acc[ai][1][m][0], u1 = acc[ai][1][m][1];
                float h[8];
#pragma unroll
                for (int j = 0; j < 4; ++j) { h[j] = silu(g0[j]) * u0[j] * w; h[4 + j] = silu(g1[j]) * u1[j] * w; }
                u32x4 o; o.x = cvt_pk_bf16(h[0], h[1]); o.y = cvt_pk_bf16(h[2], h[3]); o.z = cvt_pk_bf16(h[4], h[5]); o.w = cvt_pk_bf16(h[6], h[7]);
                *(u32x4*)(H + (size_t)(u.rowbase + slot) * DE + col0) = o; }
    }
};
struct EpiDown {
    static constexpr bool PERM = true;
    bf16_t* Y; const int* list;
    __device__ __forceinline__ void operator()(const f32x4 (&acc)[2][2][4][2], const MUnit& u, int wr, int wc, int fr, int fq) const {
        const int col0 = u.pn * BM + wc * 32 + 8 * fq;
#pragma unroll
        for (int ai = 0; ai < 2; ++ai)
#pragma unroll
            for (int m = 0; m < 4; ++m) { const int slot = u.mt * BM + ai * HALF + wr * 64 + m * 16 + fr;
                if (slot < u.cnt) { const int ent = list[u.E * CAPE + slot]; bf16_t* rowp = Y + (size_t)ent * DM + col0;
#pragma unroll
                    for (int bj = 0; bj < 2; ++bj) { const f32x4 v0 = acc[ai][bj][m][0], v1 = acc[ai][bj][m][1];
                        u32x4 w; w.x = cvt_pk_bf16(v0[0], v0[1]); w.y = cvt_pk_bf16(v0[2], v0[3]); w.z = cvt_pk_bf16(v1[0], v1[1]); w.w = cvt_pk_bf16(v1[2], v1[3]);
                        *(u32x4*)(rowp + bj * HALF) = w; } } }
    }
};

template <int K, int LDB, class Epi, class Sched>
__device__ __forceinline__ void gemm_rb(LAS unsigned char* lds, const char* Abase, const Sched& S, const Epi& E) {
    typedef typename Sched::Unit Unit;
    const int tid = opaque_tid(), wid = __builtin_amdgcn_readfirstlane(tid >> 6), lane = tid & 63, wr = wid >> 2, wc = wid & 3, fr = lane & 15, fq = lane >> 4;
    constexpr int nt = K / BK;
    int Rr[2], Cb;
#pragma unroll
    for (int i = 0; i < 2; ++i) { int R, C; stage_rc(tid * 16 + i * 8192, R, C); Rr[i] = R; Cb = C * 2; }
    const unsigned ldsw = (unsigned)wid * 1024u;
    const int aoff = lds_byte(wr * 64 + fr, fq * 8);
    const int k4 = tid >> 5, n4 = tid & 31;
    int bw[4];
#pragma unroll
    for (int q = 0; q < 4; ++q) bw[q] = (4 * n4 + q) * 128 + (((k4 >> 1) ^ (n4 & 7)) * 16) + (k4 & 1) * 8;
    int brd[2][2];
#pragma unroll
    for (int n = 0; n < 2; ++n)
#pragma unroll
        for (int k = 0; k < 2; ++k) { const int r = wc * 32 + n * 16 + fr; brd[n][k] = r * 128 + (((k * 4 + fq) ^ ((r >> 2) & 7)) * 16); }
#define RB_SB(b) (98304 + (b) * HTB)
#define RB_STAGE_A(sa, kt, OFF) do { _Pragma("unroll") for (int _h = 0; _h < 2; ++_h) _Pragma("unroll") for (int _i = 0; _i < 2; ++_i) \
        __builtin_amdgcn_global_load_lds((const unsigned*)(Abase + (size_t)(kt) * (BK * 2) + OFF[_h][_i]), (LAS unsigned*)(lds + (sa) * 32768 + _h * HTB + ldsw + _i * 8192), 16, 0, 0); } while (0)
#define RB_LOAD_B(r0, r1, r2, r3, kt, BP) do { const float* _p = BP + (size_t)(kt) * BK * LDB; \
        asm volatile("global_load_dwordx4 %0, %4, off\n\tglobal_load_dwordx4 %1, %5, off\n\tglobal_load_dwordx4 %2, %6, off\n\tglobal_load_dwordx4 %3, %7, off" \
            : "=&v"(r0), "=&v"(r1), "=&v"(r2), "=&v"(r3) : "v"(_p), "v"(_p + LDB), "v"(_p + 2 * LDB), "v"(_p + 3 * LDB) : "memory"); } while (0)
#define RB_WAIT8(r0, r1, r2, r3) asm volatile("s_waitcnt vmcnt(8)" : "+v"(r0), "+v"(r1), "+v"(r2), "+v"(r3) :: "memory")
#define RB_WRITE_B(b, r0, r1, r2, r3) do { _Pragma("unroll") for (int _q = 0; _q < 4; ++_q) { u32x2 _w; _w.x = cvt_pk_bf16(r0[_q], r1[_q]); _w.y = cvt_pk_bf16(r2[_q], r3[_q]); \
        *(LAS u32x2*)(lds + RB_SB(b) + bw[_q]) = _w; } } while (0)
#define RB_COMPUTE(sa, b) do { bf16x8 Bf[2][2]; _Pragma("unroll") for (int n = 0; n < 2; ++n) _Pragma("unroll") for (int k = 0; k < 2; ++k) Bf[n][k] = *(const LAS bf16x8*)(lds + RB_SB(b) + brd[n][k]); \
        _Pragma("unroll") for (int ai = 0; ai < 2; ++ai) { bf16x8 At[4][2]; _Pragma("unroll") for (int m = 0; m < 4; ++m) _Pragma("unroll") for (int k = 0; k < 2; ++k) At[m][k] = *(const LAS bf16x8*)(lds + (sa) * 32768 + ai * HTB + aoff + m * 2048 + k * 1024); \
            __builtin_amdgcn_s_setprio(1); _Pragma("unroll") for (int m = 0; m < 4; ++m) _Pragma("unroll") for (int n = 0; n < 2; ++n) _Pragma("unroll") for (int k = 0; k < 2; ++k) acc[ai][m][n] = __builtin_amdgcn_mfma_f32_16x16x32_bf16(Bf[n][k], At[m][k], acc[ai][m][n], 0, 0, 0); __builtin_amdgcn_s_setprio(0); } } while (0)
#define RB_SYNC() do { asm volatile("s_waitcnt lgkmcnt(0)" ::: "memory"); __builtin_amdgcn_s_barrier(); asm volatile("" ::: "memory"); sa = sa == 2 ? 0 : sa + 1; } while (0)
#define RB_STEP(b, kt2, OFF, BP, c0, c1, c2, c3, n0, n1, n2, n3) do { const int _s2 = sa >= 1 ? sa - 1 : 2; RB_STAGE_A(_s2, kt2, OFF); RB_LOAD_B(c0, c1, c2, c3, kt2, BP); \
        RB_COMPUTE(sa, b); RB_WAIT8(n0, n1, n2, n3); RB_WRITE_B((b) ^ 1, n0, n1, n2, n3); RB_SYNC(); } while (0)
    Unit u, un;
    if (!S.next(0, u)) return;
    unsigned cOff[2][2], nOff[2][2]; S.aoff(u, Rr[0], Rr[1], Cb, cOff);
    const float* bp = S.bsrc(u, 4 * n4) + (size_t)(4 * k4) * LDB; const float* nbp = bp;
    f32x4 e0, e1, e2, e3, o0, o1, o2, o3;
    asm volatile("s_waitcnt vmcnt(0)" ::: "memory");
    RB_STAGE_A(0, 0, cOff); RB_LOAD_B(e0, e1, e2, e3, 0, bp);
    RB_STAGE_A(1, 1, cOff); RB_LOAD_B(o0, o1, o2, o3, 1, bp);
    RB_WAIT8(e0, e1, e2, e3); RB_WRITE_B(0, e0, e1, e2, e3);
    asm volatile("s_waitcnt lgkmcnt(0)" ::: "memory"); __builtin_amdgcn_s_barrier(); asm volatile("" ::: "memory");
    int sa = 0;
    for (int ui = 0;; ++ui) {
        const bool has_next = S.next(ui + 1, un);
        if (has_next) { S.aoff(un, Rr[0], Rr[1], Cb, nOff); nbp = S.bsrc(un, 4 * n4) + (size_t)(4 * k4) * LDB; }
        else { nOff[0][0] = cOff[0][0]; nOff[0][1] = cOff[0][1]; nOff[1][0] = cOff[1][0]; nOff[1][1] = cOff[1][1]; nbp = bp; }
        f32x4 acc[2][4][2];
#pragma unroll
        for (int a = 0; a < 2; ++a)
#pragma unroll
            for (int m = 0; m < 4; ++m)
#pragma unroll
                for (int n = 0; n < 2; ++n) acc[a][m][n] = (f32x4){0.f, 0.f, 0.f, 0.f};
        unsigned pv[2][4]; E.pre(u, wr, fr, pv);
#pragma unroll 1
        for (int t = 0; t < nt - 2; t += 2) { RB_STEP(0, t + 2, cOff, bp, e0, e1, e2, e3, o0, o1, o2, o3); RB_STEP(1, t + 3, cOff, bp, o0, o1, o2, o3, e0, e1, e2, e3); }
        RB_STEP(0, 0, nOff, nbp, e0, e1, e2, e3, o0, o1, o2, o3); RB_STEP(1, 1, nOff, nbp, o0, o1, o2, o3, e0, e1, e2, e3);
        E(acc, u, wr, wc, fr, fq, pv);
        if (!has_next) break;
        u = un; bp = nbp; cOff[0][0] = nOff[0][0]; cOff[0][1] = nOff[0][1]; cOff[1][0] = nOff[1][0]; cOff[1][1] = nOff[1][1];
    }
    asm volatile("s_waitcnt vmcnt(0)" ::: "memory"); __builtin_amdgcn_s_barrier();
#undef RB_SB
#undef RB_STAGE_A
#undef RB_LOAD_B
#undef RB_WAIT8
#undef RB_WRITE_B
#undef RB_COMPUTE
#undef RB_STEP
#undef RB_SYNC
}
template <int K, int NT, bool GATHER> struct MoeSchedRB {
    typedef MUnit Unit;
    const float* W0; const float* W1; const LAS int* tab; const int* list; int G, c;
    __device__ __forceinline__ bool next(int i, Unit& u) const {
        const int L = i * G + c; const int total = tab[32] * NT; if (L >= total) return false;
        const int mg = L / NT;
        int E = 0;
#pragma unroll 1
        for (int e = 1; e < 32; ++e) E = (tab[e] <= mg) ? e : E;
        E = __builtin_amdgcn_readfirstlane(E);
#ifndef ORDER_MT_FAST
#define ORDER_MT_FAST 1
#endif
        if (ORDER_MT_FAST) { const int nte = tab[E + 1] - tab[E], loc = L - tab[E] * NT; u.pn = loc / nte; u.mt = loc - u.pn * nte; }
        else { u.pn = L % NT; u.mt = mg - tab[E]; }
        u.E = E; u.cnt = tab[33 + E]; u.rowbase = tab[65 + E]; return true;
    }
    __device__ __forceinline__ const float* bsrc(const Unit& u, int c4) const {
        if (GATHER) { const long dW = ((c4 >> 4) & 1) ? (long)(W1 - W0) : 0l; return W0 + dW + (size_t)u.E * DM * DE + 64 * u.pn + 16 * (c4 >> 5) + (c4 & 15); }
        else return W0 + (size_t)u.E * DE * DM + 128 * u.pn + c4;
    }
    __device__ __forceinline__ void aoff(const Unit& u, int R0, int R1, int Cb, unsigned (&o)[2][2]) const {
#pragma unroll
        for (int h = 0; h < 2; ++h)
#pragma unroll
            for (int i = 0; i < 2; ++i) { const int slot = u.mt * BM + h * HALF + (i ? R1 : R0);
                if (GATHER) { const int ent = list[u.E * CAPE + slot]; const int tok = slot < u.cnt ? (ent >> 1) : 0; o[h][i] = (unsigned)(tok * K) * 2u + Cb; }
                else o[h][i] = (unsigned)((u.rowbase + slot) * K) * 2u + Cb; }
    }
};
struct EpiGateUpRB {
    bf16_t* H; const float* gw;
    __device__ __forceinline__ void pre(const MUnit& u, int wr, int fr, unsigned (&pv)[2][4]) const {
#pragma unroll
        for (int ai = 0; ai < 2; ++ai)
#pragma unroll
            for (int m = 0; m < 4; ++m) pv[ai][m] = __float_as_uint(gw[u.E * CAPE + u.mt * BM + ai * HALF + wr * 64 + m * 16 + fr]);
    }
    __device__ __forceinline__ void operator()(const f32x4 (&acc)[2][4][2], const MUnit& u, int wr, int wc, int fr, int fq, const unsigned (&pv)[2][4]) const {
        const int col0 = u.pn * 64 + wc * 16 + 4 * fq;
#pragma unroll
        for (int ai = 0; ai < 2; ++ai)
#pragma unroll
            for (int m = 0; m < 4; ++m) { const int slot = u.mt * BM + ai * HALF + wr * 64 + m * 16 + fr;
                const float w = slot < u.cnt ? __uint_as_float(pv[ai][m]) : 0.f;
                const f32x4 g = acc[ai][m][0], up = acc[ai][m][1];
                u32x2 o; o.x = cvt_pk_bf16(silu(g[0]) * up[0] * w, silu(g[1]) * up[1] * w); o.y = cvt_pk_bf16(silu(g[2]) * up[2] * w, silu(g[3]) * up[3] * w);
                *(u32x2*)(H + (size_t)(u.rowbase + slot) * DE + col0) = o; }
    }
};
struct EpiDownRB {
    bf16_t* Y; const int* list;
    __device__ __forceinline__ void pre(const MUnit& u, int wr, int fr, unsigned (&pv)[2][4]) const {
#pragma unroll
        for (int ai = 0; ai < 2; ++ai)
#pragma unroll
            for (int m = 0; m < 4; ++m) pv[ai][m] = (unsigned)list[u.E * CAPE + u.mt * BM + ai * HALF + wr * 64 + m * 16 + fr];
    }
    __device__ __forceinline__ void operator()(const f32x4 (&acc)[2][4][2], const MUnit& u, int wr, int wc, int fr, int fq, const unsigned (&pv)[2][4]) const {
        const int col0 = u.pn * HALF + wc * 32 + 4 * fq;
#pragma unroll
        for (int ai = 0; ai < 2; ++ai)
#pragma unroll
            for (int m = 0; m < 4; ++m) { const int slot = u.mt * BM + ai * HALF + wr * 64 + m * 16 + fr;
                if (slot < u.cnt) { bf16_t* rowp = Y + (size_t)pv[ai][m] * DM + col0;
#pragma unroll
                    for (int n = 0; n < 2; ++n) { const f32x4 v = acc[ai][m][n]; u32x2 o; o.x = cvt_pk_bf16(v[0], v[1]); o.y = cvt_pk_bf16(v[2], v[3]); *(u32x2*)(rowp + n * 16) = o; } } }
    }
};
}

struct Args { const float* in[21]; float* out; unsigned char* ws; int ph_lo, ph_hi; };
#define CAS __attribute__((address_space(4)))
typedef const CAS Args* ArgP;
__device__ __forceinline__ ArgP kargs() { ArgP p = (ArgP)__builtin_amdgcn_kernarg_segment_ptr(); asm volatile("" : "+s"(p)); return p; }

enum { I_X = 0, I_N1G, I_WIN, I_CONVW, I_CONVB, I_CLNG, I_CLNB, I_GW2, I_GB2, I_GNG, I_FFB, I_WOUT, I_N2G, I_RGW, I_RGB, I_REW, I_REB, I_WG, I_WU, I_WD, I_FNG };

template <int MAP  >
__device__ __forceinline__ void cvt_item(const float* W, int K, int N, int nblk, bf16_t* WT, LAS float* scr, int item, int lane) {
    const int kb = item / nblk, nb = item % nblk, k0 = 64 * kb, n0 = 32 * nb;
    const int n4 = lane & 7, kr = lane >> 3;
    const bool nok = (n0 + 4 * n4) < N;
    f32x4 v[8];
#pragma unroll
    for (int i = 0; i < 8; ++i) v[i] = nok ? *(const f32x4*)(W + (size_t)(k0 + 8 * i + kr) * N + n0 + 4 * n4) : (f32x4){0.f, 0.f, 0.f, 0.f};
#pragma unroll
    for (int i = 0; i < 8; ++i) { LAS float* d = scr + (8 * i + kr) * 33 + 4 * n4; d[0] = v[i].x; d[1] = v[i].y; d[2] = v[i].z; d[3] = v[i].w; }
    LDS_WAIT(); asm volatile("" ::: "memory");
    const int c = lane & 7;
#pragma unroll
    for (int j = 0; j < 4; ++j) { const int n = (lane >> 3) + 8 * j; const LAS float* s = scr + (8 * c) * 33 + n;
        u32x4 o; o.x = cvt_pk_bf16(s[0 * 33], s[1 * 33]); o.y = cvt_pk_bf16(s[2 * 33], s[3 * 33]); o.z = cvt_pk_bf16(s[4 * 33], s[5 * 33]); o.w = cvt_pk_bf16(s[6 * 33], s[7 * 33]);
        const int nn = n0 + n; const int row = MAP == 0 ? nn : ((nn >> 7) * 256 + (nn & 127) + (MAP == 2 ? 128 : 0));
        *(u32x4*)(WT + (size_t)row * K + k0 + 8 * c) = o; }
    LDS_WAIT(); asm volatile("" ::: "memory");
}
constexpr int CV_I_IN = 32 * 184, CV_I_OUT = 32 * 64, CV_N_IN = 2 * CV_I_IN;
__device__ __forceinline__ void cvt_range(ArgP a, LAS unsigned char* lds, int first, int count, int rank, int nranks) {
    const int tid = opaque_tid(), lane = tid & 63, wave = tid >> 6;
    LAS float* scr = (LAS float*)(lds + wave * 16384);
    for (int it = first + rank * NWAVES + wave; it < first + count; it += nranks * NWAVES) {
        int r = it;
        if (r < CV_N_IN) { const int l = r / CV_I_IN; cvt_item<0>(a->in[I_WIN] + (size_t)l * DM * DIN, DM, DIN, 184, (bf16_t*)(a->ws + WS_WIN) + (size_t)l * DINP * DM, scr, r % CV_I_IN, lane); continue; } r -= CV_N_IN;
        { const int l = r / CV_I_OUT; cvt_item<0>(a->in[I_WOUT] + (size_t)l * DM * DM, DM, DM, 64, (bf16_t*)(a->ws + WS_WOUT) + (size_t)l * DM * DM, scr, r % CV_I_OUT, lane); }
    }
}
__device__ __forceinline__ void idle_rank(int nunits, int G, int c, int& rank, int& nranks) {
    const int maxu = (nunits + G - 1) / G, nidle = maxu * G - nunits, first = nunits - (maxu - 1) * G;
    if (nidle >= 16) { nranks = nidle; rank = c >= first ? c - first : -1; } else { nranks = G; rank = c; }
}
__device__ __forceinline__ void p0_prologue(ArgP a, LAS unsigned char* lds) {
    const int tid = opaque_tid(), lane = tid & 63, wave = tid >> 6;
    LAS float* scr = (LAS float*)(lds + wave * 16384);
    const int gw = blockIdx.x * NWAVES + wave, NGW = gridDim.x * NWAVES;
    constexpr int I_IN = CV_I_IN;
    cvt_range(a, lds, 0, I_IN, blockIdx.x, gridDim.x);
    for (int idx = blockIdx.x * NTHR + tid; idx < DEPTH * 48 * DM; idx += gridDim.x * NTHR) {
        const int k = idx % DM, c = (idx / DM) % 48, l = idx / (DM * 48);
        float w = 0.f;
        if (c < 4) w = a->in[I_RGW][((size_t)l * DM + k) * 4 + c];
        else if (c < 36) w = a->in[I_REW][(((size_t)l * 4 + ((c - 4) >> 3)) * DM + k) * 8 + ((c - 4) & 7)];
        w *= a->in[I_N2G][l * DM + k];
        const bf16_t hi = f2bf(w), lo = f2bf(w - bf2f(hi));
        bf16_t* wr = (bf16_t*)(a->ws + WS_WR);
        wr[((size_t)(l * 2 + 0) * 48 + c) * DM + k] = hi; wr[((size_t)(l * 2 + 1) * 48 + c) * DM + k] = lo;
    }
    const float* g = a->in[I_N1G];
    f32x4 nx[8];
    if (gw < T) {
#pragma unroll
        for (int j = 0; j < 8; ++j) nx[j] = ((const f32x4*)(a->in[I_X] + (size_t)gw * DM) + lane)[64 * j]; }
    for (int m = gw; m < T; m += NGW) {
        f32x4 v[8]; float s = 0.f;
#pragma unroll
        for (int j = 0; j < 8; ++j) { v[j] = nx[j]; s += (v[j].x * v[j].x + v[j].y * v[j].y) + (v[j].z * v[j].z + v[j].w * v[j].w); }
        if (m + NGW < T) {
#pragma unroll
            for (int j = 0; j < 8; ++j) nx[j] = ((const f32x4*)(a->in[I_X] + (size_t)(m + NGW) * DM) + lane)[64 * j]; }
        const float rstd = rsqrtf(wave_sum(s) * (1.f / DM) + EPS);
        u32x2* o = (u32x2*)((bf16_t*)(a->ws + WS_H) + (size_t)m * DM) + lane; u32x2* xb = (u32x2*)((bf16_t*)(a->ws + WS_XB) + (size_t)m * DM) + lane;
#pragma unroll
        for (int j = 0; j < 8; ++j) { const f32x4 gg = ((const f32x4*)g)[lane + 64 * j]; u32x2 w; w.x = cvt_pk_bf16(v[j].x * rstd * gg.x, v[j].y * rstd * gg.y); w.y = cvt_pk_bf16(v[j].z * rstd * gg.z, v[j].w * rstd * gg.w); o[64 * j] = w;
            u32x2 xw; xw.x = cvt_pk_bf16(v[j].x, v[j].y); xw.y = cvt_pk_bf16(v[j].z, v[j].w); xb[64 * j] = xw; }
    }
}

__device__ __forceinline__ void conv_phase(ArgP a, LAS unsigned char* lds, int l) {
    const int tid = opaque_tid(), lane = tid & 63, wave = tid >> 6, cp = tid & 255, th = tid >> 8;
    const bf16_t* P = (const bf16_t*)(a->ws + WS_P); bf16_t* mix = (bf16_t*)(a->ws + WS_MIX);
    LAS float* ut = (LAS float*)lds;
    for (int item = blockIdx.x; item < NB * (SEQ / 32); item += gridDim.x) {
        const int b = item / (SEQ / 32), s0 = (item % (SEQ / 32)) * 32;
        __syncthreads();
#pragma unroll
        for (int i = 0; i < 8; ++i) { const int idx = tid + i * 512, r = idx >> 6, c8 = idx & 63, sq = s0 - 30 + r;
            if (r < 62) { f32x4 u0 = {0.f, 0.f, 0.f, 0.f}, u1 = {0.f, 0.f, 0.f, 0.f};
                if (sq >= 0) { const bf16_t* row = P + (size_t)(b * SEQ + sq) * DINP + c8 * 8; const u32x4 av = *(const u32x4*)(row + C_CA), gv = *(const u32x4*)(row + C_CG);
                    u0.x = bflo(av.x) * __builtin_amdgcn_rcpf(1.f + __expf(-bflo(gv.x))); u0.y = bfhi(av.x) * __builtin_amdgcn_rcpf(1.f + __expf(-bfhi(gv.x)));
                    u0.z = bflo(av.y) * __builtin_amdgcn_rcpf(1.f + __expf(-bflo(gv.y))); u0.w = bfhi(av.y) * __builtin_amdgcn_rcpf(1.f + __expf(-bfhi(gv.y)));
                    u1.x = bflo(av.z) * __builtin_amdgcn_rcpf(1.f + __expf(-bflo(gv.z))); u1.y = bfhi(av.z) * __builtin_amdgcn_rcpf(1.f + __expf(-bfhi(gv.z)));
                    u1.z = bflo(av.w) * __builtin_amdgcn_rcpf(1.f + __expf(-bflo(gv.w))); u1.w = bfhi(av.w) * __builtin_amdgcn_rcpf(1.f + __expf(-bfhi(gv.w))); }
                *(LAS f32x4*)(ut + r * 512 + c8 * 8) = u0; *(LAS f32x4*)(ut + r * 512 + c8 * 8 + 4) = u1; } }
        f32x2 w[31];
#pragma unroll
        for (int j = 0; j < 31; ++j) w[j] = *(const f32x2*)(a->in[I_CONVW] + ((size_t)l * 31 + j) * 512 + 2 * cp);
        const f32x2 cb = *(const f32x2*)(a->in[I_CONVB] + l * 512 + 2 * cp);
        __syncthreads();
        f32x2 y[16];
#pragma unroll
        for (int t = 0; t < 16; ++t) y[t] = cb;
#pragma unroll
        for (int r = 0; r < 46; ++r) { const f32x2 u = *(const LAS f32x2*)(ut + (th * 16 + r) * 512 + 2 * cp);
#pragma unroll
            for (int t = 0; t < 16; ++t) { const int j = r - t; if (j >= 0 && j < 31) y[t] += w[j] * u; } }
        __syncthreads();
#pragma unroll
        for (int t = 0; t < 16; ++t) *(LAS f32x2*)(ut + (th * 16 + t) * 512 + 2 * cp) = y[t];
        __syncthreads();
#pragma unroll
        for (int q = 0; q < 4; ++q) { const int t = wave * 4 + q;
            const f32x4 y0 = *(const LAS f32x4*)(ut + t * 512 + lane * 8), y1 = *(const LAS f32x4*)(ut + t * 512 + lane * 8 + 4);
            const float mu = wave_sum((y0.x + y0.y) + (y0.z + y0.w) + (y1.x + y1.y) + (y1.z + y1.w)) * (1.f / 512.f);
            const f32x4 d0 = y0 - mu, d1 = y1 - mu;
            const float var = wave_sum((d0.x * d0.x + d0.y * d0.y) + (d0.z * d0.z + d0.w * d0.w) + (d1.x * d1.x + d1.y * d1.y) + (d1.z * d1.z + d1.w * d1.w)) * (1.f / 512.f);
            const float rstd = rsqrtf(var + EPS);
            const f32x4 g0 = *(const f32x4*)(a->in[I_CLNG] + l * 512 + lane * 8), g1 = *(const f32x4*)(a->in[I_CLNG] + l * 512 + lane * 8 + 4);
            const f32x4 b0 = *(const f32x4*)(a->in[I_CLNB] + l * 512 + lane * 8), b1 = *(const f32x4*)(a->in[I_CLNB] + l * 512 + lane * 8 + 4);
            float o[8];
#pragma unroll
            for (int j = 0; j < 4; ++j) { o[j] = silu(d0[j] * rstd * g0[j] + b0[j]); o[4 + j] = silu(d1[j] * rstd * g1[j] + b1[j]); }
            u32x4 pk; pk.x = cvt_pk_bf16(o[0], o[1]); pk.y = cvt_pk_bf16(o[2], o[3]); pk.z = cvt_pk_bf16(o[4], o[5]); pk.w = cvt_pk_bf16(o[6], o[7]);
            *(u32x4*)(mix + (size_t)(b * SEQ + s0 + t) * DM + M_CONV + lane * 8) = pk; }
    }
    __syncthreads();
}

constexpr int GL_ALOW = 0, GL_TOT = 5120, GL_END0 = 5120 + 2048;
__device__ __forceinline__ void gla_cum(ArgP a, LAS unsigned char* lds, int l, int h, int t0, float (&cum)[16], float& last) {
    const int tid = opaque_tid(), d = tid & 127, cg = tid >> 7;
    const bf16_t* P = (const bf16_t*)(a->ws + WS_P);
    LAS float* alow = (LAS float*)(lds + GL_ALOW); LAS float* tot = (LAS float*)(lds + GL_TOT);
#pragma unroll
    for (int i = 0; i < 2; ++i) { const int idx = tid + i * 512, c = idx >> 4, r = idx & 15; alow[c * 20 + r] = bf2f(P[(size_t)(t0 + c) * DINP + C_GLOW + r]); }
    float w2[16];
#pragma unroll
    for (int r = 0; r < 16; ++r) w2[r] = a->in[I_GW2][((size_t)l * 16 + r) * 512 + h * 128 + d];
    const float b2 = a->in[I_GB2][l * 512 + h * 128 + d];
    __syncthreads();
    float run = 0.f;
#pragma unroll
    for (int j = 0; j < 16; ++j) { const int c = cg * 16 + j; float z = b2;
#pragma unroll
        for (int q = 0; q < 4; ++q) { const f32x4 av = *(const LAS f32x4*)(alow + c * 20 + q * 4); z += av.x * w2[q * 4] + av.y * w2[q * 4 + 1] + av.z * w2[q * 4 + 2] + av.w * w2[q * 4 + 3]; }
        run += log_sigmoid(z) * (1.f / 16.f); cum[j] = run; }
    tot[cg * 128 + d] = run;
    __syncthreads();
    float pre = 0.f, all = 0.f;
#pragma unroll
    for (int q = 0; q < 4; ++q) { const float tv = tot[q * 128 + d]; pre += (q < cg) ? tv : 0.f; all += tv; }
#pragma unroll
    for (int j = 0; j < 16; ++j) cum[j] += pre;
    last = all;
}
constexpr int GA_KT = GL_END0, GA_V = GA_KT + 128 * 144, GA_OUT = GA_V + 64 * 528, GA_END = GA_OUT + 256 * 256;
static_assert(GA_END <= MISC_OFF, "GLA-A LDS");
__device__ __forceinline__ void gla_a_phase(ArgP a, LAS unsigned char* lds, int l) {
    const int tid = opaque_tid(), lane = tid & 63, wave = tid >> 6, d = tid & 127, cg = tid >> 7, g = lane >> 4, li = lane & 15;
    const bf16_t* P = (const bf16_t*)(a->ws + WS_P);
    for (int item = blockIdx.x; item < 512; item += gridDim.x) {
        const int n = item & 31, h = (item >> 5) & 3, b = item >> 7, t0 = b * SEQ + n * 64;
        float cum[16], last;
        bf16_t kraw[16]; u32x4 vraw[4];
#pragma unroll
        for (int j = 0; j < 16; ++j) kraw[j] = P[(size_t)(t0 + cg * 16 + j) * DINP + C_GK + h * 128 + d];
#pragma unroll
        for (int i = 0; i < 4; ++i) { const int idx = tid + i * 512, c = idx >> 5, e8 = idx & 31; vraw[i] = *(const u32x4*)(P + (size_t)(t0 + c) * DINP + C_GV + h * 256 + e8 * 8); }
        __syncthreads();
        gla_cum(a, lds, l, h, t0, cum, last);
        { float* cg_ = (float*)(a->ws + WS_CUM) + (size_t)(t0 + cg * 16) * 512 + h * 128 + d;
#pragma unroll
          for (int j = 0; j < 16; ++j) cg_[j * 512] = cum[j]; }
        { unsigned pk[8];
#pragma unroll
          for (int j = 0; j < 16; j += 2) { const float k0 = bf2f(kraw[j]), k1 = bf2f(kraw[j + 1]);
              pk[j >> 1] = cvt_pk_bf16(k0 * __expf(last - cum[j]), k1 * __expf(last - cum[j + 1])); }
          LAS u32x4* dst = (LAS u32x4*)(lds + GA_KT + d * 144 + cg * 32);
          dst[0] = (u32x4){pk[0], pk[1], pk[2], pk[3]}; dst[1] = (u32x4){pk[4], pk[5], pk[6], pk[7]}; }
        if (cg == 0) ((float*)(a->ws + WS_DEC))[item * 128 + d] = __expf(last);
#pragma unroll
        for (int i = 0; i < 4; ++i) { const int idx = tid + i * 512, c = idx >> 5, e8 = idx & 31;
            *(LAS u32x4*)(lds + GA_V + c * 528 + e8 * 16) = vraw[i]; }
        __syncthreads();
        f32x4 acc[2][8];
#pragma unroll
        for (int i = 0; i < 2; ++i)
#pragma unroll
            for (int j = 0; j < 8; ++j) acc[i][j] = (f32x4){0.f, 0.f, 0.f, 0.f};
#pragma unroll
        for (int kk = 0; kk < 2; ++kk) {
            bf16x8 af[2], bfr[8];
#pragma unroll
            for (int i = 0; i < 2; ++i) { const LAS unsigned char* p = lds + GA_V + (kk * 32 + 8 * g + (li >> 2)) * 528 + ((wave * 2 + i) * 16 + 4 * (li & 3)) * 2;
                af[i] = cat8(vtr(p), vtr(p + 4 * 528)); }
#pragma unroll
            for (int j = 0; j < 8; ++j) bfr[j] = *(const LAS bf16x8*)(lds + GA_KT + (j * 16 + li) * 144 + (kk * 32 + 8 * g) * 2);
#pragma unroll
            for (int i = 0; i < 2; ++i)
#pragma unroll
                for (int j = 0; j < 8; ++j) acc[i][j] = mfma16(af[i], bfr[j], acc[i][j]);
        }
#pragma unroll
        for (int i = 0; i < 2; ++i)
#pragma unroll
            for (int j = 0; j < 8; ++j)
#pragma unroll
                for (int r = 0; r < 4; ++r) *(LAS bf16_t*)(lds + GA_OUT + (((wave * 2 + i) * 16 + 4 * g + r) * 128 + j * 16 + li) * 2) = f2bf(acc[i][j][r]);
        __syncthreads();
        bf16_t* kv = (bf16_t*)(a->ws + WS_KV) + (size_t)item * 32768;
#pragma unroll
        for (int i = 0; i < 8; ++i) { const int idx = tid + i * 512; *(u32x4*)(kv + idx * 8) = *(const LAS u32x4*)(lds + GA_OUT + idx * 16); }
    }
    __syncthreads();
}
__device__ __forceinline__ void gla_b_phase(ArgP a) {
    bf16_t* kvb = (bf16_t*)(a->ws + WS_KV); const float* dec = (const float*)(a->ws + WS_DEC);
    const int tid0 = opaque_tid();
    for (int idx = blockIdx.x * NTHR + tid0; idx < 16 * 8192; idx += gridDim.x * NTHR) {
        const int bh = idx >> 13, off = (idx & 8191) * 4, d0 = off & 127;
        float st[4] = {0.f, 0.f, 0.f, 0.f};
#pragma unroll 1
        for (int n0 = 0; n0 < 32; n0 += 8) {
            u32x2 kvv[8]; f32x4 dc[8];
#pragma unroll
            for (int q = 0; q < 8; ++q) { const int ch = bh * 32 + n0 + q; kvv[q] = *(const u32x2*)(kvb + (size_t)ch * 32768 + off); dc[q] = *(const f32x4*)(dec + ch * 128 + d0); }
#pragma unroll
            for (int q = 0; q < 8; ++q) { const int ch = bh * 32 + n0 + q;
                u32x2 o; o.x = cvt_pk_bf16(st[0], st[1]); o.y = cvt_pk_bf16(st[2], st[3]);
                *(u32x2*)(kvb + (size_t)ch * 32768 + off) = o;
                st[0] = dc[q].x * st[0] + bflo(kvv[q].x); st[1] = dc[q].y * st[1] + bfhi(kvv[q].x); st[2] = dc[q].z * st[2] + bflo(kvv[q].y); st[3] = dc[q].w * st[3] + bfhi(kvv[q].y); }
        }
    }
}
constexpr int GC_QD = GL_END0, GC_KI = GC_QD + 64 * 272, GC_ATT = GC_KI + 64 * 272, GC_V = GC_ATT + 64 * 144, GC_SS = GC_V + 64 * 528, GC_END = GC_SS + 64 * 8 * 4;
constexpr int GC_OST = GL_END0;
static_assert(GC_END <= MISC_OFF && GC_OST + 64 * 260 * 4 <= GC_SS, "GLA-C LDS");
__device__ __forceinline__ void gla_c_phase(ArgP a, LAS unsigned char* lds, int l) {
    const int tid = opaque_tid(), lane = tid & 63, wave = tid >> 6, d = tid & 127, cg = tid >> 7, g = lane >> 4, li = lane & 15;
    const bf16_t* P = (const bf16_t*)(a->ws + WS_P); bf16_t* mix = (bf16_t*)(a->ws + WS_MIX);
    for (int item = blockIdx.x; item < 512; item += gridDim.x) {
        const int n = item & 31, h = (item >> 5) & 3, b = item >> 7, t0 = b * SEQ + n * 64;
        float cum[16];
        { const float* cg_ = (const float*)(a->ws + WS_CUM) + (size_t)(t0 + cg * 16) * 512 + h * 128 + d;
#pragma unroll
          for (int j = 0; j < 16; ++j) cum[j] = cg_[j * 512]; }
        bf16_t qraw[16], kraw[16]; u32x4 vraw[4];
#pragma unroll
        for (int j = 0; j < 16; ++j) { const bf16_t* row = P + (size_t)(t0 + cg * 16 + j) * DINP + h * 128 + d; qraw[j] = row[C_GQ]; kraw[j] = row[C_GK]; }
#pragma unroll
        for (int i = 0; i < 4; ++i) { const int idx = tid + i * 512, c = idx >> 5, e8 = idx & 31; vraw[i] = *(const u32x4*)(P + (size_t)(t0 + c) * DINP + C_GV + h * 256 + e8 * 8); }
        __syncthreads();
        const bf16_t* ST = (const bf16_t*)(a->ws + WS_KV) + (size_t)item * 32768;
        bf16x8 sf[2][4];
#pragma unroll
        for (int i = 0; i < 2; ++i)
#pragma unroll
            for (int ks = 0; ks < 4; ++ks) sf[i][ks] = *(const bf16x8*)(ST + ((wave * 2 + i) * 16 + li) * 128 + ks * 32 + 8 * g);
#pragma unroll
        for (int j = 0; j < 16; ++j) { const int c = cg * 16 + j;
            const float qv = bf2f(qraw[j]) * 0.08838834764831845f * __expf(cum[j]), kv = bf2f(kraw[j]) * __expf(-cum[j]);
            *(LAS bf16_t*)(lds + GC_QD + c * 272 + d * 2) = f2bf(qv); *(LAS bf16_t*)(lds + GC_KI + c * 272 + d * 2) = f2bf(kv); }
#pragma unroll
        for (int i = 0; i < 4; ++i) { const int idx = tid + i * 512, c = idx >> 5, e8 = idx & 31;
            *(LAS u32x4*)(lds + GC_V + c * 528 + e8 * 16) = vraw[i]; }
        __syncthreads();
        { const int cb = wave >> 1;
#pragma unroll
          for (int i = 0; i < 2; ++i) { const int sb = 2 * (wave & 1) + i; f32x4 s = (f32x4){0.f, 0.f, 0.f, 0.f};
              if (sb <= cb) {
#pragma unroll
                  for (int ks = 0; ks < 4; ++ks) { const bf16x8 qa = *(const LAS bf16x8*)(lds + GC_QD + (cb * 16 + li) * 272 + (ks * 32 + 8 * g) * 2), kb = *(const LAS bf16x8*)(lds + GC_KI + (sb * 16 + li) * 272 + (ks * 32 + 8 * g) * 2);
                      s = mfma16(qa, kb, s); } }
#pragma unroll
              for (int r = 0; r < 4; ++r) { const int c = cb * 16 + 4 * g + r, sc = sb * 16 + li; *(LAS bf16_t*)(lds + GC_ATT + c * 144 + sc * 2) = f2bf(sc <= c ? s[r] : 0.f); } } }
        __syncthreads();
        f32x4 acc[4][2];
#pragma unroll
        for (int cb = 0; cb < 4; ++cb)
#pragma unroll
            for (int i = 0; i < 2; ++i) acc[cb][i] = (f32x4){0.f, 0.f, 0.f, 0.f};
#pragma unroll
        for (int ks = 0; ks < 2; ++ks) { bf16x8 vf[2];
#pragma unroll
            for (int i = 0; i < 2; ++i) { const LAS unsigned char* p = lds + GC_V + (ks * 32 + 8 * g + (li >> 2)) * 528 + ((wave * 2 + i) * 16 + 4 * (li & 3)) * 2; vf[i] = cat8(vtr(p), vtr(p + 4 * 528)); }
#pragma unroll
            for (int cb = 0; cb < 4; ++cb) { const bf16x8 af = *(const LAS bf16x8*)(lds + GC_ATT + (cb * 16 + li) * 144 + (ks * 32 + 8 * g) * 2);
#pragma unroll
                for (int i = 0; i < 2; ++i) acc[cb][i] = mfma16(af, vf[i], acc[cb][i]); } }
#pragma unroll
        for (int ks = 0; ks < 4; ++ks)
#pragma unroll
            for (int cb = 0; cb < 4; ++cb) { const bf16x8 qa = *(const LAS bf16x8*)(lds + GC_QD + (cb * 16 + li) * 272 + (ks * 32 + 8 * g) * 2);
#pragma unroll
                for (int i = 0; i < 2; ++i) acc[cb][i] = mfma16(qa, sf[i][ks], acc[cb][i]); }
        LAS float* ss = (LAS float*)(lds + GC_SS);
#pragma unroll
        for (int cb = 0; cb < 4; ++cb)
#pragma unroll
            for (int r = 0; r < 4; ++r) { float q = acc[cb][0][r] * acc[cb][0][r] + acc[cb][1][r] * acc[cb][1][r];
                q += __shfl_xor(q, 1); q += __shfl_xor(q, 2); q += __shfl_xor(q, 4); q += __shfl_xor(q, 8);
                if (li == 0) ss[(cb * 16 + 4 * g + r) * 8 + wave] = q; }
        __syncthreads();
        LAS float* ost = (LAS float*)(lds + GC_OST);
#pragma unroll
        for (int cb = 0; cb < 4; ++cb)
#pragma unroll
            for (int r = 0; r < 4; ++r) { const int c = cb * 16 + 4 * g + r; const f32x4 s0 = *(const LAS f32x4*)(ss + c * 8), s1 = *(const LAS f32x4*)(ss + c * 8 + 4);
                const float rstd = rsqrtf(((s0.x + s0.y) + (s0.z + s0.w) + (s1.x + s1.y) + (s1.z + s1.w)) * (1.f / 256.f) + EPS);
#pragma unroll
                for (int i = 0; i < 2; ++i) ost[c * 260 + (wave * 2 + i) * 16 + li] = acc[cb][i][r] * rstd; }
        __syncthreads();
        const float* ng = a->in[I_GNG] + l * 256;
#pragma unroll
        for (int i = 0; i < 4; ++i) { const int idx = tid + i * 512, c = idx >> 5, e8 = idx & 31;
            const f32x4 o0 = *(const LAS f32x4*)(ost + c * 260 + e8 * 8), o1 = *(const LAS f32x4*)(ost + c * 260 + e8 * 8 + 4);
            const f32x4 n0 = *(const f32x4*)(ng + e8 * 8), n1 = *(const f32x4*)(ng + e8 * 8 + 4);
            const u32x4 gg = *(const u32x4*)(P + (size_t)(t0 + c) * DINP + C_GG + h * 256 + e8 * 8);
            u32x4 pk;
            pk.x = cvt_pk_bf16(o0.x * n0.x * silu(bflo(gg.x)), o0.y * n0.y * silu(bfhi(gg.x))); pk.y = cvt_pk_bf16(o0.z * n0.z * silu(bflo(gg.y)), o0.w * n0.w * silu(bfhi(gg.y)));
            pk.z = cvt_pk_bf16(o1.x * n1.x * silu(bflo(gg.z)), o1.y * n1.y * silu(bfhi(gg.z))); pk.w = cvt_pk_bf16(o1.z * n1.z * silu(bflo(gg.w)), o1.w * n1.w * silu(bfhi(gg.w)));
            *(u32x4*)(mix + (size_t)(t0 + c) * DM + M_GLA + h * 256 + e8 * 8) = pk; }
    }
    __syncthreads();
}

typedef float f32x16 __attribute__((ext_vector_type(16)));
template <int OFF> __device__ __forceinline__ s16x4 vtr_a(unsigned addr) { s16x4 r; asm volatile("ds_read_b64_tr_b16 %0, %1 offset:%2" : "=v"(r) : "v"(addr), "n"(OFF)); return r; }
#define FX_LGKM0(x) asm volatile("s_waitcnt lgkmcnt(0)" : "+v"(x[0][0][0]), "+v"(x[0][0][1]), "+v"(x[0][1][0]), "+v"(x[0][1][1]), "+v"(x[1][0][0]), "+v"(x[1][0][1]), "+v"(x[1][1][0]), "+v"(x[1][1][1]) :: "memory")
constexpr int FX_F = 0, FX_K = 8192, FX_TILE = 32768, FX_V = FX_K + FX_TILE, FX_BUF = 2 * FX_TILE, FX_MG = FX_K  , FX_WS = FX_K + 2 * FX_BUF, FX_END = FX_WS + 64;
static_assert(FX_END <= MISC_OFF && 3 * 2 * 64 * 66 * 4 <= 2 * FX_BUF, "FoX LDS");
__device__ __forceinline__ void fox_phase(ArgP a, LAS unsigned char* lds, int l) {
    const int tid = opaque_tid(), lane = tid & 63, wave = tid >> 6, wv = __builtin_amdgcn_readfirstlane(tid >> 6), r32 = lane & 31, hh = lane >> 5, rg = wave & 1, kg = wave >> 1;
    const bf16_t* P = (const bf16_t*)(a->ws + WS_P); bf16_t* mix = (bf16_t*)(a->ws + WS_MIX);
    LAS float* Fs = (LAS float*)(lds + FX_F); LAS float* wsum = (LAS float*)(lds + FX_WS);
    constexpr float C1 = 0.08838834764831845f * LOG2E;
    const int k_off = (32 * kg + r32) * 256 + (((r32 & 15) ^ hh) << 4);
    const int v_off = (32 * kg + 4 * hh + ((lane >> 2) & 3)) * 256 + (((lane >> 2) & 3) << 6) + ((2 * ((lane >> 4) & 1) + ((lane & 3) >> 1)) << 4) + ((lane & 1) << 3);
    unsigned dk_o[4]; const unsigned dv_o = (unsigned)((lane >> 4) * (DINP * 2) + C_FV * 2 + (((lane & 15) ^ ((lane >> 4) << 2)) << 4));
#pragma unroll
    for (int j = 0; j < 4; ++j) dk_o[j] = (unsigned)((lane >> 4) * (DINP * 2) + C_FK * 2 + (((lane & 15) ^ (4 * j + (lane >> 4))) << 4));
#define FX_DMA(bo_, key0_) do { const char* _g = (const char*)(P + ((size_t)(b * SEQ + (key0_) + 16 * wv) * DINP + h * 128)); \
        _Pragma("unroll") for (int _j = 0; _j < 4; ++_j) { const char* _r = _g + (size_t)(4 * _j) * DINP * 2; \
            __builtin_amdgcn_global_load_lds((const unsigned*)(_r + dk_o[_j]), (LAS unsigned*)(lds + (bo_) + FX_K + wv * 4096 + _j * 1024), 16, 0, 0); \
            __builtin_amdgcn_global_load_lds((const unsigned*)(_r + dv_o), (LAS unsigned*)(lds + (bo_) + FX_V + wv * 4096 + _j * 1024), 16, 0, 0); } } while (0)
    for (int pr = blockIdx.x; pr < 256; pr += gridDim.x) {
        const int bh = pr & 15, b = bh >> 2, h = bh & 3, rr = pr >> 4;
        { const int t2 = opaque_tid(), ln = t2 & 63, wq = t2 >> 6;
          bf16_t fraw[4];
#pragma unroll
          for (int j = 0; j < 4; ++j) fraw[j] = P[(size_t)(b * SEQ + t2 * 4 + j) * DINP + C_FF + h];
          __syncthreads();
          const float fb = a->in[I_FFB][l * 4 + h]; float v[4]; float run = 0.f;
#pragma unroll
          for (int j = 0; j < 4; ++j) { run += log_sigmoid(bf2f(fraw[j]) + fb); v[j] = run; }
          float inc = run;
#pragma unroll
          for (int o = 1; o < 64; o <<= 1) { const float t = __shfl_up(inc, o); if (ln >= o) inc += t; }
          if (ln == 63) wsum[wq] = inc;
          __syncthreads();
          float pre = inc - run;
#pragma unroll
          for (int q = 0; q < 8; ++q) pre += (q < wq) ? wsum[q] : 0.f;
          *(LAS f32x4*)(Fs + t2 * 4) = (f32x4){(v[0] + pre) * LOG2E, (v[1] + pre) * LOG2E, (v[2] + pre) * LOG2E, (v[3] + pre) * LOG2E}; }
        __syncthreads();
#pragma unroll 1
        for (int half = 0; half < 2; ++half) {
            const int qb = half == 0 ? 31 - rr : rr, q0 = qb * 64, qrow = q0 + rg * 32 + r32, nsteps = (qb + 2) >> 1;
            bf16x8 qf[8];
#pragma unroll
            for (int ks = 0; ks < 8; ++ks) qf[ks] = *(const bf16x8*)(P + (size_t)(b * SEQ + qrow) * DINP + C_FQ + h * 128 + ks * 16 + 8 * hh);
            const float Fq = Fs[qrow];
            float m = -1e30f, lsum = 0.f; f32x16 O[4];
#pragma unroll
            for (int j = 0; j < 4; ++j)
#pragma unroll
                for (int r = 0; r < 16; ++r) O[j][r] = 0.f;
            __syncthreads();
            FX_DMA(0, 0);
            if (1 < nsteps) { FX_DMA(FX_BUF, 128); asm volatile("s_waitcnt vmcnt(8)" ::: "memory"); } else asm volatile("s_waitcnt vmcnt(0)" ::: "memory");
            __builtin_amdgcn_s_barrier();
#pragma unroll 1
            for (int st = 0; st < nsteps; ++st) {
                const int kb0 = st * 128, bo = (st & 1) * FX_BUF;
                const int kw0 = kb0 + 32 * kg;
                if (kw0 <= q0 + rg * 32 + 31) {
                    bf16x8 kf[8];
#pragma unroll
                    for (int ks = 0; ks < 8; ++ks) kf[ks] = *(const LAS bf16x8*)(lds + bo + FX_K + (k_off ^ (ks << 5)));
                    __builtin_amdgcn_sched_barrier(0);
                    f32x16 sc;
#pragma unroll
                    for (int r = 0; r < 16; ++r) sc[r] = 0.f;
#pragma unroll
                    for (int ks = 0; ks < 8; ++ks) sc = __builtin_amdgcn_mfma_f32_32x32x16_bf16(kf[ks], qf[ks], sc, 0, 0, 0);
                    s16x4 vf[2][2][2], vg[2][2][2]; f32x4 fk[4];
#pragma unroll
                    for (int db = 0; db < 2; ++db) { const unsigned vp = (unsigned)(size_t)(lds + bo + FX_V) + (unsigned)(v_off ^ (db << 6));
                        vf[db][0][0] = vtr_a<0>(vp); vf[db][0][1] = vtr_a<2048>(vp); vf[db][1][0] = vtr_a<4096>(vp); vf[db][1][1] = vtr_a<6144>(vp); }
#pragma unroll
                    for (int i = 0; i < 4; ++i) fk[i] = *(const LAS f32x4*)(Fs + kw0 + 8 * i + 4 * hh);
                    __builtin_amdgcn_sched_barrier(0);
                    FX_LGKM0(vf);
#pragma unroll
                    for (int i = 0; i < 4; ++i)
#pragma unroll
                        for (int j = 0; j < 4; ++j) sc[4 * i + j] = sc[4 * i + j] * C1 + (Fq - fk[i][j]);
                    if (kw0 + 31 > q0 + rg * 32) {
#pragma unroll
                        for (int r = 0; r < 16; ++r) if (kw0 + (r & 3) + 8 * (r >> 2) + 4 * hh > qrow) sc[r] = -__builtin_inff(); }
                    float mx = sc[0];
#pragma unroll
                    for (int r = 1; r < 16; ++r) mx = fmaxf(mx, sc[r]);
                    mx = fmaxf(mx, __shfl_xor(mx, 32));
                    const float mn = fmaxf(m, mx), alpha = __builtin_amdgcn_exp2f(m - mn); m = mn;
                    float ps = 0.f;
#pragma unroll
                    for (int r = 0; r < 16; ++r) { sc[r] = __builtin_amdgcn_exp2f(sc[r] - mn); ps += sc[r]; }
                    bf16x8 pf[2];
#pragma unroll
                    for (int s2 = 0; s2 < 2; ++s2) { u32x4 w; w.x = cvt_pk_bf16(sc[8 * s2], sc[8 * s2 + 1]); w.y = cvt_pk_bf16(sc[8 * s2 + 2], sc[8 * s2 + 3]); w.z = cvt_pk_bf16(sc[8 * s2 + 4], sc[8 * s2 + 5]); w.w = cvt_pk_bf16(sc[8 * s2 + 6], sc[8 * s2 + 7]);
                        pf[s2] = __builtin_bit_cast(bf16x8, w); }
                    lsum = lsum * alpha + ps;
                    if (!__all(alpha == 1.f)) {
#pragma unroll
                        for (int db = 0; db < 4; ++db)
#pragma unroll
                            for (int r = 0; r < 16; ++r) O[db][r] *= alpha; }
                    __builtin_amdgcn_sched_barrier(0);
#pragma unroll
                    for (int db = 0; db < 2; ++db) { const unsigned vp = (unsigned)(size_t)(lds + bo + FX_V) + (unsigned)(v_off ^ ((db + 2) << 6));
                        vg[db][0][0] = vtr_a<0>(vp); vg[db][0][1] = vtr_a<2048>(vp); vg[db][1][0] = vtr_a<4096>(vp); vg[db][1][1] = vtr_a<6144>(vp); }
#pragma unroll
                    for (int db = 0; db < 2; ++db)
#pragma unroll
                        for (int s2 = 0; s2 < 2; ++s2) O[db] = __builtin_amdgcn_mfma_f32_32x32x16_bf16(cat8(vf[db][s2][0], vf[db][s2][1]), pf[s2], O[db], 0, 0, 0);
                    __builtin_amdgcn_sched_barrier(0);
                    FX_LGKM0(vg);
#pragma unroll
                    for (int db = 0; db < 2; ++db)
#pragma unroll
                        for (int s2 = 0; s2 < 2; ++s2) O[db + 2] = __builtin_amdgcn_mfma_f32_32x32x16_bf16(cat8(vg[db][s2][0], vg[db][s2][1]), pf[s2], O[db + 2], 0, 0, 0);
                }
                asm volatile("s_waitcnt vmcnt(0)" ::: "memory");
                __builtin_amdgcn_s_barrier();
                if (st + 2 < nsteps) FX_DMA(bo, kb0 + 256);
            }
            lsum += __shfl_xor(lsum, 32);
            LAS float* mg = (LAS float*)(lds + FX_MG);
            if (kg > 0) { LAS float* q = mg + (((kg - 1) * 2 + rg) * 64 + lane) * 66; q[0] = m; q[1] = lsum;
#pragma unroll
                for (int db = 0; db < 4; ++db)
#pragma unroll
                    for (int r = 0; r < 16; ++r) q[2 + db * 16 + r] = O[db][r]; }
            __syncthreads();
            if (kg == 0) { float mn = m;
#pragma unroll
                for (int j = 0; j < 3; ++j) mn = fmaxf(mn, mg[((j * 2 + rg) * 64 + lane) * 66]);
                float a0 = __builtin_amdgcn_exp2f(m - mn), lt = lsum * a0;
#pragma unroll
                for (int db = 0; db < 4; ++db)
#pragma unroll
                    for (int r = 0; r < 16; ++r) O[db][r] *= a0;
#pragma unroll
                for (int j = 0; j < 3; ++j) { const LAS float* q = mg + ((j * 2 + rg) * 64 + lane) * 66; const float aj = __builtin_amdgcn_exp2f(q[0] - mn); lt += q[1] * aj;
#pragma unroll
                    for (int db = 0; db < 4; ++db)
#pragma unroll
                        for (int r = 0; r < 16; ++r) O[db][r] += q[2 + db * 16 + r] * aj; }
                const float inv = 1.f / lt;
                bf16_t* orow = mix + (size_t)(b * SEQ + qrow) * DM + M_FOX + h * 128 + 4 * hh;
#pragma unroll
                for (int db = 0; db < 4; ++db)
#pragma unroll
                    for (int i = 0; i < 4; ++i) { u32x2 w; w.x = cvt_pk_bf16(O[db][4 * i] * inv, O[db][4 * i + 1] * inv); w.y = cvt_pk_bf16(O[db][4 * i + 2] * inv, O[db][4 * i + 3] * inv);
                        *(u32x2*)(orow + db * 32 + 8 * i) = w; } }
        }
    }
#undef FX_DMA
    __syncthreads();
}

constexpr int RT_RS = 0, RT_PART = 256, RT_END = RT_PART + 8 * 32 * 48 * 4;
__device__ __forceinline__ void router_phase(ArgP a, LAS unsigned char* lds, int l, const bf16_t* x1) {
    const int tid = opaque_tid(), lane = tid & 63, wave = tid >> 6, g = lane >> 4, li = lane & 15;
    LAS float* rsd = (LAS float*)(lds + RT_RS); LAS float* part = (LAS float*)(lds + RT_PART);
    const float* g2 = a->in[I_N2G] + l * DM; bf16_t* h2 = (bf16_t*)(a->ws + WS_H);
    const bf16_t* wr = (const bf16_t*)(a->ws + WS_WR) + (size_t)l * 2 * 48 * DM;
    unsigned* cnt = (unsigned*)(a->ws + WS_CTL) + CW_CNT + l * 32 * 64; int* list = (int*)(a->ws + WS_LIST); float* gwb = (float*)(a->ws + WS_GW);
    for (int item = blockIdx.x; item < T / 32; item += gridDim.x) {
        const int tk0 = item * 32;
        __syncthreads();
        { u32x4 q[4][4];
#pragma unroll
          for (int r = 0; r < 4; ++r)
#pragma unroll
              for (int j = 0; j < 4; ++j) q[r][j] = ((const u32x4*)(x1 + (size_t)(tk0 + wave * 4 + r) * DM) + lane)[64 * j];
          f32x4 ga[4], gb[4];
#pragma unroll
          for (int j = 0; j < 4; ++j) { ga[j] = ((const f32x4*)g2)[2 * (lane + 64 * j)]; gb[j] = ((const f32x4*)g2)[2 * (lane + 64 * j) + 1]; }
#pragma unroll
          for (int r = 0; r < 4; ++r) { const int row = wave * 4 + r; float s = 0.f;
#pragma unroll
              for (int j = 0; j < 4; ++j) { const u32x4 w = q[r][j]; s += (bflo(w.x) * bflo(w.x) + bfhi(w.x) * bfhi(w.x)) + (bflo(w.y) * bflo(w.y) + bfhi(w.y) * bfhi(w.y)) + (bflo(w.z) * bflo(w.z) + bfhi(w.z) * bfhi(w.z)) + (bflo(w.w) * bflo(w.w) + bfhi(w.w) * bfhi(w.w)); }
              const float rstd = rsqrtf(wave_sum(s) * (1.f / DM) + EPS);
              if (lane == 0) rsd[row] = rstd;
              u32x4* o = (u32x4*)(h2 + (size_t)(tk0 + row) * DM) + lane;
#pragma unroll
              for (int j = 0; j < 4; ++j) { const u32x4 x = q[r][j]; u32x4 w;
                  w.x = cvt_pk_bf16(bflo(x.x) * rstd * ga[j].x, bfhi(x.x) * rstd * ga[j].y); w.y = cvt_pk_bf16(bflo(x.y) * rstd * ga[j].z, bfhi(x.y) * rstd * ga[j].w);
                  w.z = cvt_pk_bf16(bflo(x.z) * rstd * gb[j].x, bfhi(x.z) * rstd * gb[j].y); w.w = cvt_pk_bf16(bflo(x.w) * rstd * gb[j].z, bfhi(x.w) * rstd * gb[j].w); o[64 * j] = w; } } }
        __syncthreads();
        { const int kq = wave;
          f32x4 acc[2][3];
#pragma unroll
          for (int mb = 0; mb < 2; ++mb)
#pragma unroll
              for (int cb = 0; cb < 3; ++cb) acc[mb][cb] = (f32x4){0.f, 0.f, 0.f, 0.f};
          const bf16_t* xrow = x1 + (size_t)(tk0 + li) * DM + kq * 256 + 8 * g; const bf16_t* wq = wr + kq * 256 + 8 * g;
#pragma unroll 2
          for (int ks = 0; ks < 8; ++ks) {
              const bf16x8 ax0 = *(const bf16x8*)(xrow + ks * 32), ax1 = *(const bf16x8*)(xrow + (size_t)16 * DM + ks * 32);
#pragma unroll
              for (int cb = 0; cb < 3; ++cb) { const bf16x8 wh = *(const bf16x8*)(wq + (size_t)(cb * 16 + li) * DM + ks * 32), wl = *(const bf16x8*)(wq + (size_t)(48 + cb * 16 + li) * DM + ks * 32);
                  acc[0][cb] = mfma16(ax0, wh, acc[0][cb]); acc[0][cb] = mfma16(ax0, wl, acc[0][cb]); acc[1][cb] = mfma16(ax1, wh, acc[1][cb]); acc[1][cb] = mfma16(ax1, wl, acc[1][cb]); }
          }
#pragma unroll
          for (int mb = 0; mb < 2; ++mb)
#pragma unroll
              for (int cb = 0; cb < 3; ++cb)
#pragma unroll
                  for (int r = 0; r < 4; ++r) part[(kq * 32 + mb * 16 + 4 * g + r) * 48 + cb * 16 + li] = acc[mb][cb][r] * rsd[mb * 16 + 4 * g + r]; }
        __syncthreads();
        if (tid < 32) {
            const int tok = tk0 + tid; float lg[36];
#pragma unroll
            for (int c = 0; c < 36; ++c) lg[c] = 0.f;
#pragma unroll 1
            for (int q = 0; q < 8; ++q) {
#pragma unroll
                for (int c = 0; c < 36; ++c) lg[c] += part[(q * 32 + tid) * 48 + c]; }
            float gl[4]; int grp = 0; float gmx;
#pragma unroll
            for (int c = 0; c < 4; ++c) gl[c] = lg[c] + a->in[I_RGB][l * 4 + c];
            gmx = gl[0];
#pragma unroll
            for (int c = 1; c < 4; ++c) if (gl[c] > gmx) { gmx = gl[c]; grp = c; }
            float den = 0.f;
#pragma unroll
            for (int c = 0; c < 4; ++c) den += __expf(gl[c] - gmx);
            const float ptop = 1.f / den;
            float v1 = -__builtin_inff(), v2 = -__builtin_inff(); int i1 = 0, i2 = 0;
#pragma unroll
            for (int e = 0; e < 8; ++e) { float ev = 0.f;
#pragma unroll
                for (int q = 0; q < 4; ++q) ev = (grp == q) ? lg[4 + q * 8 + e] : ev;
                const float v = ev + a->in[I_REB][(l * 4 + grp) * 8 + e];
                if (v > v1) { v2 = v1; i2 = i1; v1 = v; i1 = e; } else if (v > v2) { v2 = v; i2 = e; } }
            const float w1 = ptop / (1.f + __expf(v2 - v1)), w2 = ptop - w1;
            const int E1 = grp * 8 + i1, E2 = grp * 8 + i2;
            const unsigned s1 = atomicAdd(cnt + E1 * 64, 1u), s2 = atomicAdd(cnt + E2 * 64, 1u);
            list[E1 * CAPE + s1] = tok * 2; gwb[E1 * CAPE + s1] = w1;
            list[E2 * CAPE + s2] = tok * 2 + 1; gwb[E2 * CAPE + s2] = w2;
        }
    }
    __syncthreads();
}
__device__ __forceinline__ void moe_setup(ArgP a, LAS int* tab, int l) {
    __syncthreads();
    if (threadIdx.x < 32) { unsigned* cnt = (unsigned*)(a->ws + WS_CTL) + CW_CNT + l * 32 * 64; tab[33 + threadIdx.x] = (int)__hip_atomic_load(cnt + threadIdx.x * 64, __ATOMIC_RELAXED, __HIP_MEMORY_SCOPE_AGENT); }
    __syncthreads();
    if (threadIdx.x == 0) { int ts = 0; for (int e = 0; e < 32; ++e) { tab[e] = ts; tab[65 + e] = ts * 256; ts += (tab[33 + e] + 255) >> 8; } tab[32] = ts; }
    __syncthreads();
}
__device__ __forceinline__ void combine_phase(ArgP a, int l, const bf16_t* x1, bf16_t* x2) {
    const int tid = opaque_tid(), lane = tid & 63, wave = tid >> 6;
    const int gw = blockIdx.x * NWAVES + wave, NGW = gridDim.x * NWAVES;
    const bf16_t* Y = (const bf16_t*)(a->ws + WS_Y);
    const float* g = (l + 1 < DEPTH) ? a->in[I_N1G] + (l + 1) * DM : a->in[I_FNG];
    u32x2 rx[8], ry0[8], ry1[8];
#define CB_LOAD(m_) do { const u32x2* xr = (const u32x2*)(x1 + (size_t)(m_) * DM) + lane; const u32x2* y0 = (const u32x2*)(Y + (size_t)(2 * (m_)) * DM) + lane; const u32x2* y1 = (const u32x2*)(Y + (size_t)(2 * (m_) + 1) * DM) + lane; \
        _Pragma("unroll") for (int j = 0; j < 8; ++j) { rx[j] = xr[64 * j]; ry0[j] = y0[64 * j]; ry1[j] = y1[64 * j]; } } while (0)
    if (gw < T) CB_LOAD(gw);
    for (int m = gw; m < T; m += NGW) {
        f32x4 v[8]; float s = 0.f;
#pragma unroll
        for (int j = 0; j < 8; ++j) { const u32x2 xx = rx[j], a0 = ry0[j], a1 = ry1[j];
            v[j] = (f32x4){bflo(xx.x) + (bflo(a0.x) + bflo(a1.x)), bfhi(xx.x) + (bfhi(a0.x) + bfhi(a1.x)), bflo(xx.y) + (bflo(a0.y) + bflo(a1.y)), bfhi(xx.y) + (bfhi(a0.y) + bfhi(a1.y))};
            s += (v[j].x * v[j].x + v[j].y * v[j].y) + (v[j].z * v[j].z + v[j].w * v[j].w); }
        if (m + NGW < T) CB_LOAD(m + NGW);
        const float rstd = rsqrtf(wave_sum(s) * (1.f / DM) + EPS);
        if (l + 1 < DEPTH) {
            u32x2* xo = (u32x2*)(x2 + (size_t)m * DM) + lane; u32x2* o = (u32x2*)((bf16_t*)(a->ws + WS_H) + (size_t)m * DM) + lane;
#pragma unroll
            for (int j = 0; j < 8; ++j) { u32x2 xw; xw.x = cvt_pk_bf16(v[j].x, v[j].y); xw.y = cvt_pk_bf16(v[j].z, v[j].w); xo[64 * j] = xw;
                const f32x4 gg = ((const f32x4*)g)[lane + 64 * j]; u32x2 w; w.x = cvt_pk_bf16(v[j].x * rstd * gg.x, v[j].y * rstd * gg.y); w.y = cvt_pk_bf16(v[j].z * rstd * gg.z, v[j].w * rstd * gg.w); o[64 * j] = w; }
        } else {
            f32x4* oo = (f32x4*)(a->out + (size_t)m * DM) + lane;
#pragma unroll
            for (int j = 0; j < 8; ++j) { const f32x4 gg = ((const f32x4*)g)[lane + 64 * j]; oo[64 * j] = (f32x4){v[j].x * rstd * gg.x, v[j].y * rstd * gg.y, v[j].z * rstd * gg.z, v[j].w * rstd * gg.w}; }
        }
    }
}

constexpr int PH_PER_LAYER = 9, N_PHASES = 1 + DEPTH * PH_PER_LAYER;
#ifndef PH_MASK
#define PH_MASK 0x3ff
#endif
__global__ void __launch_bounds__(NTHR, 2) fwd(Args) {
    extern __shared__ __attribute__((aligned(16))) unsigned char lds_raw[];
    LAS unsigned char* lds = (LAS unsigned char*)lds_raw;
    volatile LAS unsigned* MISC = (volatile LAS unsigned*)(lds + MISC_OFF);
    LAS int* tab = (LAS int*)(lds + MISC_OFF + 64);
    if (threadIdx.x < 256) MISC[threadIdx.x] = 0u;
    __syncthreads();
    int lo, hi; XcdBarrier bar;
    { ArgP a = kargs(); lo = a->ph_lo; hi = a->ph_hi; bar.bar = (unsigned*)(a->ws + WS_CTL) + CW_BAR; bar.x = 0; bar.st = nullptr;
      if (!MK_PER_PHASE) bar = xcd_barrier_post((unsigned*)(a->ws + WS_CTL) + CW_BAR, MISC); }
#define IN(k) (lo <= (k) && (k) < hi)
#define EN(j) ((PH_MASK >> (j)) & 1)
#ifndef REP_MASK
#define REP_MASK 0
#endif
#define REP(j) for (int _rep = 0; _rep < 1 + ((REP_MASK >> (j)) & 1); ++_rep)
#define SEAM(k) do { if (!MK_PER_PHASE && IN(k) && IN((k) + 1)) xcd_barrier(bar); } while (0)
    if (EN(0) && IN(0)) REP(0) { p0_prologue(kargs(), lds); __syncthreads(); }
    SEAM(0);
#pragma unroll 1
    for (int l = 0; l < DEPTH; ++l) {
        const int p0 = 1 + l * PH_PER_LAYER;
        if (EN(1) && IN(p0 + 0)) REP(1) { ArgP a = kargs();
            pg::DenseSched<DM> S; S.init((const bf16_t*)(a->ws + WS_WIN) + (size_t)l * DINP * DM, T, DINP, gridDim.x, blockIdx.x);
            pg::EpiBf16 E{(bf16_t*)(a->ws + WS_P), DINP};
            pg::gemm_phase<DM, pg::EpiBf16, pg::DenseSched<DM>>(lds, (const char*)(a->ws + WS_H), S, E);
            if (l == 0) { int rk, nr; idle_rank((T / 256) * (DINP / 256), gridDim.x, blockIdx.x, rk, nr); if (rk >= 0) cvt_range(kargs(), lds, CV_N_IN, CV_I_OUT, rk, nr); __syncthreads(); }
        }
        SEAM(p0 + 0);
        if (EN(2) && IN(p0 + 1)) { REP(2) conv_phase(kargs(), lds, l); REP(10) gla_a_phase(kargs(), lds, l); }
        SEAM(p0 + 1);
        if (EN(3) && IN(p0 + 2)) { gla_b_phase(kargs()); REP(3) fox_phase(kargs(), lds, l); }
        SEAM(p0 + 2);
        if (EN(4) && IN(p0 + 3)) REP(4) { gla_c_phase(kargs(), lds, l); }
        SEAM(p0 + 3);
        if (EN(5) && IN(p0 + 4)) REP(5) { ArgP a = kargs();
            pg::DenseSched<DM> S; S.init((const bf16_t*)(a->ws + WS_WOUT) + (size_t)l * DM * DM, T, DM, gridDim.x, blockIdx.x);
            pg::EpiRes E{(const bf16_t*)(a->ws + WS_XB), (bf16_t*)(a->ws + WS_XA), DM};
            pg::gemm_phase<DM, pg::EpiRes, pg::DenseSched<DM>>(lds, (const char*)(a->ws + WS_MIX), S, E);
        }
        SEAM(p0 + 4);
        if (EN(6) && IN(p0 + 5)) { ArgP a = kargs(); router_phase(a, lds, l, (const bf16_t*)(a->ws + WS_XA)); }
        SEAM(p0 + 5);
        if (EN(7) && IN(p0 + 6)) REP(7) { ArgP a = kargs();
            moe_setup(a, tab, l);
            const int vcu = (gridDim.x % 8 == 0) ? (int)((blockIdx.x % 8) * (gridDim.x / 8) + blockIdx.x / 8) : (int)blockIdx.x;
            pg::MoeSchedRB<DM, 8, true> S{a->in[I_WG] + (size_t)l * NEX * DM * DE, a->in[I_WU] + (size_t)l * NEX * DM * DE, tab, (const int*)(a->ws + WS_LIST), (int)gridDim.x, vcu};
#ifndef RBP
#define RBP 0
#endif
            pg::EpiGateUpRB E{(bf16_t*)(a->ws + (_rep ? WS_WGU : WS_HB)), (const float*)(a->ws + WS_GW)};
            pg::gemm_rb<DM, DE, pg::EpiGateUpRB, pg::MoeSchedRB<DM, 8, true>>(lds, (const char*)(a->ws + WS_H), S, E);
            if (l == 0) { int rk, nr; idle_rank(tab[32] * 8, gridDim.x, vcu, rk, nr); if (rk >= 0) { cvt_range(kargs(), lds, CV_I_IN, CV_I_IN, rk, nr); cvt_range(kargs(), lds, CV_N_IN + CV_I_OUT, CV_I_OUT, rk, nr); } __syncthreads(); }
        }
        SEAM(p0 + 6);
        if (EN(8) && IN(p0 + 7)) REP(8) { ArgP a = kargs();
            moe_setup(a, tab, l);
            const int vcu = (gridDim.x % 8 == 0) ? (int)((blockIdx.x % 8) * (gridDim.x / 8) + blockIdx.x / 8) : (int)blockIdx.x;
            pg::MoeSchedRB<DE, 16, false> S{a->in[I_WD] + (size_t)l * NEX * DE * DM, nullptr, tab, (const int*)(a->ws + WS_LIST), (int)gridDim.x, vcu};
            pg::EpiDownRB E{(bf16_t*)(a->ws + WS_Y), (const int*)(a->ws + WS_LIST)};
            pg::gemm_rb<DE, DM, pg::EpiDownRB, pg::MoeSchedRB<DE, 16, false>>(lds, (const char*)(a->ws + WS_HB), S, E);
        }
        SEAM(p0 + 7);
        if (EN(9) && IN(p0 + 8)) REP(9) { ArgP a = kargs(); combine_phase(a, l, (const bf16_t*)(a->ws + WS_XA), (bf16_t*)(a->ws + WS_XB)); }
        SEAM(p0 + 8);
    }
#undef IN
#undef EN
#undef SEAM
}

#ifdef DBG_STAGE
__global__ void dbg_dump(const unsigned char* ws, float* out, int kind) {
    for (size_t i = (size_t)blockIdx.x * blockDim.x + threadIdx.x; i < (size_t)T * DM; i += (size_t)gridDim.x * blockDim.x) {
        const size_t r = i / DM, c = i % DM; float v = 0.f;
        if (kind == 1) v = bf2f(((const bf16_t*)(ws + WS_P))[r * DINP + 2048 + c]);
        else if (kind == 2) v = bf2f(((const bf16_t*)(ws + WS_MIX))[i]);
        else if (kind == 7) v = c < 512 ? bf2f(((const bf16_t*)(ws + WS_MIX))[i]) : 0.f;
        else if (kind == 8) v = (c >= 512 && c < 1536) ? bf2f(((const bf16_t*)(ws + WS_MIX))[i]) : 0.f;
        else if (kind == 9) v = c >= 1536 ? bf2f(((const bf16_t*)(ws + WS_MIX))[i]) : 0.f;
        else if (kind == 10 || kind == 11) v = bf2f(((const bf16_t*)(ws + WS_KV))[i]);
        else if (kind == 12) v = ((const float*)(ws + WS_DEC))[i & 65535];
        else if (kind == 13) v = bf2f(((const bf16_t*)(ws + WS_P))[r * DINP + c]);
        else if (kind == 14) v = bf2f(((const bf16_t*)(ws + WS_P))[r * DINP + 3840 + c]);
        else if (kind == 3) v = bf2f(((const bf16_t*)(ws + WS_XA))[i]);
        else if (kind == 4) v = bf2f(((const bf16_t*)(ws + WS_XB))[i]);
        else if (kind == 5) v = bf2f(((const bf16_t*)(ws + WS_H))[i]);
        else if (kind == 6) v = ((const float*)(ws + WS_Y))[i] + ((const float*)(ws + WS_Y))[i + (size_t)T * DM];
        out[i] = v; }
}
#endif
extern "C" void kernel_launch(void* const* d_in, const int* in_sizes, int n_in, void* d_out, int out_size, void* d_ws, size_t ws_size, hipStream_t stream) {
    static int grid = 0;
    if (grid == 0) {
        if (n_in != 21 || ws_size < WS_END) { fprintf(stderr, "kernel_launch: need 21 inputs and %zu bytes of workspace (got %d, %zu)\n", (size_t)WS_END, n_in, ws_size); grid = -1; return; }
        int dev = 0, cus = 0, per_cu = 0;
        if (hipGetDevice(&dev) != hipSuccess || hipDeviceGetAttribute(&cus, hipDeviceAttributeMultiprocessorCount, dev) != hipSuccess) { grid = -1; return; }
        if (hipFuncSetAttribute((const void*)fwd, hipFuncAttributeMaxDynamicSharedMemorySize, LDS_BYTES) != hipSuccess) { fprintf(stderr, "kernel_launch: hipFuncSetAttribute failed\n"); grid = -1; return; }
        if (hipOccupancyMaxActiveBlocksPerMultiprocessor(&per_cu, (const void*)fwd, NTHR, LDS_BYTES) != hipSuccess || per_cu < 1) { fprintf(stderr, "kernel_launch: occupancy query says %d\n", per_cu); per_cu = 1; }
        (void)hipGetLastError();
        grid = cus;
    }
    if (grid < 0) return;
    (void)hipMemsetAsync((char*)d_ws + WS_CTL, 0, CTL_ZERO_BYTES, stream);
    Args a{};
    for (int i = 0; i < 21; ++i) a.in[i] = (const float*)d_in[i];
    a.out = (float*)d_out; a.ws = (unsigned char*)d_ws;
#ifdef DBG_STAGE
    { const int last[15] = {0, 1, 4, 5, 9, 6, 8, 4, 4, 4, 2, 3, 2, 1, 1}; for (int p = 0; p <= last[DBG_STAGE]; ++p) { a.ph_lo = p; a.ph_hi = p + 1; hipLaunchKernelGGL(fwd, dim3(grid), dim3(NTHR), LDS_BYTES, stream, a); }
      hipLaunchKernelGGL(dbg_dump, dim3(2048), dim3(256), 0, stream, (const unsigned char*)d_ws, (float*)d_out, DBG_STAGE); }
#elif MK_PER_PHASE
    for (int p = 0; p < N_PHASES; ++p) { a.ph_lo = p; a.ph_hi = p + 1; hipLaunchKernelGGL(fwd, dim3(grid), dim3(NTHR), LDS_BYTES, stream, a); }
#else
    a.ph_lo = 0; a.ph_hi = N_PHASES; hipLaunchKernelGGL(fwd, dim3(grid), dim3(NTHR), LDS_BYTES, stream, a);
#endif
}
```

```cpp
#include <hip/hip_runtime.h>
#include <cstdio>
#include <cstdint>

#ifndef MK_PER_PHASE
#define MK_PER_PHASE 0
#endif

#define LAS __attribute__((address_space(3)))
#define GAS __attribute__((address_space(1)))
typedef unsigned short bf16_t;
typedef short bf16x8 __attribute__((ext_vector_type(8)));
typedef short s16x4 __attribute__((ext_vector_type(4)));
typedef short v4i16_t __attribute__((ext_vector_type(4)));
typedef float f32x4 __attribute__((ext_vector_type(4)));
typedef float f32x2 __attribute__((ext_vector_type(2)));
typedef unsigned u32x4 __attribute__((ext_vector_type(4)));
typedef unsigned u32x2 __attribute__((ext_vector_type(2)));

constexpr int NB = 4, SEQ = 2048, T = NB * SEQ, DM = 2048, DEPTH = 2;
constexpr int DIN = 5652, DINP = 5888;
constexpr int C_CA = 0, C_CG = 512, C_GQ = 1024, C_GK = 1536, C_GV = 2048, C_GG = 3072, C_GLOW = 4096, C_FQ = 4112, C_FK = 4624, C_FV = 5136, C_FF = 5648;
constexpr int M_CONV = 0, M_GLA = 512, M_FOX = 1536;
constexpr int NEX = 32, DE = 512, CAPE = 8192, HROWS = 16384 + 32 * 256;
constexpr float EPS = 1e-6f;
constexpr float LOG2E = 1.4426950408889634f;

constexpr size_t MiB = 1u << 20;
constexpr size_t WS_CTL = 0, CTL_ZERO_BYTES = 64 * 1024;
constexpr size_t WS_WIN = 1 * MiB;
constexpr size_t WS_WOUT = 48 * MiB;
constexpr size_t WS_WGU = 64 * MiB;
constexpr size_t WS_WD = 320 * MiB;
constexpr size_t WS_WR = 448 * MiB;
constexpr size_t WS_XA = 449 * MiB;
constexpr size_t WS_XB = 513 * MiB;
constexpr size_t WS_H = 577 * MiB;
constexpr size_t WS_P = 609 * MiB;
constexpr size_t WS_MIX = 701 * MiB;
constexpr size_t WS_KV = 733 * MiB;
constexpr size_t WS_DEC = 765 * MiB;
constexpr size_t WS_LF = 765 * MiB + 512 * 1024;
constexpr size_t WS_CUM = 64 * MiB;
constexpr size_t WS_LIST = 766 * MiB;
constexpr size_t WS_GW = 767 * MiB;
constexpr size_t WS_HB = 768 * MiB;
constexpr size_t WS_Y = 792 * MiB;
constexpr size_t WS_END = 920 * MiB;
constexpr int CW_BAR = 0;
constexpr int CW_CNT = 4096;

constexpr int LDS_BYTES = 163840, MISC_OFF = LDS_BYTES - 1024;
constexpr int NWAVES = 8, NTHR = 512;

typedef __bf16 bf2_t __attribute__((ext_vector_type(2)));
__device__ __forceinline__ unsigned cvt_pk_bf16(float lo, float hi) { const f32x2 v = {lo, hi}; return __builtin_bit_cast(unsigned, __builtin_convertvector(v, bf2_t)); }
__device__ __forceinline__ bf16_t f2bf(float f) { return __builtin_bit_cast(bf16_t, (__bf16)f); }
__device__ __forceinline__ float bf2f(bf16_t b) { return __uint_as_float(((unsigned)b) << 16); }
__device__ __forceinline__ float bflo(unsigned w) { return __uint_as_float(w << 16); }
__device__ __forceinline__ float bfhi(unsigned w) { return __uint_as_float(w & 0xffff0000u); }
__device__ __forceinline__ float wave_sum(float v) {
#pragma unroll
    for (int o = 1; o < 64; o <<= 1) v += __shfl_xor(v, o);
    return v;
}
__device__ __forceinline__ float log_sigmoid(float x) { return fminf(x, 0.f) - __logf(1.f + __expf(-fabsf(x))); }
__device__ __forceinline__ float silu(float x) { return x * __builtin_amdgcn_rcpf(1.f + __expf(-x)); }
__device__ __forceinline__ s16x4 vtr(const LAS void* p) { return __builtin_bit_cast(s16x4, __builtin_amdgcn_ds_read_tr16_b64_v4i16((LAS v4i16_t*)p)); }
__device__ __forceinline__ bf16x8 cat8(s16x4 a, s16x4 b) { bf16x8 r; r[0] = a[0]; r[1] = a[1]; r[2] = a[2]; r[3] = a[3]; r[4] = b[0]; r[5] = b[1]; r[6] = b[2]; r[7] = b[3]; return r; }
__device__ __forceinline__ f32x4 mfma16(bf16x8 a, bf16x8 b, f32x4 c) { return __builtin_amdgcn_mfma_f32_16x16x32_bf16(a, b, c, 0, 0, 0); }
__device__ __forceinline__ int opaque_tid() { int t = threadIdx.x; asm volatile("" : "+v"(t)); return t; }
#define LDS_WAIT() asm volatile("s_waitcnt lgkmcnt(0)" ::: "memory")
#define VM_WAIT() asm volatile("s_waitcnt vmcnt(0)" ::: "memory")

#define XB_TMO      128
#define XB_XCNT(j)  (256  + 64 * (j))
#define XB_XSUB(j)  (1280 + 64 * (j))
#define XB_XGEN(j)  (2304 + 64 * (j))
#define XB_TOP      3328
#define XB_TOPGEN   3392
#define XCD_BAR_WORDS 3456
#define XB_SPIN_CAP (1u << 18)
__device__ __forceinline__ unsigned xb_ld(unsigned* p)              { return __hip_atomic_load(p, __ATOMIC_RELAXED, __HIP_MEMORY_SCOPE_AGENT); }
__device__ __forceinline__ unsigned xb_add(unsigned* p, unsigned v) { return __hip_atomic_fetch_add(p, v, __ATOMIC_RELAXED, __HIP_MEMORY_SCOPE_AGENT); }
__device__ __forceinline__ unsigned xb_xcc_id() { return (unsigned)__builtin_amdgcn_s_getreg((3 << 11) | 20) & 0xFu; }
#define XB_SPIN(cond, bar) do { unsigned _sp = 0; while (cond) { __builtin_amdgcn_s_sleep(1); \
    if ((++_sp & 255u) == 0u) { if (xb_ld(&(bar)[XB_TMO])) break; if (_sp > XB_SPIN_CAP) { atomicAdd(&(bar)[XB_TMO], 1u); break; } } } } while (0)
struct XcdBarrier { unsigned* bar; unsigned x; volatile LAS unsigned* st; };
__device__ __forceinline__ XcdBarrier xcd_barrier_post(unsigned* bar, volatile LAS unsigned* st) {
    XcdBarrier b; b.bar = bar; b.x = xb_xcc_id(); b.st = st;
    if (threadIdx.x == 0) (void)xb_add(&bar[XB_XCNT(b.x)], 1u);
    return b;
}
__device__ __forceinline__ void xcd_barrier_complete(unsigned* bar, unsigned x, unsigned& nloc, unsigned& nx) {
    const unsigned G = gridDim.x * gridDim.y * gridDim.z;
    unsigned sum, cnt, mine, sp = 0u;
    for (;;) {
        sum = 0u; cnt = 0u; mine = 0u;
#pragma unroll
        for (unsigned j = 0; j < 16; ++j) { const unsigned c = xb_ld(&bar[XB_XCNT(j)]); sum += c; cnt += (c > 0u) ? 1u : 0u; mine = (j == x) ? c : mine; }
        if (sum == G) break;
        __builtin_amdgcn_s_sleep(1);
        if ((++sp & 255u) == 0u) { if (xb_ld(&bar[XB_TMO])) break; if (sp > XB_SPIN_CAP) { atomicAdd(&bar[XB_TMO], 1u); break; } }
    }
    nloc = mine > 0u ? mine : 1u; nx = cnt > 0u ? cnt : 1u;
}
__device__ __forceinline__ void xcd_barrier(const XcdBarrier& b) {
    asm volatile("s_waitcnt vmcnt(0)" ::: "memory");
    __syncthreads();
    if (threadIdx.x == 0) {
        unsigned* bar = b.bar;
        __builtin_amdgcn_s_waitcnt(0);
        unsigned nloc = b.st[0], nx = b.st[1];
        if (nloc == 0u) { xcd_barrier_complete(bar, b.x, nloc, nx); b.st[0] = nloc; b.st[1] = nx; }
        const unsigned old = xb_add(&bar[XB_XSUB(b.x)], 1u);
        const unsigned gen = old / nloc;
        if (old + 1u == (gen + 1u) * nloc) {
            __builtin_amdgcn_fence(__ATOMIC_RELEASE, "agent");
            asm volatile("s_waitcnt vmcnt(0)" ::: "memory");
            const unsigned og = xb_add(&bar[XB_TOP], 1u);
            const unsigned tg = og / nx;
            if (og + 1u == (tg + 1u) * nx) xb_add(&bar[XB_TOPGEN], 1u);
            else XB_SPIN(xb_ld(&bar[XB_TOPGEN]) == tg, bar);
            __builtin_amdgcn_fence(__ATOMIC_ACQUIRE, "agent");
            xb_add(&bar[XB_XGEN(b.x)], 1u);
            asm volatile("s_waitcnt vmcnt(0)" ::: "memory");
        } else {
            XB_SPIN(xb_ld(&bar[XB_XGEN(b.x)]) == gen, bar);
            __builtin_amdgcn_fence(__ATOMIC_ACQUIRE, "agent");
            asm volatile("s_waitcnt vmcnt(0)" ::: "memory");
        }
    }
    __syncthreads();
}

namespace pg {
constexpr int BM = 256, BK = 64, HALF = 128, HTB = HALF * BK * 2, STAGE_BYTES = 8 * HTB;
__host__ __device__ __forceinline__ int lds_byte(int r, int c) { const int st = (r >> 4) * 2 + (c >> 5), rr = r & 15, cc = c & 31, ob = rr * 64 + cc * 2; return st * 1024 + (ob ^ (((ob >> 9) & 1) << 5)); }
__host__ __device__ __forceinline__ void stage_rc(int b, int& R, int& C) { const int st = b / 1024, sb = b % 1024, swz = sb ^ (((sb >> 9) & 1) << 5); R = (st >> 1) * 16 + swz / 64; C = (st & 1) * 32 + (swz % 64) / 2; }
__host__ __device__ __forceinline__ int perm32(int rho) { const int n = rho >> 4, i = rho & 15; return 8 * (i >> 2) + 4 * n + (i & 3); }

template <int K, class Epi, class Sched>
__device__ __forceinline__ void gemm_phase(LAS unsigned char* lds, const char* Abase, const Sched& S, const Epi& E) {
    typedef typename Sched::Unit Unit;
    const int tid = opaque_tid(), wid = __builtin_amdgcn_readfirstlane(tid >> 6), lane = tid & 63, wr = wid >> 2, wc = wid & 3, fr = lane & 15, fq = lane >> 4;
    constexpr int nt = K / BK;
    unsigned voffB[2]; int Rr[2], Cb;
#pragma unroll
    for (int i = 0; i < 2; ++i) { int R, C; stage_rc(tid * 16 + i * 8192, R, C); const int Rb = Epi::PERM ? ((R & ~31) + perm32(R & 31)) : R;
        Rr[i] = R; Cb = C * 2; voffB[i] = (unsigned)(Rb * K + C) * 2u; }
    constexpr size_t kstep = (size_t)(BK * 2);
    constexpr size_t hstep = (size_t)HALF * K * 2;
    const unsigned ldsw = (unsigned)wid * 1024u;
    const int aoff = lds_byte(wr * 64 + fr, fq * 8), boff = lds_byte(wc * 32 + fr, fq * 8);
#define PG_SA(b, h) (((b) * 2 + (h)) * HTB)
#define PG_SB(b, h) ((4 + (b) * 2 + (h)) * HTB)
#define PG_STAGE(bufoff, gbase, voff) do { _Pragma("unroll") for (int _i = 0; _i < 2; ++_i) \
        __builtin_amdgcn_global_load_lds((const unsigned*)((const char*)(gbase) + (voff)[_i]), (LAS unsigned*)(lds + (bufoff) + ldsw + _i * 8192), 16, 0, 0); } while (0)
#define PG_LDA(dst, b, h) do { _Pragma("unroll") for (int m = 0; m < 4; ++m) _Pragma("unroll") for (int k = 0; k < 2; ++k) dst[m][k] = *(const LAS bf16x8*)(lds + PG_SA(b, h) + aoff + m * 2048 + k * 1024); } while (0)
#define PG_LDB(dst, b, h) do { _Pragma("unroll") for (int n = 0; n < 2; ++n) _Pragma("unroll") for (int k = 0; k < 2; ++k) dst[n][k] = *(const LAS bf16x8*)(lds + PG_SB(b, h) + boff + n * 2048 + k * 1024); } while (0)
#define PG_MMA(ai, bj, At, Bt) do { __builtin_amdgcn_s_setprio(1); _Pragma("unroll") for (int m = 0; m < 4; ++m) _Pragma("unroll") for (int n = 0; n < 2; ++n) _Pragma("unroll") for (int k = 0; k < 2; ++k) \
        acc[ai][bj][m][n] = __builtin_amdgcn_mfma_f32_16x16x32_bf16(Bt[n][k], At[m][k], acc[ai][bj][m][n], 0, 0, 0); __builtin_amdgcn_s_setprio(0); } while (0)
#define PG_WAIT_V(n) asm volatile("s_waitcnt vmcnt(" #n ")" ::: "memory")
#define PG_WAIT_L(n) asm volatile("s_waitcnt lgkmcnt(" #n ")" ::: "memory")
#define PG_BAR __builtin_amdgcn_s_barrier()
#define PG_SCHED __builtin_amdgcn_sched_barrier(0)
    Unit cur, nxt; int ui = 0;
    if (!S.next(0, cur)) return;
    f32x4 acc[2][2][4][2];
#pragma unroll
    for (int a = 0; a < 2; ++a)
#pragma unroll
        for (int b = 0; b < 2; ++b)
#pragma unroll
            for (int m = 0; m < 4; ++m)
#pragma unroll
                for (int n = 0; n < 2; ++n) acc[a][b][m][n] = (f32x4){0.f, 0.f, 0.f, 0.f};
    bf16x8 At[4][2], B0[2][2], B1[2][2];
    unsigned cOff[2][2], nOff[2][2];
    S.aoff(cur, Rr[0], Rr[1], Cb, cOff);
    const char* cB = S.bptr(cur);
    PG_STAGE(PG_SB(0, 0), cB, voffB); PG_STAGE(PG_SB(0, 1), cB + hstep, voffB); PG_STAGE(PG_SA(0, 0), Abase, cOff[0]); PG_STAGE(PG_SA(0, 1), Abase, cOff[1]);
    if (wr == 1) PG_BAR;
    PG_WAIT_V(2); PG_BAR;
    PG_STAGE(PG_SB(1, 0), cB + kstep, voffB); PG_STAGE(PG_SA(1, 0), Abase + kstep, cOff[0]); PG_STAGE(PG_SB(1, 1), cB + hstep + kstep, voffB);
    PG_WAIT_V(6); PG_BAR;
    for (;;) {
        const bool has_next = S.next(ui + 1, nxt);
        const char* nB = cB;
        if (has_next) { S.aoff(nxt, Rr[0], Rr[1], Cb, nOff); nB = S.bptr(nxt); }
        else { nOff[0][0] = cOff[0][0]; nOff[0][1] = cOff[0][1]; nOff[1][0] = cOff[1][0]; nOff[1][1] = cOff[1][1]; }
        for (int t = 0; t < nt; t += 2) {
            const bool last = (t == nt - 2);
            const char* a1 = Abase + (size_t)(t + 1) * kstep;
            const char* a2 = last ? Abase : Abase + (size_t)(t + 2) * kstep; const char* b2 = last ? nB : cB + (size_t)(t + 2) * kstep;
            const char* a3 = a2 + kstep; const char* b3 = b2 + kstep;
            unsigned o2[2][2];
            o2[0][0] = last ? nOff[0][0] : cOff[0][0]; o2[0][1] = last ? nOff[0][1] : cOff[0][1]; o2[1][0] = last ? nOff[1][0] : cOff[1][0]; o2[1][1] = last ? nOff[1][1] : cOff[1][1];
            PG_LDB(B0, 0, 0); PG_LDB(B1, 0, 1); PG_SCHED; PG_LDA(At, 0, 0); PG_STAGE(PG_SA(1, 1), a1, cOff[1]);
            PG_WAIT_V(8); PG_WAIT_L(0); PG_BAR; PG_MMA(0, 0, At, B0); PG_MMA(0, 1, At, B1); PG_BAR; PG_SCHED;
            PG_LDA(At, 0, 1); PG_STAGE(PG_SB(0, 0), b2, voffB); PG_STAGE(PG_SB(0, 1), b2 + hstep, voffB); PG_STAGE(PG_SA(0, 0), a2, o2[0]);
            PG_WAIT_V(8); PG_WAIT_L(0); PG_BAR; PG_MMA(1, 0, At, B0); PG_MMA(1, 1, At, B1); PG_BAR; PG_SCHED;
            PG_LDB(B0, 1, 0); PG_LDB(B1, 1, 1); PG_SCHED; PG_LDA(At, 1, 0); PG_STAGE(PG_SA(0, 1), a2, o2[1]);
            PG_WAIT_V(8); PG_WAIT_L(0); PG_BAR; PG_MMA(0, 0, At, B0); PG_MMA(0, 1, At, B1); PG_BAR; PG_SCHED;
            PG_LDA(At, 1, 1); PG_STAGE(PG_SB(1, 0), b3, voffB); PG_STAGE(PG_SB(1, 1), b3 + hstep, voffB); PG_STAGE(PG_SA(1, 0), a3, o2[0]);
            PG_WAIT_V(8); PG_WAIT_L(0); PG_BAR; PG_MMA(1, 0, At, B0); PG_MMA(1, 1, At, B1); PG_BAR; PG_SCHED;
        }
        if (wr == 0) PG_BAR;
        E(acc, cur, wr, wc, fr, fq);
        if (!has_next) break;
#pragma unroll
        for (int a = 0; a < 2; ++a)
#pragma unroll
            for (int b = 0; b < 2; ++b)
#pragma unroll
                for (int m = 0; m < 4; ++m)
#pragma unroll
                    for (int n = 0; n < 2; ++n) acc[a][b][m][n] = (f32x4){0.f, 0.f, 0.f, 0.f};
        cur = nxt; cB = nB; ++ui;
        cOff[0][0] = nOff[0][0]; cOff[0][1] = nOff[0][1]; cOff[1][0] = nOff[1][0]; cOff[1][1] = nOff[1][1];
        if (wr == 1) PG_BAR;
    }
    PG_WAIT_V(0);
    PG_BAR;
#undef PG_SA
#undef PG_SB
#undef PG_STAGE
#undef PG_LDA
#undef PG_LDB
#undef PG_MMA
#undef PG_WAIT_V
#undef PG_WAIT_L
#undef PG_BAR
#undef PG_SCHED
}

struct DUnit { int pm, pn; };
template <int K> struct DenseSched {
    typedef DUnit Unit;
    const char* Bt; int nM, nN, nwg, G, c;
    __device__ __forceinline__ void init(const void* Bt_, int M, int N, int G_, int c_) { Bt = (const char*)Bt_; nM = M / BM; nN = N / BM; nwg = nM * nN; G = G_; c = c_; }
    __device__ __forceinline__ bool next(int i, Unit& u) const {
        const long L = (long)i * G + c; if (L >= nwg) return false;
        int wgid = (int)L; { const int q = nwg / 8, r = nwg % 8, xcd = wgid % 8, off = wgid / 8; wgid = (xcd < r ? xcd * (q + 1) : r * (q + 1) + (xcd - r) * q) + off; }
        const int nig = 8 * nN, gid = wgid / nig, fm = gid * 8, gsz = (nM - fm) < 8 ? (nM - fm) : 8;
        u.pm = fm + ((wgid % nig) % gsz); u.pn = (wgid % nig) / gsz; return true;
    }
    __device__ __forceinline__ const char* bptr(const Unit& u) const { return Bt + (size_t)u.pn * BM * K * 2; }
    __device__ __forceinline__ void aoff(const Unit& u, int R0, int R1, int Cb, unsigned (&o)[2][2]) const {
#pragma unroll
        for (int h = 0; h < 2; ++h) { o[h][0] = (unsigned)((u.pm * BM + h * HALF + R0) * K) * 2u + Cb; o[h][1] = (unsigned)((u.pm * BM + h * HALF + R1) * K) * 2u + Cb; }
    }
};
struct MUnit { int E, mt, pn, cnt, rowbase; };
template <int K, int NT, bool GATHER> struct MoeSched {
    typedef MUnit Unit;
    const char* W; const LAS int* tab; const int* list; int G, c;
    __device__ __forceinline__ bool next(int i, Unit& u) const {
        const int L = i * G + c; const int total = tab[32] * NT; if (L >= total) return false;
        const int mg = L / NT; u.pn = L % NT;
        int E = 0;
#pragma unroll 1
        for (int e = 1; e < 32; ++e) E = (tab[e] <= mg) ? e : E;
        E = __builtin_amdgcn_readfirstlane(E);
        u.E = E; u.mt = mg - tab[E]; u.cnt = tab[33 + E]; u.rowbase = tab[65 + E]; return true;
    }
    __device__ __forceinline__ const char* bptr(const Unit& u) const { return W + ((size_t)u.E * NT + u.pn) * BM * K * 2; }
    __device__ __forceinline__ void aoff(const Unit& u, int R0, int R1, int Cb, unsigned (&o)[2][2]) const {
#pragma unroll
        for (int h = 0; h < 2; ++h)
#pragma unroll
            for (int i = 0; i < 2; ++i) { const int slot = u.mt * BM + h * HALF + (i ? R1 : R0);
                if (GATHER) { const int tok = slot < u.cnt ? (list[u.E * CAPE + slot] >> 1) : 0; o[h][i] = (unsigned)(tok * K) * 2u + Cb; }
                else o[h][i] = (unsigned)((u.rowbase + slot) * K) * 2u + Cb; }
    }
};

struct EpiBf16 {
    static constexpr bool PERM = true;
    bf16_t* O; int ldc;
    __device__ __forceinline__ void operator()(const f32x4 (&acc)[2][2][4][2], const DUnit& u, int wr, int wc, int fr, int fq) const {
        const int row0 = u.pm * BM + wr * 64 + fr, col0 = u.pn * BM + wc * 32 + 8 * fq;
#pragma unroll
        for (int ai = 0; ai < 2; ++ai)
#pragma unroll
            for (int m = 0; m < 4; ++m) { bf16_t* rowp = O + (size_t)(row0 + ai * HALF + m * 16) * ldc + col0;
#pragma unroll
                for (int bj = 0; bj < 2; ++bj) { const f32x4 v0 = acc[ai][bj][m][0], v1 = acc[ai][bj][m][1];
                    u32x4 w; w.x = cvt_pk_bf16(v0[0], v0[1]); w.y = cvt_pk_bf16(v0[2], v0[3]); w.z = cvt_pk_bf16(v1[0], v1[1]); w.w = cvt_pk_bf16(v1[2], v1[3]);
                    *(u32x4*)(rowp + bj * HALF) = w; } }
    }
};
struct EpiRes {
    static constexpr bool PERM = true;
    const bf16_t* res; bf16_t* C; int ldc;
    __device__ __forceinline__ void operator()(const f32x4 (&acc)[2][2][4][2], const DUnit& u, int wr, int wc, int fr, int fq) const {
        const int row0 = u.pm * BM + wr * 64 + fr, col0 = u.pn * BM + wc * 32 + 8 * fq;
#pragma unroll
        for (int ai = 0; ai < 2; ++ai)
#pragma unroll
            for (int m = 0; m < 4; ++m) { const size_t off = (size_t)(row0 + ai * HALF + m * 16) * ldc + col0;
#pragma unroll
                for (int bj = 0; bj < 2; ++bj) { const u32x4 r = *(const u32x4*)(res + off + bj * HALF); const f32x4 v0 = acc[ai][bj][m][0], v1 = acc[ai][bj][m][1];
                    u32x4 w; w.x = cvt_pk_bf16(bflo(r.x) + v0[0], bfhi(r.x) + v0[1]); w.y = cvt_pk_bf16(bflo(r.y) + v0[2], bfhi(r.y) + v0[3]);
                    w.z = cvt_pk_bf16(bflo(r.z) + v1[0], bfhi(r.z) + v1[1]); w.w = cvt_pk_bf16(bflo(r.w) + v1[2], bfhi(r.w) + v1[3]);
                    *(u32x4*)(C + off + bj * HALF) = w; } }
    }
};
struct EpiGateUp {
    static constexpr bool PERM = true;
    bf16_t* H; const float* gw;
    __device__ __forceinline__ void operator()(const f32x4 (&acc)[2][2][4][2], const MUnit& u, int wr, int wc, int fr, int fq) const {
        const int col0 = u.pn * HALF + wc * 32 + 8 * fq;
#pragma unroll
        for (int ai = 0; ai < 2; ++ai)
#pragma unroll
            for (int m = 0; m < 4; ++m) { const int slot = u.mt * BM + ai * HALF + wr * 64 + m * 16 + fr;
                const float w = slot < u.cnt ? gw[u.E * CAPE + slot] : 0.f;
                const f32x4 g0 = acc[ai][0][m][0], g1 = acc[ai][0][m][1], u0 = acc[ai][1][m][0], u1 = acc[ai][1][m][1];
                float h[8];
#pragma unroll
                for (int j = 0; j < 4; ++j) { h[j] = silu(g0[j]) * u0[j] * w; h[4 + j] = silu(g1[j]) * u1[j] * w; }
                u32x4 o; o.x = cvt_pk_bf16(h[0], h[1]); o.y = cvt_pk_bf16(h[2], h[3]); o.z = cvt_pk_bf16(h[4], h[5]); o.w = cvt_pk_bf16(h[6], h[7]);
                *(u32x4*)(H + (size_t)(u.rowbase + slot) * DE + col0) = o; }
    }
};
struct EpiDown {
    static constexpr bool PERM = true;
    bf16_t* Y; const int* list;
    __device__ __forceinline__ void operator()(const f32x4 (&acc)[2][2][4][2], const MUnit& u, int wr, int wc, int fr, int fq) const {
        const int col0 = u.pn * BM + wc * 32 + 8 * fq;
#pragma unroll
        for (int ai = 0; ai < 2; ++ai)
#pragma unroll
            for (int m = 0; m < 4; ++m) { const int slot = u.mt * BM + ai * HALF + wr * 64 + m * 16 + fr;
                if (slot < u.cnt) { const int ent = list[u.E * CAPE + slot]; bf16_t* rowp = Y + (size_t)ent * DM + col0;
#pragma unroll
                    for (int bj = 0; bj < 2; ++bj) { const f32x4 v0 = acc[ai][bj][m][0], v1 = acc[ai][bj][m][1];
                        u32x4 w; w.x = cvt_pk_bf16(v0[0], v0[1]); w.y = cvt_pk_bf16(v0[2], v0[3]); w.z = cvt_pk_bf16(v1[0], v1[1]); w.w = cvt_pk_bf16(v1[2], v1[3]);
                        *(u32x4*)(rowp + bj * HALF) = w; } } }
    }
};

template <int K, int LDB, class Epi, class Sched>
__device__ __forceinline__ void gemm_rb(LAS unsigned char* lds, const char* Abase, const Sched& S, const Epi& E) {
    typedef typename Sched::Unit Unit;
    const int tid = opaque_tid(), wid = __builtin_amdgcn_readfirstlane(tid >> 6), lane = tid & 63, wr = wid >> 2, wc = wid & 3, fr = lane & 15, fq = lane >> 4;
    constexpr int nt = K / BK;
    int Rr[2], Cb;
#pragma unroll
    for (int i = 0; i < 2; ++i) { int R, C; stage_rc(tid * 16 + i * 8192, R, C); Rr[i] = R; Cb = C * 2; }
    const unsigned ldsw = (unsigned)wid * 1024u;
    const int aoff = lds_byte(wr * 64 + fr, fq * 8);
    const int k4 = tid >> 5, n4 = tid & 31;
    int bw[4];
#pragma unroll
    for (int q = 0; q < 4; ++q) bw[q] = (4 * n4 + q) * 128 + (((k4 >> 1) ^ (n4 & 7)) * 16) + (k4 & 1) * 8;
    int brd[2][2];
#pragma unroll
    for (int n = 0; n < 2; ++n)
#pragma unroll
        for (int k = 0; k < 2; ++k) { const int r = wc * 32 + n * 16 + fr; brd[n][k] = r * 128 + (((k * 4 + fq) ^ ((r >> 2) & 7)) * 16); }
#define RB_SB(b) (98304 + (b) * HTB)
#define RB_STAGE_A(sa, kt, OFF) do { _Pragma("unroll") for (int _h = 0; _h < 2; ++_h) _Pragma("unroll") for (int _i = 0; _i < 2; ++_i) \
        __builtin_amdgcn_global_load_lds((const unsigned*)(Abase + (size_t)(kt) * (BK * 2) + OFF[_h][_i]), (LAS unsigned*)(lds + (sa) * 32768 + _h * HTB + ldsw + _i * 8192), 16, 0, 0); } while (0)
#define RB_LOAD_B(r0, r1, r2, r3, kt, BP) do { const float* _p = BP + (size_t)(kt) * BK * LDB; \
        asm volatile("global_load_dwordx4 %0, %4, off\n\tglobal_load_dwordx4 %1, %5, off\n\tglobal_load_dwordx4 %2, %6, off\n\tglobal_load_dwordx4 %3, %7, off" \
            : "=&v"(r0), "=&v"(r1), "=&v"(r2), "=&v"(r3) : "v"(_p), "v"(_p + LDB), "v"(_p + 2 * LDB), "v"(_p + 3 * LDB) : "memory"); } while (0)
#define RB_WAIT8(r0, r1, r2, r3) asm volatile("s_waitcnt vmcnt(8)" : "+v"(r0), "+v"(r1), "+v"(r2), "+v"(r3) :: "memory")
#define RB_WRITE_B(b, r0, r1, r2, r3) do { _Pragma("unroll") for (int _q = 0; _q < 4; ++_q) { u32x2 _w; _w.x = cvt_pk_bf16(r0[_q], r1[_q]); _w.y = cvt_pk_bf16(r2[_q], r3[_q]); \
        *(LAS u32x2*)(lds + RB_SB(b) + bw[_q]) = _w; } } while (0)
#define RB_COMPUTE(sa, b) do { bf16x8 Bf[2][2]; _Pragma("unroll") for (int n = 0; n < 2; ++n) _Pragma("unroll") for (int k = 0; k < 2; ++k) Bf[n][k] = *(const LAS bf16x8*)(lds + RB_SB(b) + brd[n][k]); \
        _Pragma("unroll") for (int ai = 0; ai < 2; ++ai) { bf16x8 At[4][2]; _Pragma("unroll") for (int m = 0; m < 4; ++m) _Pragma("unroll") for (int k = 0; k < 2; ++k) At[m][k] = *(const LAS bf16x8*)(lds + (sa) * 32768 + ai * HTB + aoff + m * 2048 + k * 1024); \
            __builtin_amdgcn_s_setprio(1); _Pragma("unroll") for (int m = 0; m < 4; ++m) _Pragma("unroll") for (int n = 0; n < 2; ++n) _Pragma("unroll") for (int k = 0; k < 2; ++k) acc[ai][m][n] = __builtin_amdgcn_mfma_f32_16x16x32_bf16(Bf[n][k], At[m][k], acc[ai][m][n], 0, 0, 0); __builtin_amdgcn_s_setprio(0); } } while (0)
#define RB_SYNC() do { asm volatile("s_waitcnt lgkmcnt(0)" ::: "memory"); __builtin_amdgcn_s_barrier(); asm volatile("" ::: "memory"); sa = sa == 2 ? 0 : sa + 1; } while (0)
#define RB_STEP(b, kt2, OFF, BP, c0, c1, c2, c3, n0, n1, n2, n3) do { const int _s2 = sa >= 1 ? sa - 1 : 2; RB_STAGE_A(_s2, kt2, OFF); RB_LOAD_B(c0, c1, c2, c3, kt2, BP); \
        RB_COMPUTE(sa, b); RB_WAIT8(n0, n1, n2, n3); RB_WRITE_B((b) ^ 1, n0, n1, n2, n3); RB_SYNC(); } while (0)
    Unit u, un;
    if (!S.next(0, u)) return;
    unsigned cOff[2][2], nOff[2][2]; S.aoff(u, Rr[0], Rr[1], Cb, cOff);
    const float* bp = S.bsrc(u, 4 * n4) + (size_t)(4 * k4) * LDB; const float* nbp = bp;
    f32x4 e0, e1, e2, e3, o0, o1, o2, o3;
    asm volatile("s_waitcnt vmcnt(0)" ::: "memory");
    RB_STAGE_A(0, 0, cOff); RB_LOAD_B(e0, e1, e2, e3, 0, bp);
    RB_STAGE_A(1, 1, cOff); RB_LOAD_B(o0, o1, o2, o3, 1, bp);
    RB_WAIT8(e0, e1, e2, e3); RB_WRITE_B(0, e0, e1, e2, e3);
    asm volatile("s_waitcnt lgkmcnt(0)" ::: "memory"); __builtin_amdgcn_s_barrier(); asm volatile("" ::: "memory");
    int sa = 0;
    for (int ui = 0;; ++ui) {
        const bool has_next = S.next(ui + 1, un);
        if (has_next) { S.aoff(un, Rr[0], Rr[1], Cb, nOff); nbp = S.bsrc(un, 4 * n4) + (size_t)(4 * k4) * LDB; }
        else { nOff[0][0] = cOff[0][0]; nOff[0][1] = cOff[0][1]; nOff[1][0] = cOff[1][0]; nOff[1][1] = cOff[1][1]; nbp = bp; }
        f32x4 acc[2][4][2];
#pragma unroll
        for (int a = 0; a < 2; ++a)
#pragma unroll
            for (int m = 0; m < 4; ++m)
#pragma unroll
                for (int n = 0; n < 2; ++n) acc[a][m][n] = (f32x4){0.f, 0.f, 0.f, 0.f};
        unsigned pv[2][4]; E.pre(u, wr, fr, pv);
#pragma unroll 1
        for (int t = 0; t < nt - 2; t += 2) { RB_STEP(0, t + 2, cOff, bp, e0, e1, e2, e3, o0, o1, o2, o3); RB_STEP(1, t + 3, cOff, bp, o0, o1, o2, o3, e0, e1, e2, e3); }
        RB_STEP(0, 0, nOff, nbp, e0, e1, e2, e3, o0, o1, o2, o3); RB_STEP(1, 1, nOff, nbp, o0, o1, o2, o3, e0, e1, e2, e3);
        E(acc, u, wr, wc, fr, fq, pv);
        if (!has_next) break;
        u = un; bp = nbp; cOff[0][0] = nOff[0][0]; cOff[0][1] = nOff[0][1]; cOff[1][0] = nOff[1][0]; cOff[1][1] = nOff[1][1];
    }
    asm volatile("s_waitcnt vmcnt(0)" ::: "memory"); __builtin_amdgcn_s_barrier();
#undef RB_SB
#undef RB_STAGE_A
#undef RB_LOAD_B
#undef RB_WAIT8
#undef RB_WRITE_B
#undef RB_COMPUTE
#undef RB_STEP
#undef RB_SYNC
}
template <int K, int NT, bool GATHER> struct MoeSchedRB {
    typedef MUnit Unit;
    const float* W0; const float* W1; const LAS int* tab; const int* list; int G, c;
    __device__ __forceinline__ bool next(int i, Unit& u) const {
        const int L = i * G + c; const int total = tab[32] * NT; if (L >= total) return false;
        const int mg = L / NT;
        int E = 0;
#pragma unroll 1
        for (int e = 1; e < 32; ++e) E = (tab[e] <= mg) ? e : E;
        E = __builtin_amdgcn_readfirstlane(E);
#ifndef ORDER_MT_FAST
#define ORDER_MT_FAST 1
#endif
        if (ORDER_MT_FAST) { const int nte = tab[E + 1] - tab[E], loc = L - tab[E] * NT; u.pn = loc / nte; u.mt = loc - u.pn * nte; }
        else { u.pn = L % NT; u.mt = mg - tab[E]; }
        u.E = E; u.cnt = tab[33 + E]; u.rowbase = tab[65 + E]; return true;
    }
    __device__ __forceinline__ const float* bsrc(const Unit& u, int c4) const {
        if (GATHER) { const long dW = ((c4 >> 4) & 1) ? (long)(W1 - W0) : 0l; return W0 + dW + (size_t)u.E * DM * DE + 64 * u.pn + 16 * (c4 >> 5) + (c4 & 15); }
        else return W0 + (size_t)u.E * DE * DM + 128 * u.pn + c4;
    }
    __device__ __forceinline__ void aoff(const Unit& u, int R0, int R1, int Cb, unsigned (&o)[2][2]) const {
#pragma unroll
        for (int h = 0; h < 2; ++h)
#pragma unroll
            for (int i = 0; i < 2; ++i) { const int slot = u.mt * BM + h * HALF + (i ? R1 : R0);
                if (GATHER) { const int ent = list[u.E * CAPE + slot]; const int tok = slot < u.cnt ? (ent >> 1) : 0; o[h][i] = (unsigned)(tok * K) * 2u + Cb; }
                else o[h][i] = (unsigned)((u.rowbase + slot) * K) * 2u + Cb; }
    }
};
struct EpiGateUpRB {
    bf16_t* H; const float* gw;
    __device__ __forceinline__ void pre(const MUnit& u, int wr, int fr, unsigned (&pv)[2][4]) const {
#pragma unroll
        for (int ai = 0; ai < 2; ++ai)
#pragma unroll
            for (int m = 0; m < 4; ++m) pv[ai][m] = __float_as_uint(gw[u.E * CAPE + u.mt * BM + ai * HALF + wr * 64 + m * 16 + fr]);
    }
    __device__ __forceinline__ void operator()(const f32x4 (&acc)[2][4][2], const MUnit& u, int wr, int wc, int fr, int fq, const unsigned (&pv)[2][4]) const {
        const int col0 = u.pn * 64 + wc * 16 + 4 * fq;
#pragma unroll
        for (int ai = 0; ai < 2; ++ai)
#pragma unroll
            for (int m = 0; m < 4; ++m) { const int slot = u.mt * BM + ai * HALF + wr * 64 + m * 16 + fr;
                const float w = slot < u.cnt ? __uint_as_float(pv[ai][m]) : 0.f;
                const f32x4 g = acc[ai][m][0], up = acc[ai][m][1];
                u32x2 o; o.x = cvt_pk_bf16(silu(g[0]) * up[0] * w, silu(g[1]) * up[1] * w); o.y = cvt_pk_bf16(silu(g[2]) * up[2] * w, silu(g[3]) * up[3] * w);
                *(u32x2*)(H + (size_t)(u.rowbase + slot) * DE + col0) = o; }
    }
};
struct EpiDownRB {
    bf16_t* Y; const int* list;
    __device__ __forceinline__ void pre(const MUnit& u, int wr, int fr, unsigned (&pv)[2][4]) const {
#pragma unroll
        for (int ai = 0; ai < 2; ++ai)
#pragma unroll
            for (int m = 0; m < 4; ++m) pv[ai][m] = (unsigned)list[u.E * CAPE + u.mt * BM + ai * HALF + wr * 64 + m * 16 + fr];
    }
    __device__ __forceinline__ void operator()(const f32x4 (&acc)[2][4][2], const MUnit& u, int wr, int wc, int fr, int fq, const unsigned (&pv)[2][4]) const {
        const int col0 = u.pn * HALF + wc * 32 + 4 * fq;
#pragma unroll
        for (int ai = 0; ai < 2; ++ai)
#pragma unroll
            for (int m = 0; m < 4; ++m) { const int slot = u.mt * BM + ai * HALF + wr * 64 + m * 16 + fr;
                if (slot < u.cnt) { bf16_t* rowp = Y + (size_t)pv[ai][m] * DM + col0;
#pragma unroll
                    for (int n = 0; n < 2; ++n) { const f32x4 v = acc[ai][m][n]; u32x2 o; o.x = cvt_pk_bf16(v[0], v[1]); o.y = cvt_pk_bf16(v[2], v[3]); *(u32x2*)(rowp + n * 16) = o; } } }
    }
};
}

struct Args { const float* in[21]; float* out; unsigned char* ws; int ph_lo, ph_hi; };
#define CAS __attribute__((address_space(4)))
typedef const CAS Args* ArgP;
__device__ __forceinline__ ArgP kargs() { ArgP p = (ArgP)__builtin_amdgcn_kernarg_segment_ptr(); asm volatile("" : "+s"(p)); return p; }

enum { I_X = 0, I_N1G, I_WIN, I_CONVW, I_CONVB, I_CLNG, I_CLNB, I_GW2, I_GB2, I_GNG, I_FFB, I_WOUT, I_N2G, I_RGW, I_RGB, I_REW, I_REB, I_WG, I_WU, I_WD, I_FNG };

template <int MAP  >
__device__ __forceinline__ void cvt_item(const float* W, int K, int N, int nblk, bf16_t* WT, LAS float* scr, int item, int lane) {
    const int kb = item / nblk, nb = item % nblk, k0 = 64 * kb, n0 = 32 * nb;
    const int n4 = lane & 7, kr = lane >> 3;
    const bool nok = (n0 + 4 * n4) < N;
    f32x4 v[8];
#pragma unroll
    for (int i = 0; i < 8; ++i) v[i] = nok ? *(const f32x4*)(W + (size_t)(k0 + 8 * i + kr) * N + n0 + 4 * n4) : (f32x4){0.f, 0.f, 0.f, 0.f};
#pragma unroll
    for (int i = 0; i < 8; ++i) { LAS float* d = scr + (8 * i + kr) * 33 + 4 * n4; d[0] = v[i].x; d[1] = v[i].y; d[2] = v[i].z; d[3] = v[i].w; }
    LDS_WAIT(); asm volatile("" ::: "memory");
    const int c = lane & 7;
#pragma unroll
    for (int j = 0; j < 4; ++j) { const int n = (lane >> 3) + 8 * j; const LAS float* s = scr + (8 * c) * 33 + n;
        u32x4 o; o.x = cvt_pk_bf16(s[0 * 33], s[1 * 33]); o.y = cvt_pk_bf16(s[2 * 33], s[3 * 33]); o.z = cvt_pk_bf16(s[4 * 33], s[5 * 33]); o.w = cvt_pk_bf16(s[6 * 33], s[7 * 33]);
        const int nn = n0 + n; const int row = MAP == 0 ? nn : ((nn >> 7) * 256 + (nn & 127) + (MAP == 2 ? 128 : 0));
        *(u32x4*)(WT + (size_t)row * K + k0 + 8 * c) = o; }
    LDS_WAIT(); asm volatile("" ::: "memory");
}
constexpr int CV_I_IN = 32 * 184, CV_I_OUT = 32 * 64, CV_N_IN = 2 * CV_I_IN;
__device__ __forceinline__ void cvt_range(ArgP a, LAS unsigned char* lds, int first, int count, int rank, int nranks) {
    const int tid = opaque_tid(), lane = tid & 63, wave = tid >> 6;
    LAS float* scr = (LAS float*)(lds + wave * 16384);
    for (int it = first + rank * NWAVES + wave; it < first + count; it += nranks * NWAVES) {
        int r = it;
        if (r < CV_N_IN) { const int l = r / CV_I_IN; cvt_item<0>(a->in[I_WIN] + (size_t)l * DM * DIN, DM, DIN, 184, (bf16_t*)(a->ws + WS_WIN) + (size_t)l * DINP * DM, scr, r % CV_I_IN, lane); continue; } r -= CV_N_IN;
        { const int l = r / CV_I_OUT; cvt_item<0>(a->in[I_WOUT] + (size_t)l * DM * DM, DM, DM, 64, (bf16_t*)(a->ws + WS_WOUT) + (size_t)l * DM * DM, scr, r % CV_I_OUT, lane); }
    }
}
__device__ __forceinline__ void idle_rank(int nunits, int G, int c, int& rank, int& nranks) {
    const int maxu = (nunits + G - 1) / G, nidle = maxu * G - nunits, first = nunits - (maxu - 1) * G;
    if (nidle >= 16) { nranks = nidle; rank = c >= first ? c - first : -1; } else { nranks = G; rank = c; }
}
__device__ __forceinline__ void p0_prologue(ArgP a, LAS unsigned char* lds) {
    const int tid = opaque_tid(), lane = tid & 63, wave = tid >> 6;
    LAS float* scr = (LAS float*)(lds + wave * 16384);
    const int gw = blockIdx.x * NWAVES + wave, NGW = gridDim.x * NWAVES;
    constexpr int I_IN = CV_I_IN;
    cvt_range(a, lds, 0, I_IN, blockIdx.x, gridDim.x);
    for (int idx = blockIdx.x * NTHR + tid; idx < DEPTH * 48 * DM; idx += gridDim.x * NTHR) {
        const int k = idx % DM, c = (idx / DM) % 48, l = idx / (DM * 48);
        float w = 0.f;
        if (c < 4) w = a->in[I_RGW][((size_t)l * DM + k) * 4 + c];
        else if (c < 36) w = a->in[I_REW][(((size_t)l * 4 + ((c - 4) >> 3)) * DM + k) * 8 + ((c - 4) & 7)];
        w *= a->in[I_N2G][l * DM + k];
        const bf16_t hi = f2bf(w), lo = f2bf(w - bf2f(hi));
        bf16_t* wr = (bf16_t*)(a->ws + WS_WR);
        wr[((size_t)(l * 2 + 0) * 48 + c) * DM + k] = hi; wr[((size_t)(l * 2 + 1) * 48 + c) * DM + k] = lo;
    }
    const float* g = a->in[I_N1G];
    f32x4 nx[8];
    if (gw < T) {
#pragma unroll
        for (int j = 0; j < 8; ++j) nx[j] = ((const f32x4*)(a->in[I_X] + (size_t)gw * DM) + lane)[64 * j]; }
    for (int m = gw; m < T; m += NGW) {
        f32x4 v[8]; float s = 0.f;
#pragma unroll
        for (int j = 0; j < 8; ++j) { v[j] = nx[j]; s += (v[j].x * v[j].x + v[j].y * v[j].y) + (v[j].z * v[j].z + v[j].w * v[j].w); }
        if (m + NGW < T) {
#pragma unroll
            for (int j = 0; j < 8; ++j) nx[j] = ((const f32x4*)(a->in[I_X] + (size_t)(m + NGW) * DM) + lane)[64 * j]; }
        const float rstd = rsqrtf(wave_sum(s) * (1.f / DM) + EPS);
        u32x2* o = (u32x2*)((bf16_t*)(a->ws + WS_H) + (size_t)m * DM) + lane; u32x2* xb = (u32x2*)((bf16_t*)(a->ws + WS_XB) + (size_t)m * DM) + lane;
#pragma unroll
        for (int j = 0; j < 8; ++j) { const f32x4 gg = ((const f32x4*)g)[lane + 64 * j]; u32x2 w; w.x = cvt_pk_bf16(v[j].x * rstd * gg.x, v[j].y * rstd * gg.y); w.y = cvt_pk_bf16(v[j].z * rstd * gg.z, v[j].w * rstd * gg.w); o[64 * j] = w;
            u32x2 xw; xw.x = cvt_pk_bf16(v[j].x, v[j].y); xw.y = cvt_pk_bf16(v[j].z, v[j].w); xb[64 * j] = xw; }
    }
}

__device__ __forceinline__ void conv_phase(ArgP a, LAS unsigned char* lds, int l) {
    const int tid = opaque_tid(), lane = tid & 63, wave = tid >> 6, cp = tid & 255, th = tid >> 8;
    const bf16_t* P = (const bf16_t*)(a->ws + WS_P); bf16_t* mix = (bf16_t*)(a->ws + WS_MIX);
    LAS float* ut = (LAS float*)lds;
    for (int item = blockIdx.x; item < NB * (SEQ / 32); item += gridDim.x) {
        const int b = item / (SEQ / 32), s0 = (item % (SEQ / 32)) * 32;
        __syncthreads();
#pragma unroll
        for (int i = 0; i < 8; ++i) { const int idx = tid + i * 512, r = idx >> 6, c8 = idx & 63, sq = s0 - 30 + r;
            if (r < 62) { f32x4 u0 = {0.f, 0.f, 0.f, 0.f}, u1 = {0.f, 0.f, 0.f, 0.f};
                if (sq >= 0) { const bf16_t* row = P + (size_t)(b * SEQ + sq) * DINP + c8 * 8; const u32x4 av = *(const u32x4*)(row + C_CA), gv = *(const u32x4*)(row + C_CG);
                    u0.x = bflo(av.x) * __builtin_amdgcn_rcpf(1.f + __expf(-bflo(gv.x))); u0.y = bfhi(av.x) * __builtin_amdgcn_rcpf(1.f + __expf(-bfhi(gv.x)));
                    u0.z = bflo(av.y) * __builtin_amdgcn_rcpf(1.f + __expf(-bflo(gv.y))); u0.w = bfhi(av.y) * __builtin_amdgcn_rcpf(1.f + __expf(-bfhi(gv.y)));
                    u1.x = bflo(av.z) * __builtin_amdgcn_rcpf(1.f + __expf(-bflo(gv.z))); u1.y = bfhi(av.z) * __builtin_amdgcn_rcpf(1.f + __expf(-bfhi(gv.z)));
                    u1.z = bflo(av.w) * __builtin_amdgcn_rcpf(1.f + __expf(-bflo(gv.w))); u1.w = bfhi(av.w) * __builtin_amdgcn_rcpf(1.f + __expf(-bfhi(gv.w))); }
                *(LAS f32x4*)(ut + r * 512 + c8 * 8) = u0; *(LAS f32x4*)(ut + r * 512 + c8 * 8 + 4) = u1; } }
        if (tid < 128) { const int t = tid >> 2, hd = tid & 3;
            ((float*)(a->ws + WS_LF))[(b * 4 + hd) * SEQ + s0 + t] = log_sigmoid(bf2f(P[(size_t)(b * SEQ + s0 + t) * DINP + C_FF + hd]) + a->in[I_FFB][l * 4 + hd]) * LOG2E; }
        f32x2 w[31];
#pragma unroll
        for (int j = 0; j < 31; ++j) w[j] = *(const f32x2*)(a->in[I_CONVW] + ((size_t)l * 31 + j) * 512 + 2 * cp);
        const f32x2 cb = *(const f32x2*)(a->in[I_CONVB] + l * 512 + 2 * cp);
        __syncthreads();
        f32x2 y[16];
#pragma unroll
        for (int t = 0; t < 16; ++t) y[t] = cb;
#pragma unroll
        for (int r = 0; r < 46; ++r) { const f32x2 u = *(const LAS f32x2*)(ut + (th * 16 + r) * 512 + 2 * cp);
#pragma unroll
            for (int t = 0; t < 16; ++t) { const int j = r - t; if (j >= 0 && j < 31) y[t] += w[j] * u; } }
        __syncthreads();
#pragma unroll
        for (int t = 0; t < 16; ++t) *(LAS f32x2*)(ut + (th * 16 + t) * 512 + 2 * cp) = y[t];
        __syncthreads();
#pragma unroll
        for (int q = 0; q < 4; ++q) { const int t = wave * 4 + q;
            const f32x4 y0 = *(const LAS f32x4*)(ut + t * 512 + lane * 8), y1 = *(const LAS f32x4*)(ut + t * 512 + lane * 8 + 4);
            const float mu = wave_sum((y0.x + y0.y) + (y0.z + y0.w) + (y1.x + y1.y) + (y1.z + y1.w)) * (1.f / 512.f);
            const f32x4 d0 = y0 - mu, d1 = y1 - mu;
            const float var = wave_sum((d0.x * d0.x + d0.y * d0.y) + (d0.z * d0.z + d0.w * d0.w) + (d1.x * d1.x + d1.y * d1.y) + (d1.z * d1.z + d1.w * d1.w)) * (1.f / 512.f);
            const float rstd = rsqrtf(var + EPS);
            const f32x4 g0 = *(const f32x4*)(a->in[I_CLNG] + l * 512 + lane * 8), g1 = *(const f32x4*)(a->in[I_CLNG] + l * 512 + lane * 8 + 4);
            const f32x4 b0 = *(const f32x4*)(a->in[I_CLNB] + l * 512 + lane * 8), b1 = *(const f32x4*)(a->in[I_CLNB] + l * 512 + lane * 8 + 4);
            float o[8];
#pragma unroll
            for (int j = 0; j < 4; ++j) { o[j] = silu(d0[j] * rstd * g0[j] + b0[j]); o[4 + j] = silu(d1[j] * rstd * g1[j] + b1[j]); }
            u32x4 pk; pk.x = cvt_pk_bf16(o[0], o[1]); pk.y = cvt_pk_bf16(o[2], o[3]); pk.z = cvt_pk_bf16(o[4], o[5]); pk.w = cvt_pk_bf16(o[6], o[7]);
            *(u32x4*)(mix + (size_t)(b * SEQ + s0 + t) * DM + M_CONV + lane * 8) = pk; }
    }
    __syncthreads();
}

constexpr int GL_ALOW = 0, GL_TOT = 5120, GL_END0 = 5120 + 2048;
__device__ __forceinline__ void gla_cum(ArgP a, LAS unsigned char* lds, int l, int h, int t0, float (&cum)[16], float& last) {
    const int tid = opaque_tid(), d = tid & 127, cg = tid >> 7;
    const bf16_t* P = (const bf16_t*)(a->ws + WS_P);
    LAS float* alow = (LAS float*)(lds + GL_ALOW); LAS float* tot = (LAS float*)(lds + GL_TOT);
#pragma unroll
    for (int i = 0; i < 2; ++i) { const int idx = tid + i * 512, c = idx >> 4, r = idx & 15; alow[c * 20 + r] = bf2f(P[(size_t)(t0 + c) * DINP + C_GLOW + r]); }
    float w2[16];
#pragma unroll
    for (int r = 0; r < 16; ++r) w2[r] = a->in[I_GW2][((size_t)l * 16 + r) * 512 + h * 128 + d];
    const float b2 = a->in[I_GB2][l * 512 + h * 128 + d];
    __syncthreads();
    float run = 0.f;
#pragma unroll
    for (int j = 0; j < 16; ++j) { const int c = cg * 16 + j; float z = b2;
#pragma unroll
        for (int q = 0; q < 4; ++q) { const f32x4 av = *(const LAS f32x4*)(alow + c * 20 + q * 4); z += av.x * w2[q * 4] + av.y * w2[q * 4 + 1] + av.z * w2[q * 4 + 2] + av.w * w2[q * 4 + 3]; }
        run += log_sigmoid(z) * (1.f / 16.f); cum[j] = run; }
    tot[cg * 128 + d] = run;
    __syncthreads();
    float pre = 0.f, all = 0.f;
#pragma unroll
    for (int q = 0; q < 4; ++q) { const float tv = tot[q * 128 + d]; pre += (q < cg) ? tv : 0.f; all += tv; }
#pragma unroll
    for (int j = 0; j < 16; ++j) cum[j] += pre;
    last = all;
}
constexpr int GA_KT = GL_END0, GA_V = GA_KT + 128 * 144, GA_OUT = GA_V + 64 * 528, GA_END = GA_OUT + 256 * 256;
static_assert(GA_END <= MISC_OFF, "GLA-A LDS");
__device__ __forceinline__ void gla_a_phase(ArgP a, LAS unsigned char* lds, int l) {
    const int tid = opaque_tid(), lane = tid & 63, wave = tid >> 6, d = tid & 127, cg = tid >> 7, g = lane >> 4, li = lane & 15;
    const bf16_t* P = (const bf16_t*)(a->ws + WS_P);
    for (int item = blockIdx.x; item < 512; item += gridDim.x) {
        const int n = item & 31, h = (item >> 5) & 3, b = item >> 7, t0 = b * SEQ + n * 64;
        float cum[16], last;
        bf16_t kraw[16]; u32x4 vraw[4];
#pragma unroll
        for (int j = 0; j < 16; ++j) kraw[j] = P[(size_t)(t0 + cg * 16 + j) * DINP + C_GK + h * 128 + d];
#pragma unroll
        for (int i = 0; i < 4; ++i) { const int idx = tid + i * 512, c = idx >> 5, e8 = idx & 31; vraw[i] = *(const u32x4*)(P + (size_t)(t0 + c) * DINP + C_GV + h * 256 + e8 * 8); }
        __syncthreads();
        gla_cum(a, lds, l, h, t0, cum, last);
        { float* cg_ = (float*)(a->ws + WS_CUM) + (size_t)(t0 + cg * 16) * 512 + h * 128 + d;
#pragma unroll
          for (int j = 0; j < 16; ++j) cg_[j * 512] = cum[j]; }
        { unsigned pk[8];
#pragma unroll
          for (int j = 0; j < 16; j += 2) { const float k0 = bf2f(kraw[j]), k1 = bf2f(kraw[j + 1]);
              pk[j >> 1] = cvt_pk_bf16(k0 * __expf(last - cum[j]), k1 * __expf(last - cum[j + 1])); }
          LAS u32x4* dst = (LAS u32x4*)(lds + GA_KT + d * 144 + cg * 32);
          dst[0] = (u32x4){pk[0], pk[1], pk[2], pk[3]}; dst[1] = (u32x4){pk[4], pk[5], pk[6], pk[7]}; }
        if (cg == 0) ((float*)(a->ws + WS_DEC))[item * 128 + d] = __expf(last);
#pragma unroll
        for (int i = 0; i < 4; ++i) { const int idx = tid + i * 512, c = idx >> 5, e8 = idx & 31;
            *(LAS u32x4*)(lds + GA_V + c * 528 + e8 * 16) = vraw[i]; }
        __syncthreads();
        f32x4 acc[2][8];
#pragma unroll
        for (int i = 0; i < 2; ++i)
#pragma unroll
            for (int j = 0; j < 8; ++j) acc[i][j] = (f32x4){0.f, 0.f, 0.f, 0.f};
#pragma unroll
        for (int kk = 0; kk < 2; ++kk) {
            bf16x8 af[2], bfr[8];
#pragma unroll
            for (int i = 0; i < 2; ++i) { const LAS unsigned char* p = lds + GA_V + (kk * 32 + 8 * g + (li >> 2)) * 528 + ((wave * 2 + i) * 16 + 4 * (li & 3)) * 2;
                af[i] = cat8(vtr(p), vtr(p + 4 * 528)); }
#pragma unroll
            for (int j = 0; j < 8; ++j) bfr[j] = *(const LAS bf16x8*)(lds + GA_KT + (j * 16 + li) * 144 + (kk * 32 + 8 * g) * 2);
#pragma unroll
            for (int i = 0; i < 2; ++i)
#pragma unroll
                for (int j = 0; j < 8; ++j) acc[i][j] = mfma16(af[i], bfr[j], acc[i][j]);
        }
#pragma unroll
        for (int i = 0; i < 2; ++i)
#pragma unroll
            for (int j = 0; j < 8; ++j)
#pragma unroll
                for (int r = 0; r < 4; ++r) *(LAS bf16_t*)(lds + GA_OUT + (((wave * 2 + i) * 16 + 4 * g + r) * 128 + j * 16 + li) * 2) = f2bf(acc[i][j][r]);
        __syncthreads();
        bf16_t* kv = (bf16_t*)(a->ws + WS_KV) + (size_t)item * 32768;
#pragma unroll
        for (int i = 0; i < 8; ++i) { const int idx = tid + i * 512; *(u32x4*)(kv + idx * 8) = *(const LAS u32x4*)(lds + GA_OUT + idx * 16); }
    }
    __syncthreads();
}
__device__ __forceinline__ void gla_b_phase(ArgP a, LAS unsigned char* lds) {
    bf16_t* kvb = (bf16_t*)(a->ws + WS_KV); const float* dec = (const float*)(a->ws + WS_DEC);
    const int tid0 = opaque_tid();
    LAS float* dl = (LAS float*)lds;
    for (int base = blockIdx.x * NTHR; base < 16 * 8192; base += gridDim.x * NTHR) {
        const int idx = base + tid0, bh = base >> 13, off = (idx & 8191) * 4, d0 = off & 127;
        u32x2 kvv[32];
#pragma unroll
        for (int q = 0; q < 32; ++q) kvv[q] = *(const u32x2*)(kvb + (size_t)(bh * 32 + q) * 32768 + off);
        __syncthreads();
#pragma unroll
        for (int i = 0; i < 2; ++i) *(LAS f32x4*)(dl + (tid0 + i * 512) * 4) = *(const f32x4*)(dec + (size_t)bh * 32 * 128 + (tid0 + i * 512) * 4);
        __syncthreads();
        float st[4] = {0.f, 0.f, 0.f, 0.f};
#pragma unroll
        for (int q = 0; q < 32; ++q) { const f32x4 dc = *(const LAS f32x4*)(dl + q * 128 + d0);
            u32x2 o; o.x = cvt_pk_bf16(st[0], st[1]); o.y = cvt_pk_bf16(st[2], st[3]);
            *(u32x2*)(kvb + (size_t)(bh * 32 + q) * 32768 + off) = o;
            st[0] = dc.x * st[0] + bflo(kvv[q].x); st[1] = dc.y * st[1] + bfhi(kvv[q].x); st[2] = dc.z * st[2] + bflo(kvv[q].y); st[3] = dc.w * st[3] + bfhi(kvv[q].y); }
    }
    __syncthreads();
}
constexpr int GC_QD = GL_END0, GC_KI = GC_QD + 64 * 272, GC_ATT = GC_KI + 64 * 272, GC_V = GC_ATT + 64 * 144, GC_SS = GC_V + 64 * 528, GC_END = GC_SS + 64 * 8 * 4;
constexpr int GC_OST = GL_END0;
static_assert(GC_END <= MISC_OFF && GC_OST + 64 * 260 * 4 <= GC_SS, "GLA-C LDS");
__device__ __forceinline__ void gla_c_phase(ArgP a, LAS unsigned char* lds, int l) {
    const int tid = opaque_tid(), lane = tid & 63, wave = tid >> 6, d = tid & 127, cg = tid >> 7, g = lane >> 4, li = lane & 15;
    const bf16_t* P = (const bf16_t*)(a->ws + WS_P); bf16_t* mix = (bf16_t*)(a->ws + WS_MIX);
    for (int item = blockIdx.x; item < 512; item += gridDim.x) {
        const int n = item & 31, h = (item >> 5) & 3, b = item >> 7, t0 = b * SEQ + n * 64;
        float cum[16];
        { const float* cg_ = (const float*)(a->ws + WS_CUM) + (size_t)(t0 + cg * 16) * 512 + h * 128 + d;
#pragma unroll
          for (int j = 0; j < 16; ++j) cum[j] = cg_[j * 512]; }
        bf16_t qraw[16], kraw[16]; u32x4 vraw[4];
#pragma unroll
        for (int j = 0; j < 16; ++j) { const bf16_t* row = P + (size_t)(t0 + cg * 16 + j) * DINP + h * 128 + d; qraw[j] = row[C_GQ]; kraw[j] = row[C_GK]; }
#pragma unroll
        for (int i = 0; i < 4; ++i) { const int idx = tid + i * 512, c = idx >> 5, e8 = idx & 31; vraw[i] = *(const u32x4*)(P + (size_t)(t0 + c) * DINP + C_GV + h * 256 + e8 * 8); }
        __syncthreads();
        const bf16_t* ST = (const bf16_t*)(a->ws + WS_KV) + (size_t)item * 32768;
        bf16x8 sf[2][4];
#pragma unroll
        for (int i = 0; i < 2; ++i)
#pragma unroll
            for (int ks = 0; ks < 4; ++ks) sf[i][ks] = *(const bf16x8*)(ST + ((wave * 2 + i) * 16 + li) * 128 + ks * 32 + 8 * g);
#pragma unroll
        for (int j = 0; j < 16; ++j) { const int c = cg * 16 + j;
            const float qv = bf2f(qraw[j]) * 0.08838834764831845f * __expf(cum[j]), kv = bf2f(kraw[j]) * __expf(-cum[j]);
            *(LAS bf16_t*)(lds + GC_QD + c * 272 + d * 2) = f2bf(qv); *(LAS bf16_t*)(lds + GC_KI + c * 272 + d * 2) = f2bf(kv); }
#pragma unroll
        for (int i = 0; i < 4; ++i) { const int idx = tid + i * 512, c = idx >> 5, e8 = idx & 31;
            *(LAS u32x4*)(lds + GC_V + c * 528 + e8 * 16) = vraw[i]; }
        __syncthreads();
        { const int cb = wave >> 1;
#pragma unroll
          for (int i = 0; i < 2; ++i) { const int sb = 2 * (wave & 1) + i; f32x4 s = (f32x4){0.f, 0.f, 0.f, 0.f};
              if (sb <= cb) {
#pragma unroll
                  for (int ks = 0; ks < 4; ++ks) { const bf16x8 qa = *(const LAS bf16x8*)(lds + GC_QD + (cb * 16 + li) * 272 + (ks * 32 + 8 * g) * 2), kb = *(const LAS bf16x8*)(lds + GC_KI + (sb * 16 + li) * 272 + (ks * 32 + 8 * g) * 2);
                      s = mfma16(qa, kb, s); } }
#pragma unroll
              for (int r = 0; r < 4; ++r) { const int c = cb * 16 + 4 * g + r, sc = sb * 16 + li; *(LAS bf16_t*)(lds + GC_ATT + c * 144 + sc * 2) = f2bf(sc <= c ? s[r] : 0.f); } } }
        __syncthreads();
        f32x4 acc[4][2];
#pragma unroll
        for (int cb = 0; cb < 4; ++cb)
#pragma unroll
            for (int i = 0; i < 2; ++i) acc[cb][i] = (f32x4){0.f, 0.f, 0.f, 0.f};
#pragma unroll
        for (int ks = 0; ks < 2; ++ks) { bf16x8 vf[2];
#pragma unroll
            for (int i = 0; i < 2; ++i) { const LAS unsigned char* p = lds + GC_V + (ks * 32 + 8 * g + (li >> 2)) * 528 + ((wave * 2 + i) * 16 + 4 * (li & 3)) * 2; vf[i] = cat8(vtr(p), vtr(p + 4 * 528)); }
#pragma unroll
            for (int cb = 0; cb < 4; ++cb) { const bf16x8 af = *(const LAS bf16x8*)(lds + GC_ATT + (cb * 16 + li) * 144 + (ks * 32 + 8 * g) * 2);
#pragma unroll
                for (int i = 0; i < 2; ++i) acc[cb][i] = mfma16(af, vf[i], acc[cb][i]); } }
#pragma unroll
        for (int ks = 0; ks < 4; ++ks)
#pragma unroll
            for (int cb = 0; cb < 4; ++cb) { const bf16x8 qa = *(const LAS bf16x8*)(lds + GC_QD + (cb * 16 + li) * 272 + (ks * 32 + 8 * g) * 2);
#pragma unroll
                for (int i = 0; i < 2; ++i) acc[cb][i] = mfma16(qa, sf[i][ks], acc[cb][i]); }
        LAS float* ss = (LAS float*)(lds + GC_SS);
#pragma unroll
        for (int cb = 0; cb < 4; ++cb)
#pragma unroll
            for (int r = 0; r < 4; ++r) { float q = acc[cb][0][r] * acc[cb][0][r] + acc[cb][1][r] * acc[cb][1][r];
                q += __shfl_xor(q, 1); q += __shfl_xor(q, 2); q += __shfl_xor(q, 4); q += __shfl_xor(q, 8);
                if (li == 0) ss[(cb * 16 + 4 * g + r) * 8 + wave] = q; }
        __syncthreads();
        LAS float* ost = (LAS float*)(lds + GC_OST);
#pragma unroll
        for (int cb = 0; cb < 4; ++cb)
#pragma unroll
            for (int r = 0; r < 4; ++r) { const int c = cb * 16 + 4 * g + r; const f32x4 s0 = *(const LAS f32x4*)(ss + c * 8), s1 = *(const LAS f32x4*)(ss + c * 8 + 4);
                const float rstd = rsqrtf(((s0.x + s0.y) + (s0.z + s0.w) + (s1.x + s1.y) + (s1.z + s1.w)) * (1.f / 256.f) + EPS);
#pragma unroll
                for (int i = 0; i < 2; ++i) ost[c * 260 + (wave * 2 + i) * 16 + li] = acc[cb][i][r] * rstd; }
        __syncthreads();
        const float* ng = a->in[I_GNG] + l * 256;
#pragma unroll
        for (int i = 0; i < 4; ++i) { const int idx = tid + i * 512, c = idx >> 5, e8 = idx & 31;
            const f32x4 o0 = *(const LAS f32x4*)(ost + c * 260 + e8 * 8), o1 = *(const LAS f32x4*)(ost + c * 260 + e8 * 8 + 4);
            const f32x4 n0 = *(const f32x4*)(ng + e8 * 8), n1 = *(const f32x4*)(ng + e8 * 8 + 4);
            const u32x4 gg = *(const u32x4*)(P + (size_t)(t0 + c) * DINP + C_GG + h * 256 + e8 * 8);
            u32x4 pk;
            pk.x = cvt_pk_bf16(o0.x * n0.x * silu(bflo(gg.x)), o0.y * n0.y * silu(bfhi(gg.x))); pk.y = cvt_pk_bf16(o0.z * n0.z * silu(bflo(gg.y)), o0.w * n0.w * silu(bfhi(gg.y)));
            pk.z = cvt_pk_bf16(o1.x * n1.x * silu(bflo(gg.z)), o1.y * n1.y * silu(bfhi(gg.z))); pk.w = cvt_pk_bf16(o1.z * n1.z * silu(bflo(gg.w)), o1.w * n1.w * silu(bfhi(gg.w)));
            *(u32x4*)(mix + (size_t)(t0 + c) * DM + M_GLA + h * 256 + e8 * 8) = pk; }
    }
    __syncthreads();
}

typedef float f32x16 __attribute__((ext_vector_type(16)));
template <int OFF> __device__ __forceinline__ s16x4 vtr_a(unsigned addr) { s16x4 r; asm volatile("ds_read_b64_tr_b16 %0, %1 offset:%2" : "=v"(r) : "v"(addr), "n"(OFF)); return r; }
#define FX_LGKM0(x) asm volatile("s_waitcnt lgkmcnt(0)" : "+v"(x[0][0][0]), "+v"(x[0][0][1]), "+v"(x[0][1][0]), "+v"(x[0][1][1]), "+v"(x[1][0][0]), "+v"(x[1][0][1]), "+v"(x[1][1][0]), "+v"(x[1][1][1]) :: "memory")
constexpr int FX_F = 0, FX_K = 8192, FX_TILE = 32768, FX_V = FX_K + FX_TILE, FX_BUF = 2 * FX_TILE, FX_MG = FX_K  , FX_WS = FX_K + 2 * FX_BUF, FX_END = FX_WS + 64;
static_assert(FX_END <= MISC_OFF && 3 * 2 * 64 * 66 * 4 <= 2 * FX_BUF, "FoX LDS");
__device__ __forceinline__ void fox_phase(ArgP a, LAS unsigned char* lds, int l) {
    const int tid = opaque_tid(), lane = tid & 63, wave = tid >> 6, wv = __builtin_amdgcn_readfirstlane(tid >> 6), r32 = lane & 31, hh = lane >> 5, rg = wave & 1, kg = wave >> 1;
    const bf16_t* P = (const bf16_t*)(a->ws + WS_P); bf16_t* mix = (bf16_t*)(a->ws + WS_MIX);
    LAS float* Fs = (LAS float*)(lds + FX_F); LAS float* wsum = (LAS float*)(lds + FX_WS);
    constexpr float C1 = 0.08838834764831845f * LOG2E;
    const int k_off = (32 * kg + r32) * 256 + (((r32 & 15) ^ hh) << 4);
    const int v_off = (32 * kg + 4 * hh + ((lane >> 2) & 3)) * 256 + (((lane >> 2) & 3) << 6) + ((2 * ((lane >> 4) & 1) + ((lane & 3) >> 1)) << 4) + ((lane & 1) << 3);
    unsigned dk_o[4]; const unsigned dv_o = (unsigned)((lane >> 4) * (DINP * 2) + C_FV * 2 + (((lane & 15) ^ ((lane >> 4) << 2)) << 4));
#pragma unroll
    for (int j = 0; j < 4; ++j) dk_o[j] = (unsigned)((lane >> 4) * (DINP * 2) + C_FK * 2 + (((lane & 15) ^ (4 * j + (lane >> 4))) << 4));
#define FX_DMA(bo_, key0_) do { const char* _g = (const char*)(P + ((size_t)(b * SEQ + (key0_) + 16 * wv) * DINP + h * 128)); \
        _Pragma("unroll") for (int _j = 0; _j < 4; ++_j) { const char* _r = _g + (size_t)(4 * _j) * DINP * 2; \
            __builtin_amdgcn_global_load_lds((const unsigned*)(_r + dk_o[_j]), (LAS unsigned*)(lds + (bo_) + FX_K + wv * 4096 + _j * 1024), 16, 0, 0); \
            __builtin_amdgcn_global_load_lds((const unsigned*)(_r + dv_o), (LAS unsigned*)(lds + (bo_) + FX_V + wv * 4096 + _j * 1024), 16, 0, 0); } } while (0)
    for (int pr = blockIdx.x; pr < 256; pr += gridDim.x) {
        const int bh = pr & 15, b = bh >> 2, h = bh & 3, rr = pr >> 4;
        { const int t2 = opaque_tid(), ln = t2 & 63, wq = t2 >> 6;
          const f32x4 lf = *(const f32x4*)((const float*)(a->ws + WS_LF) + (b * 4 + h) * SEQ + t2 * 4);
          __syncthreads();
          float v[4]; float run = 0.f;
#pragma unroll
          for (int j = 0; j < 4; ++j) { run += lf[j]; v[j] = run; }
          float inc = run;
#pragma unroll
          for (int o = 1; o < 64; o <<= 1) { const float t = __shfl_up(inc, o); if (ln >= o) inc += t; }
          if (ln == 63) wsum[wq] = inc;
          __syncthreads();
          float pre = inc - run;
#pragma unroll
          for (int q = 0; q < 8; ++q) pre += (q < wq) ? wsum[q] : 0.f;
          *(LAS f32x4*)(Fs + t2 * 4) = (f32x4){-(v[0] + pre), -(v[1] + pre), -(v[2] + pre), -(v[3] + pre)}; }
        __syncthreads();
#pragma unroll 1
        for (int half = 0; half < 2; ++half) {
            const int qb = half == 0 ? 31 - rr : rr, q0 = qb * 64, qrow = q0 + rg * 32 + r32, nsteps = (qb + 2) >> 1;
            bf16x8 qf[8];
#pragma unroll
            for (int ks = 0; ks < 8; ++ks) { const u32x4 w = *(const u32x4*)(P + (size_t)(b * SEQ + qrow) * DINP + C_FQ + h * 128 + ks * 16 + 8 * hh); u32x4 o;
                o.x = cvt_pk_bf16(bflo(w.x) * C1, bfhi(w.x) * C1); o.y = cvt_pk_bf16(bflo(w.y) * C1, bfhi(w.y) * C1); o.z = cvt_pk_bf16(bflo(w.z) * C1, bfhi(w.z) * C1); o.w = cvt_pk_bf16(bflo(w.w) * C1, bfhi(w.w) * C1);
                qf[ks] = __builtin_bit_cast(bf16x8, o); }
            float m = -1e30f, lsum = 0.f; f32x16 O[4];
#pragma unroll
            for (int j = 0; j < 4; ++j)
#pragma unroll
                for (int r = 0; r < 16; ++r) O[j][r] = 0.f;
            __syncthreads();
            FX_DMA(0, 0);
            if (1 < nsteps) { FX_DMA(FX_BUF, 128); asm volatile("s_waitcnt vmcnt(8)" ::: "memory"); } else asm volatile("s_waitcnt vmcnt(0)" ::: "memory");
            __builtin_amdgcn_s_barrier();
#pragma unroll 1
            for (int st = 0; st < nsteps; ++st) {
                const int kb0 = st * 128, bo = (st & 1) * FX_BUF;
                const int kw0 = kb0 + 32 * kg;
                if (kw0 <= q0 + rg * 32 + 31) {
                    bf16x8 kf[8];
#pragma unroll
                    for (int ks = 0; ks < 8; ++ks) kf[ks] = *(const LAS bf16x8*)(lds + bo + FX_K + (k_off ^ (ks << 5)));
                    f32x16 sc;
#pragma unroll
                    for (int i = 0; i < 4; ++i) { const f32x4 fk = *(const LAS f32x4*)(Fs + kw0 + 8 * i + 4 * hh); sc[4 * i] = fk[0]; sc[4 * i + 1] = fk[1]; sc[4 * i + 2] = fk[2]; sc[4 * i + 3] = fk[3]; }
                    __builtin_amdgcn_sched_barrier(0);
#pragma unroll
                    for (int ks = 0; ks < 8; ++ks) sc = __builtin_amdgcn_mfma_f32_32x32x16_bf16(kf[ks], qf[ks], sc, 0, 0, 0);
                    s16x4 vf[2][2][2], vg[2][2][2];
#pragma unroll
                    for (int db = 0; db < 2; ++db) { const unsigned vp = (unsigned)(size_t)(lds + bo + FX_V) + (unsigned)(v_off ^ (db << 6));
                        vf[db][0][0] = vtr_a<0>(vp); vf[db][0][1] = vtr_a<2048>(vp); vf[db][1][0] = vtr_a<4096>(vp); vf[db][1][1] = vtr_a<6144>(vp); }
                    __builtin_amdgcn_sched_barrier(0);
                    FX_LGKM0(vf);
                    if (kw0 + 31 > q0 + rg * 32) {
#pragma unroll
                        for (int r = 0; r < 16; ++r) if (kw0 + (r & 3) + 8 * (r >> 2) + 4 * hh > qrow) sc[r] = -__builtin_inff(); }
                    float mx = sc[0];
#pragma unroll
                    for (int r = 1; r < 16; ++r) mx = fmaxf(mx, sc[r]);
                    mx = fmaxf(mx, __shfl_xor(mx, 32));
                    const float mn = fmaxf(m, mx), alpha = __builtin_amdgcn_exp2f(m - mn); m = mn;
                    float ps = 0.f;
#pragma unroll
                    for (int r = 0; r < 16; ++r) { sc[r] = __builtin_amdgcn_exp2f(sc[r] - mn); ps += sc[r]; }
                    bf16x8 pf[2];
#pragma unroll
                    for (int s2 = 0; s2 < 2; ++s2) { u32x4 w; w.x = cvt_pk_bf16(sc[8 * s2], sc[8 * s2 + 1]); w.y = cvt_pk_bf16(sc[8 * s2 + 2], sc[8 * s2 + 3]); w.z = cvt_pk_bf16(sc[8 * s2 + 4], sc[8 * s2 + 5]); w.w = cvt_pk_bf16(sc[8 * s2 + 6], sc[8 * s2 + 7]);
                        pf[s2] = __builtin_bit_cast(bf16x8, w); }
                    lsum = lsum * alpha + ps;
                    if (!__all(alpha == 1.f)) {
#pragma unroll
                        for (int db = 0; db < 4; ++db)
#pragma unroll
                            for (int r = 0; r < 16; ++r) O[db][r] *= alpha; }
                    __builtin_amdgcn_sched_barrier(0);
#pragma unroll
                    for (int db = 0; db < 2; ++db) { const unsigned vp = (unsigned)(size_t)(lds + bo + FX_V) + (unsigned)(v_off ^ ((db + 2) << 6));
                        vg[db][0][0] = vtr_a<0>(vp); vg[db][0][1] = vtr_a<2048>(vp); vg[db][1][0] = vtr_a<4096>(vp); vg[db][1][1] = vtr_a<6144>(vp); }
#pragma unroll
                    for (int db = 0; db < 2; ++db)
#pragma unroll
                        for (int s2 = 0; s2 < 2; ++s2) O[db] = __builtin_amdgcn_mfma_f32_32x32x16_bf16(cat8(vf[db][s2][0], vf[db][s2][1]), pf[s2], O[db], 0, 0, 0);
                    __builtin_amdgcn_sched_barrier(0);
                    FX_LGKM0(vg);
#pragma unroll
                    for (int db = 0; db < 2; ++db)
#pragma unroll
                        for (int s2 = 0; s2 < 2; ++s2) O[db + 2] = __builtin_amdgcn_mfma_f32_32x32x16_bf16(cat8(vg[db][s2][0], vg[db][s2][1]), pf[s2], O[db + 2], 0, 0, 0);
                }
                asm volatile("s_waitcnt vmcnt(0)" ::: "memory");
                __builtin_amdgcn_s_barrier();
                if (st + 2 < nsteps) FX_DMA(bo, kb0 + 256);
            }
            lsum += __shfl_xor(lsum, 32);
            LAS float* mg = (LAS float*)(lds + FX_MG);
            if (kg > 0) { LAS float* q = mg + (((kg - 1) * 2 + rg) * 64 + lane) * 66; q[0] = m; q[1] = lsum;
#pragma unroll
                for (int db = 0; db < 4; ++db)
#pragma unroll
                    for (int r = 0; r < 16; ++r) q[2 + db * 16 + r] = O[db][r]; }
            __syncthreads();
            if (kg == 0) { float mn = m;
#pragma unroll
                for (int j = 0; j < 3; ++j) mn = fmaxf(mn, mg[((j * 2 + rg) * 64 + lane) * 66]);
                float a0 = __builtin_amdgcn_exp2f(m - mn), lt = lsum * a0;
#pragma unroll
                for (int db = 0; db < 4; ++db)
#pragma unroll
                    for (int r = 0; r < 16; ++r) O[db][r] *= a0;
#pragma unroll
                for (int j = 0; j < 3; ++j) { const LAS float* q = mg + ((j * 2 + rg) * 64 + lane) * 66; const float aj = __builtin_amdgcn_exp2f(q[0] - mn); lt += q[1] * aj;
#pragma unroll
                    for (int db = 0; db < 4; ++db)
#pragma unroll
                        for (int r = 0; r < 16; ++r) O[db][r] += q[2 + db * 16 + r] * aj; }
                const float inv = 1.f / lt;
                bf16_t* orow = mix + (size_t)(b * SEQ + qrow) * DM + M_FOX + h * 128 + 4 * hh;
#pragma unroll
                for (int db = 0; db < 4; ++db)
#pragma unroll
                    for (int i = 0; i < 4; ++i) { u32x2 w; w.x = cvt_pk_bf16(O[db][4 * i] * inv, O[db][4 * i + 1] * inv); w.y = cvt_pk_bf16(O[db][4 * i + 2] * inv, O[db][4 * i + 3] * inv);
                        *(u32x2*)(orow + db * 32 + 8 * i) = w; } }
        }
    }
#undef FX_DMA
    __syncthreads();
}

constexpr int RT_RS = 0, RT_PART = 256, RT_END = RT_PART + 8 * 32 * 48 * 4;
__device__ __forceinline__ void router_phase(ArgP a, LAS unsigned char* lds, int l, const bf16_t* x1) {
    const int tid = opaque_tid(), lane = tid & 63, wave = tid >> 6, g = lane >> 4, li = lane & 15;
    LAS float* rsd = (LAS float*)(lds + RT_RS); LAS float* part = (LAS float*)(lds + RT_PART);
    const float* g2 = a->in[I_N2G] + l * DM; bf16_t* h2 = (bf16_t*)(a->ws + WS_H);
    const bf16_t* wr = (const bf16_t*)(a->ws + WS_WR) + (size_t)l * 2 * 48 * DM;
    unsigned* cnt = (unsigned*)(a->ws + WS_CTL) + CW_CNT + l * 32 * 64; int* list = (int*)(a->ws + WS_LIST); float* gwb = (float*)(a->ws + WS_GW);
    for (int item = blockIdx.x; item < T / 32; item += gridDim.x) {
        const int tk0 = item * 32;
        __syncthreads();
        { u32x4 q[4][4];
#pragma unroll
          for (int r = 0; r < 4; ++r)
#pragma unroll
              for (int j = 0; j < 4; ++j) q[r][j] = ((const u32x4*)(x1 + (size_t)(tk0 + wave * 4 + r) * DM) + lane)[64 * j];
          f32x4 ga[4], gb[4];
#pragma unroll
          for (int j = 0; j < 4; ++j) { ga[j] = ((const f32x4*)g2)[2 * (lane + 64 * j)]; gb[j] = ((const f32x4*)g2)[2 * (lane + 64 * j) + 1]; }
#pragma unroll
          for (int r = 0; r < 4; ++r) { const int row = wave * 4 + r; float s = 0.f;
#pragma unroll
              for (int j = 0; j < 4; ++j) { const u32x4 w = q[r][j]; s += (bflo(w.x) * bflo(w.x) + bfhi(w.x) * bfhi(w.x)) + (bflo(w.y) * bflo(w.y) + bfhi(w.y) * bfhi(w.y)) + (bflo(w.z) * bflo(w.z) + bfhi(w.z) * bfhi(w.z)) + (bflo(w.w) * bflo(w.w) + bfhi(w.w) * bfhi(w.w)); }
              const float rstd = rsqrtf(wave_sum(s) * (1.f / DM) + EPS);
              if (lane == 0) rsd[row] = rstd;
              u32x4* o = (u32x4*)(h2 + (size_t)(tk0 + row) * DM) + lane;
#pragma unroll
              for (int j = 0; j < 4; ++j) { const u32x4 x = q[r][j]; u32x4 w;
                  w.x = cvt_pk_bf16(bflo(x.x) * rstd * ga[j].x, bfhi(x.x) * rstd * ga[j].y); w.y = cvt_pk_bf16(bflo(x.y) * rstd * ga[j].z, bfhi(x.y) * rstd * ga[j].w);
                  w.z = cvt_pk_bf16(bflo(x.z) * rstd * gb[j].x, bfhi(x.z) * rstd * gb[j].y); w.w = cvt_pk_bf16(bflo(x.w) * rstd * gb[j].z, bfhi(x.w) * rstd * gb[j].w); o[64 * j] = w; } } }
        __syncthreads();
        { const int kq = wave;
          f32x4 acc[2][3];
#pragma unroll
          for (int mb = 0; mb < 2; ++mb)
#pragma unroll
              for (int cb = 0; cb < 3; ++cb) acc[mb][cb] = (f32x4){0.f, 0.f, 0.f, 0.f};
          const bf16_t* xrow = x1 + (size_t)(tk0 + li) * DM + kq * 256 + 8 * g; const bf16_t* wq = wr + kq * 256 + 8 * g;
#pragma unroll 2
          for (int ks = 0; ks < 8; ++ks) {
              const bf16x8 ax0 = *(const bf16x8*)(xrow + ks * 32), ax1 = *(const bf16x8*)(xrow + (size_t)16 * DM + ks * 32);
#pragma unroll
              for (int cb = 0; cb < 3; ++cb) { const bf16x8 wh = *(const bf16x8*)(wq + (size_t)(cb * 16 + li) * DM + ks * 32), wl = *(const bf16x8*)(wq + (size_t)(48 + cb * 16 + li) * DM + ks * 32);
                  acc[0][cb] = mfma16(ax0, wh, acc[0][cb]); acc[0][cb] = mfma16(ax0, wl, acc[0][cb]); acc[1][cb] = mfma16(ax1, wh, acc[1][cb]); acc[1][cb] = mfma16(ax1, wl, acc[1][cb]); }
          }
#pragma unroll
          for (int mb = 0; mb < 2; ++mb)
#pragma unroll
              for (int cb = 0; cb < 3; ++cb)
#pragma unroll
                  for (int r = 0; r < 4; ++r) part[(kq * 32 + mb * 16 + 4 * g + r) * 48 + cb * 16 + li] = acc[mb][cb][r] * rsd[mb * 16 + 4 * g + r]; }
        __syncthreads();
        if (tid < 32) {
            const int tok = tk0 + tid; float lg[36];
#pragma unroll
            for (int c = 0; c < 36; ++c) lg[c] = 0.f;
#pragma unroll 1
            for (int q = 0; q < 8; ++q) {
#pragma unroll
                for (int c = 0; c < 36; ++c) lg[c] += part[(q * 32 + tid) * 48 + c]; }
            float gl[4]; int grp = 0; float gmx;
#pragma unroll
            for (int c = 0; c < 4; ++c) gl[c] = lg[c] + a->in[I_RGB][l * 4 + c];
            gmx = gl[0];
#pragma unroll
            for (int c = 1; c < 4; ++c) if (gl[c] > gmx) { gmx = gl[c]; grp = c; }
            float den = 0.f;
#pragma unroll
            for (int c = 0; c < 4; ++c) den += __expf(gl[c] - gmx);
            const float ptop = 1.f / den;
            float v1 = -__builtin_inff(), v2 = -__builtin_inff(); int i1 = 0, i2 = 0;
#pragma unroll
            for (int e = 0; e < 8; ++e) { float ev = 0.f;
#pragma unroll
                for (int q = 0; q < 4; ++q) ev = (grp == q) ? lg[4 + q * 8 + e] : ev;
                const float v = ev + a->in[I_REB][(l * 4 + grp) * 8 + e];
                if (v > v1) { v2 = v1; i2 = i1; v1 = v; i1 = e; } else if (v > v2) { v2 = v; i2 = e; } }
            const float w1 = ptop / (1.f + __expf(v2 - v1)), w2 = ptop - w1;
            const int E1 = grp * 8 + i1, E2 = grp * 8 + i2;
            const unsigned s1 = atomicAdd(cnt + E1 * 64, 1u), s2 = atomicAdd(cnt + E2 * 64, 1u);
            list[E1 * CAPE + s1] = tok * 2; gwb[E1 * CAPE + s1] = w1;
            list[E2 * CAPE + s2] = tok * 2 + 1; gwb[E2 * CAPE + s2] = w2;
        }
    }
    __syncthreads();
}
__device__ __forceinline__ void moe_setup(ArgP a, LAS int* tab, int l) {
    __syncthreads();
    if (threadIdx.x < 32) { unsigned* cnt = (unsigned*)(a->ws + WS_CTL) + CW_CNT + l * 32 * 64; tab[33 + threadIdx.x] = (int)__hip_atomic_load(cnt + threadIdx.x * 64, __ATOMIC_RELAXED, __HIP_MEMORY_SCOPE_AGENT); }
    __syncthreads();
    if (threadIdx.x == 0) { int ts = 0; for (int e = 0; e < 32; ++e) { tab[e] = ts; tab[65 + e] = ts * 256; ts += (tab[33 + e] + 255) >> 8; } tab[32] = ts; }
    __syncthreads();
}
__device__ __forceinline__ void combine_phase(ArgP a, int l, const bf16_t* x1, bf16_t* x2) {
    const int tid = opaque_tid(), lane = tid & 63, wave = tid >> 6;
    const int gw = blockIdx.x * NWAVES + wave, NGW = gridDim.x * NWAVES;
    const bf16_t* Y = (const bf16_t*)(a->ws + WS_Y);
    const float* g = (l + 1 < DEPTH) ? a->in[I_N1G] + (l + 1) * DM : a->in[I_FNG];
    u32x2 rx[8], ry0[8], ry1[8];
#define CB_LOAD(m_) do { const u32x2* xr = (const u32x2*)(x1 + (size_t)(m_) * DM) + lane; const u32x2* y0 = (const u32x2*)(Y + (size_t)(2 * (m_)) * DM) + lane; const u32x2* y1 = (const u32x2*)(Y + (size_t)(2 * (m_) + 1) * DM) + lane; \
        _Pragma("unroll") for (int j = 0; j < 8; ++j) { rx[j] = xr[64 * j]; ry0[j] = y0[64 * j]; ry1[j] = y1[64 * j]; } } while (0)
    if (gw < T) CB_LOAD(gw);
    for (int m = gw; m < T; m += NGW) {
        f32x4 v[8]; float s = 0.f;
#pragma unroll
        for (int j = 0; j < 8; ++j) { const u32x2 xx = rx[j], a0 = ry0[j], a1 = ry1[j];
            v[j] = (f32x4){bflo(xx.x) + (bflo(a0.x) + bflo(a1.x)), bfhi(xx.x) + (bfhi(a0.x) + bfhi(a1.x)), bflo(xx.y) + (bflo(a0.y) + bflo(a1.y)), bfhi(xx.y) + (bfhi(a0.y) + bfhi(a1.y))};
            s += (v[j].x * v[j].x + v[j].y * v[j].y) + (v[j].z * v[j].z + v[j].w * v[j].w); }
        if (m + NGW < T) CB_LOAD(m + NGW);
        const float rstd = rsqrtf(wave_sum(s) * (1.f / DM) + EPS);
        if (l + 1 < DEPTH) {
            u32x2* xo = (u32x2*)(x2 + (size_t)m * DM) + lane; u32x2* o = (u32x2*)((bf16_t*)(a->ws + WS_H) + (size_t)m * DM) + lane;
#pragma unroll
            for (int j = 0; j < 8; ++j) { u32x2 xw; xw.x = cvt_pk_bf16(v[j].x, v[j].y); xw.y = cvt_pk_bf16(v[j].z, v[j].w); xo[64 * j] = xw;
                const f32x4 gg = ((const f32x4*)g)[lane + 64 * j]; u32x2 w; w.x = cvt_pk_bf16(v[j].x * rstd * gg.x, v[j].y * rstd * gg.y); w.y = cvt_pk_bf16(v[j].z * rstd * gg.z, v[j].w * rstd * gg.w); o[64 * j] = w; }
        } else {
            f32x4* oo = (f32x4*)(a->out + (size_t)m * DM) + lane;
#pragma unroll
            for (int j = 0; j < 8; ++j) { const f32x4 gg = ((const f32x4*)g)[lane + 64 * j]; oo[64 * j] = (f32x4){v[j].x * rstd * gg.x, v[j].y * rstd * gg.y, v[j].z * rstd * gg.z, v[j].w * rstd * gg.w}; }
        }
    }
}

constexpr int PH_PER_LAYER = 9, N_PHASES = 1 + DEPTH * PH_PER_LAYER;
#ifndef PH_MASK
#define PH_MASK 0x3ff
#endif
__global__ void __launch_bounds__(NTHR, 2) fwd(Args) {
    extern __shared__ __attribute__((aligned(16))) unsigned char lds_raw[];
    LAS unsigned char* lds = (LAS unsigned char*)lds_raw;
    volatile LAS unsigned* MISC = (volatile LAS unsigned*)(lds + MISC_OFF);
    LAS int* tab = (LAS int*)(lds + MISC_OFF + 64);
    if (threadIdx.x < 256) MISC[threadIdx.x] = 0u;
    __syncthreads();
    int lo, hi; XcdBarrier bar;
    { ArgP a = kargs(); lo = a->ph_lo; hi = a->ph_hi; bar.bar = (unsigned*)(a->ws + WS_CTL) + CW_BAR; bar.x = 0; bar.st = nullptr;
      if (!MK_PER_PHASE) bar = xcd_barrier_post((unsigned*)(a->ws + WS_CTL) + CW_BAR, MISC); }
#define IN(k) (lo <= (k) && (k) < hi)
#define EN(j) ((PH_MASK >> (j)) & 1)
#ifndef REP_MASK
#define REP_MASK 0
#endif
#define REP(j) for (int _rep = 0; _rep < 1 + ((REP_MASK >> (j)) & 1); ++_rep)
#define SEAM(k) do { if (!MK_PER_PHASE && IN(k) && IN((k) + 1)) xcd_barrier(bar); } while (0)
    if (EN(0) && IN(0)) REP(0) { p0_prologue(kargs(), lds); __syncthreads(); }
    SEAM(0);
#pragma unroll 1
    for (int l = 0; l < DEPTH; ++l) {
        const int p0 = 1 + l * PH_PER_LAYER;
        if (EN(1) && IN(p0 + 0)) REP(1) { ArgP a = kargs();
            pg::DenseSched<DM> S; S.init((const bf16_t*)(a->ws + WS_WIN) + (size_t)l * DINP * DM, T, DINP, gridDim.x, blockIdx.x);
            pg::EpiBf16 E{(bf16_t*)(a->ws + WS_P), DINP};
            pg::gemm_phase<DM, pg::EpiBf16, pg::DenseSched<DM>>(lds, (const char*)(a->ws + WS_H), S, E);
            if (l == 0) { int rk, nr; idle_rank((T / 256) * (DINP / 256), gridDim.x, blockIdx.x, rk, nr); if (rk >= 0) cvt_range(kargs(), lds, CV_N_IN, CV_I_OUT, rk, nr); __syncthreads(); }
        }
        SEAM(p0 + 0);
        if (EN(2) && IN(p0 + 1)) { REP(2) conv_phase(kargs(), lds, l); REP(10) gla_a_phase(kargs(), lds, l); }
        SEAM(p0 + 1);
        if (EN(3) && IN(p0 + 2)) { gla_b_phase(kargs(), lds); REP(3) fox_phase(kargs(), lds, l); }
        SEAM(p0 + 2);
        if (EN(4) && IN(p0 + 3)) REP(4) { gla_c_phase(kargs(), lds, l); }
        SEAM(p0 + 3);
        if (EN(5) && IN(p0 + 4)) REP(5) { ArgP a = kargs();
            pg::DenseSched<DM> S; S.init((const bf16_t*)(a->ws + WS_WOUT) + (size_t)l * DM * DM, T, DM, gridDim.x, blockIdx.x);
            pg::EpiRes E{(const bf16_t*)(a->ws + WS_XB), (bf16_t*)(a->ws + WS_XA), DM};
            pg::gemm_phase<DM, pg::EpiRes, pg::DenseSched<DM>>(lds, (const char*)(a->ws + WS_MIX), S, E);
        }
        SEAM(p0 + 4);
        if (EN(6) && IN(p0 + 5)) { ArgP a = kargs(); router_phase(a, lds, l, (const bf16_t*)(a->ws + WS_XA)); }
        SEAM(p0 + 5);
        if (EN(7) && IN(p0 + 6)) REP(7) { ArgP a = kargs();
            moe_setup(a, tab, l);
            const int vcu = (gridDim.x % 8 == 0) ? (int)((blockIdx.x % 8) * (gridDim.x / 8) + blockIdx.x / 8) : (int)blockIdx.x;
            pg::MoeSchedRB<DM, 8, true> S{a->in[I_WG] + (size_t)l * NEX * DM * DE, a->in[I_WU] + (size_t)l * NEX * DM * DE, tab, (const int*)(a->ws + WS_LIST), (int)gridDim.x, vcu};
#ifndef RBP
#define RBP 0
#endif
            pg::EpiGateUpRB E{(bf16_t*)(a->ws + (_rep ? WS_WGU : WS_HB)), (const float*)(a->ws + WS_GW)};
            pg::gemm_rb<DM, DE, pg::EpiGateUpRB, pg::MoeSchedRB<DM, 8, true>>(lds, (const char*)(a->ws + WS_H), S, E);
            if (l == 0) { int rk, nr; idle_rank(tab[32] * 8, gridDim.x, vcu, rk, nr); if (rk >= 0) { cvt_range(kargs(), lds, CV_I_IN, CV_I_IN, rk, nr); cvt_range(kargs(), lds, CV_N_IN + CV_I_OUT, CV_I_OUT, rk, nr); } __syncthreads(); }
        }
        SEAM(p0 + 6);
        if (EN(8) && IN(p0 + 7)) REP(8) { ArgP a = kargs();
            moe_setup(a, tab, l);
            const int vcu = (gridDim.x % 8 == 0) ? (int)((blockIdx.x % 8) * (gridDim.x / 8) + blockIdx.x / 8) : (int)blockIdx.x;
            pg::MoeSchedRB<DE, 16, false> S{a->in[I_WD] + (size_t)l * NEX * DE * DM, nullptr, tab, (const int*)(a->ws + WS_LIST), (int)gridDim.x, vcu};
            pg::EpiDownRB E{(bf16_t*)(a->ws + WS_Y), (const int*)(a->ws + WS_LIST)};
            pg::gemm_rb<DE, DM, pg::EpiDownRB, pg::MoeSchedRB<DE, 16, false>>(lds, (const char*)(a->ws + WS_HB), S, E);
        }
        SEAM(p0 + 7);
        if (EN(9) && IN(p0 + 8)) REP(9) { ArgP a = kargs(); combine_phase(a, l, (const bf16_t*)(a->ws + WS_XA), (bf16_t*)(a->ws + WS_XB)); }
        SEAM(p0 + 8);
    }
#undef IN
#undef EN
#undef SEAM
}

#ifdef DBG_STAGE
__global__ void dbg_dump(const unsigned char* ws, float* out, int kind) {
    for (size_t i = (size_t)blockIdx.x * blockDim.x + threadIdx.x; i < (size_t)T * DM; i += (size_t)gridDim.x * blockDim.x) {
        const size_t r = i / DM, c = i % DM; float v = 0.f;
        if (kind == 1) v = bf2f(((const bf16_t*)(ws + WS_P))[r * DINP + 2048 + c]);
        else if (kind == 2) v = bf2f(((const bf16_t*)(ws + WS_MIX))[i]);
        else if (kind == 7) v = c < 512 ? bf2f(((const bf16_t*)(ws + WS_MIX))[i]) : 0.f;
        else if (kind == 8) v = (c >= 512 && c < 1536) ? bf2f(((const bf16_t*)(ws + WS_MIX))[i]) : 0.f;
        else if (kind == 9) v = c >= 1536 ? bf2f(((const bf16_t*)(ws + WS_MIX))[i]) : 0.f;
        else if (kind == 10 || kind == 11) v = bf2f(((const bf16_t*)(ws + WS_KV))[i]);
        else if (kind == 12) v = ((const float*)(ws + WS_DEC))[i & 65535];
        else if (kind == 13) v = bf2f(((const bf16_t*)(ws + WS_P))[r * DINP + c]);
        else if (kind == 14) v = bf2f(((const bf16_t*)(ws + WS_P))[r * DINP + 3840 + c]);
        else if (kind == 3) v = bf2f(((const bf16_t*)(ws + WS_XA))[i]);
        else if (kind == 4) v = bf2f(((const bf16_t*)(ws + WS_XB))[i]);
        else if (kind == 5) v = bf2f(((const bf16_t*)(ws + WS_H))[i]);
        else if (kind == 6) v = ((const float*)(ws + WS_Y))[i] + ((const float*)(ws + WS_Y))[i + (size_t)T * DM];
        out[i] = v; }
}
#endif
extern "C" void kernel_launch(void* const* d_in, const int* in_sizes, int n_in, void* d_out, int out_size, void* d_ws, size_t ws_size, hipStream_t stream) {
    static int grid = 0;
    if (grid == 0) {
        if (n_in != 21 || ws_size < WS_END) { fprintf(stderr, "kernel_launch: need 21 inputs and %zu bytes of workspace (got %d, %zu)\n", (size_t)WS_END, n_in, ws_size); grid = -1; return; }
        int dev = 0, cus = 0, per_cu = 0;
        if (hipGetDevice(&dev) != hipSuccess || hipDeviceGetAttribute(&cus, hipDeviceAttributeMultiprocessorCount, dev) != hipSuccess) { grid = -1; return; }
        if (hipFuncSetAttribute((const void*)fwd, hipFuncAttributeMaxDynamicSharedMemorySize, LDS_BYTES) != hipSuccess) { fprintf(stderr, "kernel_launch: hipFuncSetAttribute failed\n"); grid = -1; return; }
        if (hipOccupancyMaxActiveBlocksPerMultiprocessor(&per_cu, (const void*)fwd, NTHR, LDS_BYTES) != hipSuccess || per_cu < 1) { fprintf(stderr, "kernel_launch: occupancy query says %d\n", per_cu); per_cu = 1; }
        (void)hipGetLastError();
        grid = cus;
    }
    if (grid < 0) return;
    (void)hipMemsetAsync((char*)d_ws + WS_CTL, 0, CTL_ZERO_BYTES, stream);
    Args a{};
    for (int i = 0; i < 21; ++i) a.in[i] = (const float*)d_in[i];
    a.out = (float*)d_out; a.ws = (unsigned char*)d_ws;
#ifdef DBG_STAGE
    { const int last[15] = {0, 1, 4, 5, 9, 6, 8, 4, 4, 4, 2, 3, 2, 1, 1}; for (int p = 0; p <= last[DBG_STAGE]; ++p) { a.ph_lo = p; a.ph_hi = p + 1; hipLaunchKernelGGL(fwd, dim3(grid), dim3(NTHR), LDS_BYTES, stream, a); }
      hipLaunchKernelGGL(dbg_dump, dim3(2048), dim3(256), 0, stream, (const unsigned char*)d_ws, (float*)d_out, DBG_STAGE); }
#elif MK_PER_PHASE
    for (int p = 0; p < N_PHASES; ++p) { a.ph_lo = p; a.ph_hi = p + 1; hipLaunchKernelGGL(fwd, dim3(grid), dim3(NTHR), LDS_BYTES, stream, a); }
#else
    a.ph_lo = 0; a.ph_hi = N_PHASES; hipLaunchKernelGGL(fwd, dim3(grid), dim3(NTHR), LDS_BYTES, stream, a);
#endif
}
```

```cpp
#include <hip/hip_runtime.h>
#include <cstdio>
#include <cstdint>

#ifndef MK_PER_PHASE
#define MK_PER_PHASE 0
#endif

#define LAS __attribute__((address_space(3)))
#define GAS __attribute__((address_space(1)))
typedef unsigned short bf16_t;
typedef short bf16x8 __attribute__((ext_vector_type(8)));
typedef short s16x4 __attribute__((ext_vector_type(4)));
typedef short v4i16_t __attribute__((ext_vector_type(4)));
typedef float f32x4 __attribute__((ext_vector_type(4)));
typedef float f32x2 __attribute__((ext_vector_type(2)));
typedef unsigned u32x4 __attribute__((ext_vector_type(4)));
typedef unsigned u32x2 __attribute__((ext_vector_type(2)));

constexpr int NB = 4, SEQ = 2048, T = NB * SEQ, DM = 2048, DEPTH = 2;
constexpr int DIN = 5652, DINP = 5888;
constexpr int C_CA = 0, C_CG = 512, C_GQ = 1024, C_GK = 1536, C_GV = 2048, C_GG = 3072, C_GLOW = 4096, C_FQ = 4112, C_FK = 4624, C_FV = 5136, C_FF = 5648;
constexpr int M_CONV = 0, M_GLA = 512, M_FOX = 1536;
constexpr int NEX = 32, DE = 512, CAPE = 8192, HROWS = 16384 + 32 * 256;
constexpr float EPS = 1e-6f;
constexpr float LOG2E = 1.4426950408889634f;

constexpr size_t MiB = 1u << 20;
constexpr size_t WS_CTL = 0, CTL_ZERO_BYTES = 64 * 1024;
constexpr size_t WS_WIN = 1 * MiB;
constexpr size_t WS_WOUT = 48 * MiB;
constexpr size_t WS_WGU = 64 * MiB;
constexpr size_t WS_WD = 320 * MiB;
constexpr size_t WS_WR = 448 * MiB;
constexpr size_t WS_XA = 449 * MiB;
constexpr size_t WS_XB = 513 * MiB;
constexpr size_t WS_H = 577 * MiB;
constexpr size_t WS_RSB = 577 * MiB;
constexpr size_t WS_P = 609 * MiB;
constexpr size_t WS_MIX = 701 * MiB;
constexpr size_t WS_KV = 733 * MiB;
constexpr size_t WS_DEC = 765 * MiB;
constexpr size_t WS_RS = 765 * MiB + 768 * 1024;
constexpr size_t WS_LF = 765 * MiB + 512 * 1024;
constexpr size_t WS_CUM = 64 * MiB;
constexpr size_t WS_LIST = 766 * MiB;
constexpr size_t WS_GW = 767 * MiB;
constexpr size_t WS_HB = 768 * MiB;
constexpr size_t WS_Y = 792 * MiB;
constexpr size_t WS_END = 920 * MiB;
constexpr int CW_BAR = 0;
constexpr int CW_CNT = 4096;

constexpr int LDS_BYTES = 163840, MISC_OFF = LDS_BYTES - 1024;
constexpr int NWAVES = 8, NTHR = 512;

typedef __bf16 bf2_t __attribute__((ext_vector_type(2)));
__device__ __forceinline__ unsigned cvt_pk_bf16(float lo, float hi) { const f32x2 v = {lo, hi}; return __builtin_bit_cast(unsigned, __builtin_convertvector(v, bf2_t)); }
__device__ __forceinline__ bf16_t f2bf(float f) { return __builtin_bit_cast(bf16_t, (__bf16)f); }
__device__ __forceinline__ float bf2f(bf16_t b) { return __uint_as_float(((unsigned)b) << 16); }
__device__ __forceinline__ float bflo(unsigned w) { return __uint_as_float(w << 16); }
__device__ __forceinline__ float bfhi(unsigned w) { return __uint_as_float(w & 0xffff0000u); }
template <int CTRL> __device__ __forceinline__ float dpp_f(float v) { return __int_as_float(__builtin_amdgcn_update_dpp(0, __float_as_int(v), CTRL, 0xf, 0xf, false)); }
__device__ __forceinline__ float row16_sum(float v) { v += dpp_f<0x128>(v); v += dpp_f<0x124>(v); v += dpp_f<0x122>(v); v += dpp_f<0x121>(v); return v; }
__device__ __forceinline__ float wave_sum(float v) {
    v = row16_sum(v);
    const int b = __float_as_int(v);
    return (__int_as_float(__builtin_amdgcn_readlane(b, 0)) + __int_as_float(__builtin_amdgcn_readlane(b, 16))) + (__int_as_float(__builtin_amdgcn_readlane(b, 32)) + __int_as_float(__builtin_amdgcn_readlane(b, 48)));
}
__device__ __forceinline__ float log_sigmoid(float x) { return fminf(x, 0.f) - __logf(1.f + __expf(-fabsf(x))); }
__device__ __forceinline__ float silu(float x) { return x * __builtin_amdgcn_rcpf(1.f + __expf(-x)); }
__device__ __forceinline__ s16x4 vtr(const LAS void* p) { return __builtin_bit_cast(s16x4, __builtin_amdgcn_ds_read_tr16_b64_v4i16((LAS v4i16_t*)p)); }
__device__ __forceinline__ bf16x8 cat8(s16x4 a, s16x4 b) { bf16x8 r; r[0] = a[0]; r[1] = a[1]; r[2] = a[2]; r[3] = a[3]; r[4] = b[0]; r[5] = b[1]; r[6] = b[2]; r[7] = b[3]; return r; }
__device__ __forceinline__ f32x4 mfma16(bf16x8 a, bf16x8 b, f32x4 c) { return __builtin_amdgcn_mfma_f32_16x16x32_bf16(a, b, c, 0, 0, 0); }
__device__ __forceinline__ int opaque_tid() { int t = threadIdx.x; asm volatile("" : "+v"(t)); return t; }
#define LDS_WAIT() asm volatile("s_waitcnt lgkmcnt(0)" ::: "memory")
#define VM_WAIT() asm volatile("s_waitcnt vmcnt(0)" ::: "memory")

#define XB_TMO      128
#define XB_XCNT(j)  (256  + 64 * (j))
#define XB_XSUB(j)  (1280 + 64 * (j))
#define XB_XGEN(j)  (2304 + 64 * (j))
#define XB_TOP      3328
#define XB_TOPGEN   3392
#define XCD_BAR_WORDS 3456
#define XB_SPIN_CAP (1u << 18)
__device__ __forceinline__ unsigned xb_ld(unsigned* p)              { return __hip_atomic_load(p, __ATOMIC_RELAXED, __HIP_MEMORY_SCOPE_AGENT); }
__device__ __forceinline__ unsigned xb_add(unsigned* p, unsigned v) { return __hip_atomic_fetch_add(p, v, __ATOMIC_RELAXED, __HIP_MEMORY_SCOPE_AGENT); }
__device__ __forceinline__ unsigned xb_xcc_id() { return (unsigned)__builtin_amdgcn_s_getreg((3 << 11) | 20) & 0xFu; }
#define XB_SPIN(cond, bar) do { unsigned _sp = 0; while (cond) { __builtin_amdgcn_s_sleep(1); \
    if ((++_sp & 255u) == 0u) { if (xb_ld(&(bar)[XB_TMO])) break; if (_sp > XB_SPIN_CAP) { atomicAdd(&(bar)[XB_TMO], 1u); break; } } } } while (0)
struct XcdBarrier { unsigned* bar; unsigned x; volatile LAS unsigned* st; };
__device__ __forceinline__ XcdBarrier xcd_barrier_post(unsigned* bar, volatile LAS unsigned* st) {
    XcdBarrier b; b.bar = bar; b.x = xb_xcc_id(); b.st = st;
    if (threadIdx.x == 0) (void)xb_add(&bar[XB_XCNT(b.x)], 1u);
    return b;
}
__device__ __forceinline__ void xcd_barrier_complete(unsigned* bar, unsigned x, unsigned& nloc, unsigned& nx) {
    const unsigned G = gridDim.x * gridDim.y * gridDim.z;
    unsigned sum, cnt, mine, sp = 0u;
    for (;;) {
        sum = 0u; cnt = 0u; mine = 0u;
#pragma unroll
        for (unsigned j = 0; j < 16; ++j) { const unsigned c = xb_ld(&bar[XB_XCNT(j)]); sum += c; cnt += (c > 0u) ? 1u : 0u; mine = (j == x) ? c : mine; }
        if (sum == G) break;
        __builtin_amdgcn_s_sleep(1);
        if ((++sp & 255u) == 0u) { if (xb_ld(&bar[XB_TMO])) break; if (sp > XB_SPIN_CAP) { atomicAdd(&bar[XB_TMO], 1u); break; } }
    }
    nloc = mine > 0u ? mine : 1u; nx = cnt > 0u ? cnt : 1u;
}
__device__ __forceinline__ void xcd_barrier(const XcdBarrier& b) {
    asm volatile("s_waitcnt vmcnt(0)" ::: "memory");
    __syncthreads();
    if (threadIdx.x == 0) {
        unsigned* bar = b.bar;
        __builtin_amdgcn_s_waitcnt(0);
        unsigned nloc = b.st[0], nx = b.st[1];
        if (nloc == 0u) { xcd_barrier_complete(bar, b.x, nloc, nx); b.st[0] = nloc; b.st[1] = nx; }
        const unsigned old = xb_add(&bar[XB_XSUB(b.x)], 1u);
        const unsigned gen = old / nloc;
        if (old + 1u == (gen + 1u) * nloc) {
            __builtin_amdgcn_fence(__ATOMIC_RELEASE, "agent");
            asm volatile("s_waitcnt vmcnt(0)" ::: "memory");
            const unsigned og = xb_add(&bar[XB_TOP], 1u);
            const unsigned tg = og / nx;
            if (og + 1u == (tg + 1u) * nx) xb_add(&bar[XB_TOPGEN], 1u);
            else XB_SPIN(xb_ld(&bar[XB_TOPGEN]) == tg, bar);
            __builtin_amdgcn_fence(__ATOMIC_ACQUIRE, "agent");
            xb_add(&bar[XB_XGEN(b.x)], 1u);
            asm volatile("s_waitcnt vmcnt(0)" ::: "memory");
        } else {
            XB_SPIN(xb_ld(&bar[XB_XGEN(b.x)]) == gen, bar);
            __builtin_amdgcn_fence(__ATOMIC_ACQUIRE, "agent");
            asm volatile("s_waitcnt vmcnt(0)" ::: "memory");
        }
    }
    __syncthreads();
}

namespace pg {
constexpr int BM = 256, BK = 64, HALF = 128, HTB = HALF * BK * 2, STAGE_BYTES = 8 * HTB, RB_GK_OFF = 131072;
__host__ __device__ __forceinline__ int lds_byte(int r, int c) { const int st = (r >> 4) * 2 + (c >> 5), rr = r & 15, cc = c & 31, ob = rr * 64 + cc * 2; return st * 1024 + (ob ^ (((ob >> 9) & 1) << 5)); }
__host__ __device__ __forceinline__ void stage_rc(int b, int& R, int& C) { const int st = b / 1024, sb = b % 1024, swz = sb ^ (((sb >> 9) & 1) << 5); R = (st >> 1) * 16 + swz / 64; C = (st & 1) * 32 + (swz % 64) / 2; }
__host__ __device__ __forceinline__ int perm32(int rho) { const int n = rho >> 4, i = rho & 15; return 8 * (i >> 2) + 4 * n + (i & 3); }

template <int K, class Epi, class Sched>
__device__ __forceinline__ void gemm_phase(LAS unsigned char* lds, const char* Abase, const Sched& S, const Epi& E) {
    typedef typename Sched::Unit Unit;
    const int tid = opaque_tid(), wid = __builtin_amdgcn_readfirstlane(tid >> 6), lane = tid & 63, wr = wid >> 2, wc = wid & 3, fr = lane & 15, fq = lane >> 4;
    constexpr int nt = K / BK;
    unsigned voffB[2]; int Rr[2], Cb;
#pragma unroll
    for (int i = 0; i < 2; ++i) { int R, C; stage_rc(tid * 16 + i * 8192, R, C); const int Rb = Epi::PERM ? ((R & ~31) + perm32(R & 31)) : R;
        Rr[i] = R; Cb = C * 2; voffB[i] = (unsigned)(Rb * K + C) * 2u; }
    constexpr size_t kstep = (size_t)(BK * 2);
    constexpr size_t hstep = (size_t)HALF * K * 2;
    const unsigned ldsw = (unsigned)wid * 1024u;
    const int aoff = lds_byte(wr * 64 + fr, fq * 8), boff = lds_byte(wc * 32 + fr, fq * 8);
#define PG_SA(b, h) (((b) * 2 + (h)) * HTB)
#define PG_SB(b, h) ((4 + (b) * 2 + (h)) * HTB)
#define PG_STAGE(bufoff, gbase, voff) do { _Pragma("unroll") for (int _i = 0; _i < 2; ++_i) \
        __builtin_amdgcn_global_load_lds((const unsigned*)((const char*)(gbase) + (voff)[_i]), (LAS unsigned*)(lds + (bufoff) + ldsw + _i * 8192), 16, 0, 0); } while (0)
#define PG_LDA(dst, b, h) do { _Pragma("unroll") for (int m = 0; m < 4; ++m) _Pragma("unroll") for (int k = 0; k < 2; ++k) dst[m][k] = *(const LAS bf16x8*)(lds + PG_SA(b, h) + aoff + m * 2048 + k * 1024); } while (0)
#define PG_LDB(dst, b, h) do { _Pragma("unroll") for (int n = 0; n < 2; ++n) _Pragma("unroll") for (int k = 0; k < 2; ++k) dst[n][k] = *(const LAS bf16x8*)(lds + PG_SB(b, h) + boff + n * 2048 + k * 1024); } while (0)
#define PG_MMA(ai, bj, At, Bt) do { __builtin_amdgcn_s_setprio(1); _Pragma("unroll") for (int m = 0; m < 4; ++m) _Pragma("unroll") for (int n = 0; n < 2; ++n) _Pragma("unroll") for (int k = 0; k < 2; ++k) \
        acc[ai][bj][m][n] = __builtin_amdgcn_mfma_f32_16x16x32_bf16(Bt[n][k], At[m][k], acc[ai][bj][m][n], 0, 0, 0); __builtin_amdgcn_s_setprio(0); } while (0)
#define PG_WAIT_V(n) asm volatile("s_waitcnt vmcnt(" #n ")" ::: "memory")
#define PG_WAIT_L(n) asm volatile("s_waitcnt lgkmcnt(" #n ")" ::: "memory")
#define PG_BAR __builtin_amdgcn_s_barrier()
#define PG_SCHED __builtin_amdgcn_sched_barrier(0)
    Unit cur, nxt; int ui = 0;
    if (!S.next(0, cur)) return;
    f32x4 acc[2][2][4][2];
#pragma unroll
    for (int a = 0; a < 2; ++a)
#pragma unroll
        for (int b = 0; b < 2; ++b)
#pragma unroll
            for (int m = 0; m < 4; ++m)
#pragma unroll
                for (int n = 0; n < 2; ++n) acc[a][b][m][n] = (f32x4){0.f, 0.f, 0.f, 0.f};
    bf16x8 At[4][2], B0[2][2], B1[2][2];
    unsigned cOff[2][2], nOff[2][2];
    S.aoff(cur, Rr[0], Rr[1], Cb, cOff);
    const char* cB = S.bptr(cur);
    PG_STAGE(PG_SB(0, 0), cB, voffB); PG_STAGE(PG_SB(0, 1), cB + hstep, voffB); PG_STAGE(PG_SA(0, 0), Abase, cOff[0]); PG_STAGE(PG_SA(0, 1), Abase, cOff[1]);
    if (wr == 1) PG_BAR;
    PG_WAIT_V(2); PG_BAR;
    PG_STAGE(PG_SB(1, 0), cB + kstep, voffB); PG_STAGE(PG_SA(1, 0), Abase + kstep, cOff[0]); PG_STAGE(PG_SB(1, 1), cB + hstep + kstep, voffB);
    PG_WAIT_V(6); PG_BAR;
    for (;;) {
        const bool has_next = S.next(ui + 1, nxt);
        const char* nB = cB;
        if (has_next) { S.aoff(nxt, Rr[0], Rr[1], Cb, nOff); nB = S.bptr(nxt); }
        else { nOff[0][0] = cOff[0][0]; nOff[0][1] = cOff[0][1]; nOff[1][0] = cOff[1][0]; nOff[1][1] = cOff[1][1]; }
        for (int t = 0; t < nt; t += 2) {
            const bool last = (t == nt - 2);
            const char* a1 = Abase + (size_t)(t + 1) * kstep;
            const char* a2 = last ? Abase : Abase + (size_t)(t + 2) * kstep; const char* b2 = last ? nB : cB + (size_t)(t + 2) * kstep;
            const char* a3 = a2 + kstep; const char* b3 = b2 + kstep;
            unsigned o2[2][2];
            o2[0][0] = last ? nOff[0][0] : cOff[0][0]; o2[0][1] = last ? nOff[0][1] : cOff[0][1]; o2[1][0] = last ? nOff[1][0] : cOff[1][0]; o2[1][1] = last ? nOff[1][1] : cOff[1][1];
            PG_LDB(B0, 0, 0); PG_LDB(B1, 0, 1); PG_SCHED; PG_LDA(At, 0, 0); PG_STAGE(PG_SA(1, 1), a1, cOff[1]);
            PG_WAIT_V(8); PG_WAIT_L(0); PG_BAR; PG_MMA(0, 0, At, B0); PG_MMA(0, 1, At, B1); PG_BAR; PG_SCHED;
            PG_LDA(At, 0, 1); PG_STAGE(PG_SB(0, 0), b2, voffB); PG_STAGE(PG_SB(0, 1), b2 + hstep, voffB); PG_STAGE(PG_SA(0, 0), a2, o2[0]);
            PG_WAIT_V(8); PG_WAIT_L(0); PG_BAR; PG_MMA(1, 0, At, B0); PG_MMA(1, 1, At, B1); PG_BAR; PG_SCHED;
            PG_LDB(B0, 1, 0); PG_LDB(B1, 1, 1); PG_SCHED; PG_LDA(At, 1, 0); PG_STAGE(PG_SA(0, 1), a2, o2[1]);
            PG_WAIT_V(8); PG_WAIT_L(0); PG_BAR; PG_MMA(0, 0, At, B0); PG_MMA(0, 1, At, B1); PG_BAR; PG_SCHED;
            PG_LDA(At, 1, 1); PG_STAGE(PG_SB(1, 0), b3, voffB); PG_STAGE(PG_SB(1, 1), b3 + hstep, voffB); PG_STAGE(PG_SA(1, 0), a3, o2[0]);
            PG_WAIT_V(8); PG_WAIT_L(0); PG_BAR; PG_MMA(1, 0, At, B0); PG_MMA(1, 1, At, B1); PG_BAR; PG_SCHED;
        }
        if (wr == 0) PG_BAR;
        E(acc, cur, wr, wc, fr, fq);
        if (!has_next) break;
#pragma unroll
        for (int a = 0; a < 2; ++a)
#pragma unroll
            for (int b = 0; b < 2; ++b)
#pragma unroll
                for (int m = 0; m < 4; ++m)
#pragma unroll
                    for (int n = 0; n < 2; ++n) acc[a][b][m][n] = (f32x4){0.f, 0.f, 0.f, 0.f};
        cur = nxt; cB = nB; ++ui;
        cOff[0][0] = nOff[0][0]; cOff[0][1] = nOff[0][1]; cOff[1][0] = nOff[1][0]; cOff[1][1] = nOff[1][1];
        if (wr == 1) PG_BAR;
    }
    PG_WAIT_V(0);
    PG_BAR;
#undef PG_SA
#undef PG_SB
#undef PG_STAGE
#undef PG_LDA
#undef PG_LDB
#undef PG_MMA
#undef PG_WAIT_V
#undef PG_WAIT_L
#undef PG_BAR
#undef PG_SCHED
}

struct DUnit { int pm, pn; };
template <int K> struct DenseSched {
    typedef DUnit Unit;
    const char* Bt; int nM, nN, nwg, G, c;
    __device__ __forceinline__ void init(const void* Bt_, int M, int N, int G_, int c_) { Bt = (const char*)Bt_; nM = M / BM; nN = N / BM; nwg = nM * nN; G = G_; c = c_; }
    __device__ __forceinline__ bool next(int i, Unit& u) const {
        const long L = (long)i * G + c; if (L >= nwg) return false;
        int wgid = (int)L; { const int q = nwg / 8, r = nwg % 8, xcd = wgid % 8, off = wgid / 8; wgid = (xcd < r ? xcd * (q + 1) : r * (q + 1) + (xcd - r) * q) + off; }
        const int nig = 8 * nN, gid = wgid / nig, fm = gid * 8, gsz = (nM - fm) < 8 ? (nM - fm) : 8;
        u.pm = fm + ((wgid % nig) % gsz); u.pn = (wgid % nig) / gsz; return true;
    }
    __device__ __forceinline__ const char* bptr(const Unit& u) const { return Bt + (size_t)u.pn * BM * K * 2; }
    __device__ __forceinline__ void aoff(const Unit& u, int R0, int R1, int Cb, unsigned (&o)[2][2]) const {
#pragma unroll
        for (int h = 0; h < 2; ++h) { o[h][0] = (unsigned)((u.pm * BM + h * HALF + R0) * K) * 2u + Cb; o[h][1] = (unsigned)((u.pm * BM + h * HALF + R1) * K) * 2u + Cb; }
    }
};
struct MUnit { int E, mt, pn, cnt, rowbase; };
template <int K, int NT, bool GATHER> struct MoeSched {
    typedef MUnit Unit;
    const char* W; const LAS int* tab; const int* list; int G, c;
    __device__ __forceinline__ bool next(int i, Unit& u) const {
        const int L = i * G + c; const int total = tab[32] * NT; if (L >= total) return false;
        const int mg = L / NT; u.pn = L % NT;
        int E = 0;
#pragma unroll 1
        for (int e = 1; e < 32; ++e) E = (tab[e] <= mg) ? e : E;
        E = __builtin_amdgcn_readfirstlane(E);
        u.E = E; u.mt = mg - tab[E]; u.cnt = tab[33 + E]; u.rowbase = tab[65 + E]; return true;
    }
    __device__ __forceinline__ const char* bptr(const Unit& u) const { return W + ((size_t)u.E * NT + u.pn) * BM * K * 2; }
    __device__ __forceinline__ void aoff(const Unit& u, int R0, int R1, int Cb, unsigned (&o)[2][2]) const {
#pragma unroll
        for (int h = 0; h < 2; ++h)
#pragma unroll
            for (int i = 0; i < 2; ++i) { const int slot = u.mt * BM + h * HALF + (i ? R1 : R0);
                if (GATHER) { const int tok = slot < u.cnt ? (list[u.E * CAPE + slot] >> 1) : 0; o[h][i] = (unsigned)(tok * K) * 2u + Cb; }
                else o[h][i] = (unsigned)((u.rowbase + slot) * K) * 2u + Cb; }
    }
};

struct EpiBf16 {
    static constexpr bool PERM = true;
    bf16_t* O; int ldc; const float* rs;
    __device__ __forceinline__ void operator()(const f32x4 (&acc)[2][2][4][2], const DUnit& u, int wr, int wc, int fr, int fq) const {
        const int row0 = u.pm * BM + wr * 64 + fr, col0 = u.pn * BM + wc * 32 + 8 * fq;
#pragma unroll
        for (int ai = 0; ai < 2; ++ai)
#pragma unroll
            for (int m = 0; m < 4; ++m) { bf16_t* rowp = O + (size_t)(row0 + ai * HALF + m * 16) * ldc + col0; const float r = rs[row0 + ai * HALF + m * 16];
#pragma unroll
                for (int bj = 0; bj < 2; ++bj) { const f32x4 v0 = acc[ai][bj][m][0] * r, v1 = acc[ai][bj][m][1] * r;
                    u32x4 w; w.x = cvt_pk_bf16(v0[0], v0[1]); w.y = cvt_pk_bf16(v0[2], v0[3]); w.z = cvt_pk_bf16(v1[0], v1[1]); w.w = cvt_pk_bf16(v1[2], v1[3]);
                    *(u32x4*)(rowp + bj * HALF) = w; } }
    }
};
struct EpiRes {
    static constexpr bool PERM = true;
    const bf16_t* res; bf16_t* C; int ldc;
    __device__ __forceinline__ void operator()(const f32x4 (&acc)[2][2][4][2], const DUnit& u, int wr, int wc, int fr, int fq) const {
        const int row0 = u.pm * BM + wr * 64 + fr, col0 = u.pn * BM + wc * 32 + 8 * fq;
#pragma unroll
        for (int ai = 0; ai < 2; ++ai)
#pragma unroll
            for (int m = 0; m < 4; ++m) { const size_t off = (size_t)(row0 + ai * HALF + m * 16) * ldc + col0;
#pragma unroll
                for (int bj = 0; bj < 2; ++bj) { const u32x4 r = *(const u32x4*)(res + off + bj * HALF); const f32x4 v0 = acc[ai][bj][m][0], v1 = acc[ai][bj][m][1];
                    u32x4 w; w.x = cvt_pk_bf16(bflo(r.x) + v0[0], bfhi(r.x) + v0[1]); w.y = cvt_pk_bf16(bflo(r.y) + v0[2], bfhi(r.y) + v0[3]);
                    w.z = cvt_pk_bf16(bflo(r.z) + v1[0], bfhi(r.z) + v1[1]); w.w = cvt_pk_bf16(bflo(r.w) + v1[2], bfhi(r.w) + v1[3]);
                    *(u32x4*)(C + off + bj * HALF) = w; } }
    }
};
struct EpiGateUp {
    static constexpr bool PERM = true;
    bf16_t* H; const float* gw;
    __device__ __forceinline__ void operator()(const f32x4 (&acc)[2][2][4][2], const MUnit& u, int wr, int wc, int fr, int fq) const {
        const int col0 = u.pn * HALF + wc * 32 + 8 * fq;
#pragma unroll
        for (int ai = 0; ai < 2; ++ai)
#pragma unroll
            for (int m = 0; m < 4; ++m) { const int slot = u.mt * BM + ai * HALF + wr * 64 + m * 16 + fr;
                const float w = slot < u.cnt ? gw[u.E * CAPE + slot] : 0.f;
                const f32x4 g0 = acc[ai][0][m][0], g1 = acc[ai][0][m][1], u0 = acc[ai][1][m][0], u1 = acc[ai][1][m][1];
                float h[8];
#pragma unroll
                for (int j = 0; j < 4; ++j) { h[j] = silu(g0[j]) * u0[j] * w; h[4 + j] = silu(g1[j]) * u1[j] * w; }
                u32x4 o; o.x = cvt_pk_bf16(h[0], h[1]); o.y = cvt_pk_bf16(h[2], h[3]); o.z = cvt_pk_bf16(h[4], h[5]); o.w = cvt_pk_bf16(h[6], h[7]);
                *(u32x4*)(H + (size_t)(u.rowbase + slot) * DE + col0) = o; }
    }
};
struct EpiDown {
    static constexpr bool PERM = true;
    bf16_t* Y; const int* list;
    __device__ __forceinline__ void operator()(const f32x4 (&acc)[2][2][4][2], const MUnit& u, int wr, int wc, int fr, int fq) const {
        const int col0 = u.pn * BM + wc * 32 + 8 * fq;
#pragma unroll
        for (int ai = 0; ai < 2; ++ai)
#pragma unroll
            for (int m = 0; m < 4; ++m) { const int slot = u.mt * BM + ai * HALF + wr * 64 + m * 16 + fr;
                if (slot < u.cnt) { const int ent = list[u.E * CAPE + slot]; bf16_t* rowp = Y + (size_t)ent * DM + col0;
#pragma unroll
                    for (int bj = 0; bj < 2; ++bj) { const f32x4 v0 = acc[ai][bj][m][0], v1 = acc[ai][bj][m][1];
                        u32x4 w; w.x = cvt_pk_bf16(v0[0], v0[1]); w.y = cvt_pk_bf16(v0[2], v0[3]); w.z = cvt_pk_bf16(v1[0], v1[1]); w.w = cvt_pk_bf16(v1[2], v1[3]);
                        *(u32x4*)(rowp + bj * HALF) = w; } } }
    }
};

template <int K, int LDB, class Epi, class Sched, bool GK = false  >
__device__ __forceinline__ void gemm_rb(LAS unsigned char* lds, const char* Abase, const Sched& S, const Epi& E) {
    typedef typename Sched::Unit Unit;
    const int tid = opaque_tid(), wid = __builtin_amdgcn_readfirstlane(tid >> 6), lane = tid & 63, wr = wid >> 2, wc = wid & 3, fr = lane & 15, fq = lane >> 4;
    constexpr int nt = K / BK;
    int Rr[2], Cb;
#pragma unroll
    for (int i = 0; i < 2; ++i) { int R, C; stage_rc(tid * 16 + i * 8192, R, C); Rr[i] = R; Cb = C * 2; }
    const unsigned ldsw = (unsigned)wid * 1024u;
    const int aoff = lds_byte(wr * 64 + fr, fq * 8);
    const int k4 = tid >> 5, n4 = tid & 31;
    int bw[4];
#pragma unroll
    for (int q = 0; q < 4; ++q) bw[q] = (4 * n4 + q) * 128 + (((k4 >> 1) ^ (n4 & 7)) * 16) + (k4 & 1) * 8;
    int brd[2][2];
#pragma unroll
    for (int n = 0; n < 2; ++n)
#pragma unroll
        for (int k = 0; k < 2; ++k) { const int r = wc * 32 + n * 16 + fr; brd[n][k] = r * 128 + (((k * 4 + fq) ^ ((r >> 2) & 7)) * 16); }
#define RB_SB(b) (98304 + (b) * HTB)
#define RB_STAGE_A(sa, kt, OFF) do { _Pragma("unroll") for (int _h = 0; _h < 2; ++_h) _Pragma("unroll") for (int _i = 0; _i < 2; ++_i) \
        __builtin_amdgcn_global_load_lds((const unsigned*)(Abase + (size_t)(kt) * (BK * 2) + OFF[_h][_i]), (LAS unsigned*)(lds + (sa) * 32768 + _h * HTB + ldsw + _i * 8192), 16, 0, 0); } while (0)
#define RB_LOAD_B(r0, r1, r2, r3, kt, BP) do { const float* _p = BP + (size_t)(kt) * BK * LDB; \
        asm volatile("global_load_dwordx4 %0, %4, off\n\tglobal_load_dwordx4 %1, %5, off\n\tglobal_load_dwordx4 %2, %6, off\n\tglobal_load_dwordx4 %3, %7, off" \
            : "=&v"(r0), "=&v"(r1), "=&v"(r2), "=&v"(r3) : "v"(_p), "v"(_p + LDB), "v"(_p + 2 * LDB), "v"(_p + 3 * LDB) : "memory"); } while (0)
#define RB_WAIT8(r0, r1, r2, r3) asm volatile("s_waitcnt vmcnt(8)" : "+v"(r0), "+v"(r1), "+v"(r2), "+v"(r3) :: "memory")
#define RB_WRITE_B(b, r0, r1, r2, r3, kw) do { f32x4 _g = {1.f, 1.f, 1.f, 1.f}; if (GK) _g = *(const LAS f32x4*)(lds + RB_GK_OFF + ((kw) * BK + 4 * k4) * 4); \
        _Pragma("unroll") for (int _q = 0; _q < 4; ++_q) { u32x2 _w; _w.x = GK ? cvt_pk_bf16(r0[_q] * _g.x, r1[_q] * _g.y) : cvt_pk_bf16(r0[_q], r1[_q]); _w.y = GK ? cvt_pk_bf16(r2[_q] * _g.z, r3[_q] * _g.w) : cvt_pk_bf16(r2[_q], r3[_q]); \
        *(LAS u32x2*)(lds + RB_SB(b) + bw[_q]) = _w; } } while (0)
#define RB_COMPUTE(sa, b) do { bf16x8 Bf[2][2]; _Pragma("unroll") for (int n = 0; n < 2; ++n) _Pragma("unroll") for (int k = 0; k < 2; ++k) Bf[n][k] = *(const LAS bf16x8*)(lds + RB_SB(b) + brd[n][k]); \
        _Pragma("unroll") for (int ai = 0; ai < 2; ++ai) { bf16x8 At[4][2]; _Pragma("unroll") for (int m = 0; m < 4; ++m) _Pragma("unroll") for (int k = 0; k < 2; ++k) At[m][k] = *(const LAS bf16x8*)(lds + (sa) * 32768 + ai * HTB + aoff + m * 2048 + k * 1024); \
            __builtin_amdgcn_s_setprio(1); _Pragma("unroll") for (int m = 0; m < 4; ++m) _Pragma("unroll") for (int n = 0; n < 2; ++n) _Pragma("unroll") for (int k = 0; k < 2; ++k) acc[ai][m][n] = __builtin_amdgcn_mfma_f32_16x16x32_bf16(Bf[n][k], At[m][k], acc[ai][m][n], 0, 0, 0); __builtin_amdgcn_s_setprio(0); } } while (0)
#define RB_SYNC() do { asm volatile("s_waitcnt lgkmcnt(0)" ::: "memory"); __builtin_amdgcn_s_barrier(); asm volatile("" ::: "memory"); sa = sa == 2 ? 0 : sa + 1; } while (0)
#define RB_STEP(b, kt2, kw, OFF, BP, c0, c1, c2, c3, n0, n1, n2, n3) do { const int _s2 = sa >= 1 ? sa - 1 : 2; RB_STAGE_A(_s2, kt2, OFF); RB_LOAD_B(c0, c1, c2, c3, kt2, BP); \
        RB_COMPUTE(sa, b); RB_WAIT8(n0, n1, n2, n3); RB_WRITE_B((b) ^ 1, n0, n1, n2, n3, kw); RB_SYNC(); } while (0)
    Unit u, un;
    if (!S.next(0, u)) return;
    unsigned cOff[2][2], nOff[2][2]; S.aoff(u, Rr[0], Rr[1], Cb, cOff);
    const float* bp = S.bsrc(u, 4 * n4) + (size_t)(4 * k4) * LDB; const float* nbp = bp;
    f32x4 e0, e1, e2, e3, o0, o1, o2, o3;
    asm volatile("s_waitcnt vmcnt(0)" ::: "memory");
    RB_STAGE_A(0, 0, cOff); RB_LOAD_B(e0, e1, e2, e3, 0, bp);
    RB_STAGE_A(1, 1, cOff); RB_LOAD_B(o0, o1, o2, o3, 1, bp);
    RB_WAIT8(e0, e1, e2, e3); RB_WRITE_B(0, e0, e1, e2, e3, 0);
    asm volatile("s_waitcnt lgkmcnt(0)" ::: "memory"); __builtin_amdgcn_s_barrier(); asm volatile("" ::: "memory");
    int sa = 0;
    for (int ui = 0;; ++ui) {
        const bool has_next = S.next(ui + 1, un);
        if (has_next) { S.aoff(un, Rr[0], Rr[1], Cb, nOff); nbp = S.bsrc(un, 4 * n4) + (size_t)(4 * k4) * LDB; }
        else { nOff[0][0] = cOff[0][0]; nOff[0][1] = cOff[0][1]; nOff[1][0] = cOff[1][0]; nOff[1][1] = cOff[1][1]; nbp = bp; }
        f32x4 acc[2][4][2];
#pragma unroll
        for (int a = 0; a < 2; ++a)
#pragma unroll
            for (int m = 0; m < 4; ++m)
#pragma unroll
                for (int n = 0; n < 2; ++n) acc[a][m][n] = (f32x4){0.f, 0.f, 0.f, 0.f};
        unsigned pv[2][4], pr[2][4]; E.pre(u, wr, fr, pv, pr);
#pragma unroll 1
        for (int t = 0; t < nt - 2; t += 2) { RB_STEP(0, t + 2, t + 1, cOff, bp, e0, e1, e2, e3, o0, o1, o2, o3); RB_STEP(1, t + 3, t + 2, cOff, bp, o0, o1, o2, o3, e0, e1, e2, e3); }
        RB_STEP(0, 0, nt - 1, nOff, nbp, e0, e1, e2, e3, o0, o1, o2, o3); RB_STEP(1, 1, 0, nOff, nbp, o0, o1, o2, o3, e0, e1, e2, e3);
        E(acc, u, wr, wc, fr, fq, pv, pr);
        if (!has_next) break;
        u = un; bp = nbp; cOff[0][0] = nOff[0][0]; cOff[0][1] = nOff[0][1]; cOff[1][0] = nOff[1][0]; cOff[1][1] = nOff[1][1];
    }
    asm volatile("s_waitcnt vmcnt(0)" ::: "memory"); __builtin_amdgcn_s_barrier();
#undef RB_SB
#undef RB_STAGE_A
#undef RB_LOAD_B
#undef RB_WAIT8
#undef RB_WRITE_B
#undef RB_COMPUTE
#undef RB_STEP
#undef RB_SYNC
}
template <int K, int NT, bool GATHER> struct MoeSchedRB {
    typedef MUnit Unit;
    const float* W0; const float* W1; const LAS int* tab; const int* list; int G, c;
    __device__ __forceinline__ bool next(int i, Unit& u) const {
        const int L = i * G + c; const int total = tab[32] * NT; if (L >= total) return false;
        const int mg = L / NT;
        int E = 0;
#pragma unroll 1
        for (int e = 1; e < 32; ++e) E = (tab[e] <= mg) ? e : E;
        E = __builtin_amdgcn_readfirstlane(E);
#ifndef ORDER_MT_FAST
#define ORDER_MT_FAST 1
#endif
        if (ORDER_MT_FAST) { const int nte = tab[E + 1] - tab[E], loc = L - tab[E] * NT; u.pn = loc / nte; u.mt = loc - u.pn * nte; }
        else { u.pn = L % NT; u.mt = mg - tab[E]; }
        u.E = E; u.cnt = tab[33 + E]; u.rowbase = tab[65 + E]; return true;
    }
    __device__ __forceinline__ const float* bsrc(const Unit& u, int c4) const {
        if (GATHER) { const long dW = ((c4 >> 4) & 1) ? (long)(W1 - W0) : 0l; return W0 + dW + (size_t)u.E * DM * DE + 64 * u.pn + 16 * (c4 >> 5) + (c4 & 15); }
        else return W0 + (size_t)u.E * DE * DM + 128 * u.pn + c4;
    }
    __device__ __forceinline__ void aoff(const Unit& u, int R0, int R1, int Cb, unsigned (&o)[2][2]) const {
#pragma unroll
        for (int h = 0; h < 2; ++h)
#pragma unroll
            for (int i = 0; i < 2; ++i) { const int slot = u.mt * BM + h * HALF + (i ? R1 : R0);
                if (GATHER) { const int ent = list[u.E * CAPE + slot]; const int tok = slot < u.cnt ? (ent >> 1) : 0; o[h][i] = (unsigned)(tok * K) * 2u + Cb; }
                else o[h][i] = (unsigned)((u.rowbase + slot) * K) * 2u + Cb; }
    }
};
struct EpiGateUpRB {
    bf16_t* H; const float* gw; const float* rsb;
    __device__ __forceinline__ void pre(const MUnit& u, int wr, int fr, unsigned (&pv)[2][4], unsigned (&pr)[2][4]) const {
#pragma unroll
        for (int ai = 0; ai < 2; ++ai)
#pragma unroll
            for (int m = 0; m < 4; ++m) { const int sl = u.E * CAPE + u.mt * BM + ai * HALF + wr * 64 + m * 16 + fr; pv[ai][m] = __float_as_uint(gw[sl]); pr[ai][m] = __float_as_uint(rsb[sl]); }
    }
    __device__ __forceinline__ void operator()(const f32x4 (&acc)[2][4][2], const MUnit& u, int wr, int wc, int fr, int fq, const unsigned (&pv)[2][4], const unsigned (&pr)[2][4]) const {
        const int col0 = u.pn * 64 + wc * 16 + 4 * fq;
#pragma unroll
        for (int ai = 0; ai < 2; ++ai)
#pragma unroll
            for (int m = 0; m < 4; ++m) { const int slot = u.mt * BM + ai * HALF + wr * 64 + m * 16 + fr;
                const bool ok = slot < u.cnt; const float rs = ok ? __uint_as_float(pr[ai][m]) : 0.f, w = ok ? __uint_as_float(pv[ai][m]) * rs : 0.f;
                const f32x4 g = acc[ai][m][0] * rs, up = acc[ai][m][1];
                u32x2 o; o.x = cvt_pk_bf16(silu(g[0]) * up[0] * w, silu(g[1]) * up[1] * w); o.y = cvt_pk_bf16(silu(g[2]) * up[2] * w, silu(g[3]) * up[3] * w);
                *(u32x2*)(H + (size_t)(u.rowbase + slot) * DE + col0) = o; }
    }
};
struct EpiDownRB {
    bf16_t* Y; const int* list;
    __device__ __forceinline__ void pre(const MUnit& u, int wr, int fr, unsigned (&pv)[2][4], unsigned (&)[2][4]) const {
#pragma unroll
        for (int ai = 0; ai < 2; ++ai)
#pragma unroll
            for (int m = 0; m < 4; ++m) pv[ai][m] = (unsigned)list[u.E * CAPE + u.mt * BM + ai * HALF + wr * 64 + m * 16 + fr];
    }
    __device__ __forceinline__ void operator()(const f32x4 (&acc)[2][4][2], const MUnit& u, int wr, int wc, int fr, int fq, const unsigned (&pv)[2][4], const unsigned (&)[2][4]) const {
        const int col0 = u.pn * HALF + wc * 32 + 4 * fq;
#pragma unroll
        for (int ai = 0; ai < 2; ++ai)
#pragma unroll
            for (int m = 0; m < 4; ++m) { const int slot = u.mt * BM + ai * HALF + wr * 64 + m * 16 + fr;
                if (slot < u.cnt) { bf16_t* rowp = Y + (size_t)pv[ai][m] * DM + col0;
#pragma unroll
                    for (int n = 0; n < 2; ++n) { const f32x4 v = acc[ai][m][n]; u32x2 o; o.x = cvt_pk_bf16(v[0], v[1]); o.y = cvt_pk_bf16(v[2], v[3]); *(u32x2*)(rowp + n * 16) = o; } } }
    }
};
}

struct Args { const float* in[21]; float* out; unsigned char* ws; int ph_lo, ph_hi; };
#define CAS __attribute__((address_space(4)))
typedef const CAS Args* ArgP;
__device__ __forceinline__ ArgP kargs() { ArgP p = (ArgP)__builtin_amdgcn_kernarg_segment_ptr(); asm volatile("" : "+s"(p)); return p; }

enum { I_X = 0, I_N1G, I_WIN, I_CONVW, I_CONVB, I_CLNG, I_CLNB, I_GW2, I_GB2, I_GNG, I_FFB, I_WOUT, I_N2G, I_RGW, I_RGB, I_REW, I_REB, I_WG, I_WU, I_WD, I_FNG };

template <int MAP  >
__device__ __forceinline__ void cvt_item(const float* W, int K, int N, int nblk, bf16_t* WT, LAS float* scr, int item, int lane, const float* gk = nullptr  ) {
    const int kb = item / nblk, nb = item % nblk, k0 = 64 * kb, n0 = 32 * nb;
    const int n4 = lane & 7, kr = lane >> 3;
    const bool nok = (n0 + 4 * n4) < N;
    f32x4 v[8];
#pragma unroll
    for (int i = 0; i < 8; ++i) { v[i] = nok ? *(const f32x4*)(W + (size_t)(k0 + 8 * i + kr) * N + n0 + 4 * n4) : (f32x4){0.f, 0.f, 0.f, 0.f}; if (gk) v[i] = v[i] * gk[k0 + 8 * i + kr]; }
#pragma unroll
    for (int i = 0; i < 8; ++i) { LAS float* d = scr + (8 * i + kr) * 33 + 4 * n4; d[0] = v[i].x; d[1] = v[i].y; d[2] = v[i].z; d[3] = v[i].w; }
    LDS_WAIT(); asm volatile("" ::: "memory");
    const int c = lane & 7;
#pragma unroll
    for (int j = 0; j < 4; ++j) { const int n = (lane >> 3) + 8 * j; const LAS float* s = scr + (8 * c) * 33 + n;
        u32x4 o; o.x = cvt_pk_bf16(s[0 * 33], s[1 * 33]); o.y = cvt_pk_bf16(s[2 * 33], s[3 * 33]); o.z = cvt_pk_bf16(s[4 * 33], s[5 * 33]); o.w = cvt_pk_bf16(s[6 * 33], s[7 * 33]);
        const int nn = n0 + n; const int row = MAP == 0 ? nn : ((nn >> 7) * 256 + (nn & 127) + (MAP == 2 ? 128 : 0));
        *(u32x4*)(WT + (size_t)row * K + k0 + 8 * c) = o; }
    LDS_WAIT(); asm volatile("" ::: "memory");
}
constexpr int CV_I_IN = 32 * 184, CV_I_OUT = 32 * 64, CV_N_IN = 2 * CV_I_IN;
__device__ __forceinline__ void cvt_range(ArgP a, LAS unsigned char* lds, int first, int count, int rank, int nranks) {
    const int tid = opaque_tid(), lane = tid & 63, wave = tid >> 6;
    LAS float* scr = (LAS float*)(lds + wave * 16384);
    for (int it = first + rank * NWAVES + wave; it < first + count; it += nranks * NWAVES) {
        int r = it;
        if (r < CV_N_IN) { const int l = r / CV_I_IN; cvt_item<0>(a->in[I_WIN] + (size_t)l * DM * DIN, DM, DIN, 184, (bf16_t*)(a->ws + WS_WIN) + (size_t)l * DINP * DM, scr, r % CV_I_IN, lane, a->in[I_N1G] + l * DM); continue; } r -= CV_N_IN;
        { const int l = r / CV_I_OUT; cvt_item<0>(a->in[I_WOUT] + (size_t)l * DM * DM, DM, DM, 64, (bf16_t*)(a->ws + WS_WOUT) + (size_t)l * DM * DM, scr, r % CV_I_OUT, lane); }
    }
}
__device__ __forceinline__ void idle_rank(int nunits, int G, int c, int& rank, int& nranks) {
    const int maxu = (nunits + G - 1) / G, nidle = maxu * G - nunits, first = nunits - (maxu - 1) * G;
    if (nidle >= 16) { nranks = nidle; rank = c >= first ? c - first : -1; } else { nranks = G; rank = c; }
}
__device__ __forceinline__ void p0_prologue(ArgP a, LAS unsigned char* lds) {
    const int tid = opaque_tid(), lane = tid & 63, wave = tid >> 6;
    LAS float* scr = (LAS float*)(lds + wave * 16384);
    const int gw = blockIdx.x * NWAVES + wave, NGW = gridDim.x * NWAVES;
    constexpr int I_IN = CV_I_IN;
    cvt_range(a, lds, 0, I_IN, blockIdx.x, gridDim.x);
    for (int idx = blockIdx.x * NTHR + tid; idx < DEPTH * 48 * DM; idx += gridDim.x * NTHR) {
        const int k = idx % DM, c = (idx / DM) % 48, l = idx / (DM * 48);
        float w = 0.f;
        if (c < 4) w = a->in[I_RGW][((size_t)l * DM + k) * 4 + c];
        else if (c < 36) w = a->in[I_REW][(((size_t)l * 4 + ((c - 4) >> 3)) * DM + k) * 8 + ((c - 4) & 7)];
        w *= a->in[I_N2G][l * DM + k];
        const bf16_t hi = f2bf(w), lo = f2bf(w - bf2f(hi));
        bf16_t* wr = (bf16_t*)(a->ws + WS_WR);
        wr[((size_t)(l * 2 + 0) * 48 + c) * DM + k] = hi; wr[((size_t)(l * 2 + 1) * 48 + c) * DM + k] = lo;
    }
    f32x4 nx[8];
    if (gw < T) {
#pragma unroll
        for (int j = 0; j < 8; ++j) nx[j] = ((const f32x4*)(a->in[I_X] + (size_t)gw * DM) + lane)[64 * j]; }
    for (int m = gw; m < T; m += NGW) {
        f32x4 v[8]; float s = 0.f;
#pragma unroll
        for (int j = 0; j < 8; ++j) { v[j] = nx[j]; s += (v[j].x * v[j].x + v[j].y * v[j].y) + (v[j].z * v[j].z + v[j].w * v[j].w); }
        if (m + NGW < T) {
#pragma unroll
            for (int j = 0; j < 8; ++j) nx[j] = ((const f32x4*)(a->in[I_X] + (size_t)(m + NGW) * DM) + lane)[64 * j]; }
        const float rstd = rsqrtf(wave_sum(s) * (1.f / DM) + EPS);
        if (lane == 0) ((float*)(a->ws + WS_RS))[m] = rstd;
        u32x2* xb = (u32x2*)((bf16_t*)(a->ws + WS_XB) + (size_t)m * DM) + lane;
#pragma unroll
        for (int j = 0; j < 8; ++j) { u32x2 xw; xw.x = cvt_pk_bf16(v[j].x, v[j].y); xw.y = cvt_pk_bf16(v[j].z, v[j].w); xb[64 * j] = xw; }
    }
}

__device__ __forceinline__ void conv_phase(ArgP a, LAS unsigned char* lds, int l) {
    const int tid = opaque_tid(), lane = tid & 63, wave = tid >> 6, cp = tid & 255, th = tid >> 8;
    const bf16_t* P = (const bf16_t*)(a->ws + WS_P); bf16_t* mix = (bf16_t*)(a->ws + WS_MIX);
    LAS float* ut = (LAS float*)lds;
    for (int item = blockIdx.x; item < NB * (SEQ / 32); item += gridDim.x) {
        const int b = item / (SEQ / 32), s0 = (item % (SEQ / 32)) * 32;
        __syncthreads();
#pragma unroll
        for (int i = 0; i < 8; ++i) { const int idx = tid + i * 512, r = idx >> 6, c8 = idx & 63, sq = s0 - 30 + r;
            if (r < 62) { f32x4 u0 = {0.f, 0.f, 0.f, 0.f}, u1 = {0.f, 0.f, 0.f, 0.f};
                if (sq >= 0) { const bf16_t* row = P + (size_t)(b * SEQ + sq) * DINP + c8 * 8; const u32x4 av = *(const u32x4*)(row + C_CA), gv = *(const u32x4*)(row + C_CG);
                    u0.x = bflo(av.x) * __builtin_amdgcn_rcpf(1.f + __expf(-bflo(gv.x))); u0.y = bfhi(av.x) * __builtin_amdgcn_rcpf(1.f + __expf(-bfhi(gv.x)));
                    u0.z = bflo(av.y) * __builtin_amdgcn_rcpf(1.f + __expf(-bflo(gv.y))); u0.w = bfhi(av.y) * __builtin_amdgcn_rcpf(1.f + __expf(-bfhi(gv.y)));
                    u1.x = bflo(av.z) * __builtin_amdgcn_rcpf(1.f + __expf(-bflo(gv.z))); u1.y = bfhi(av.z) * __builtin_amdgcn_rcpf(1.f + __expf(-bfhi(gv.z)));
                    u1.z = bflo(av.w) * __builtin_amdgcn_rcpf(1.f + __expf(-bflo(gv.w))); u1.w = bfhi(av.w) * __builtin_amdgcn_rcpf(1.f + __expf(-bfhi(gv.w))); }
                *(LAS f32x4*)(ut + r * 512 + c8 * 8) = u0; *(LAS f32x4*)(ut + r * 512 + c8 * 8 + 4) = u1; } }
        if (tid < 128) { const int t = tid >> 2, hd = tid & 3;
            ((float*)(a->ws + WS_LF))[(b * 4 + hd) * SEQ + s0 + t] = log_sigmoid(bf2f(P[(size_t)(b * SEQ + s0 + t) * DINP + C_FF + hd]) + a->in[I_FFB][l * 4 + hd]) * LOG2E; }
        f32x2 w[31];
#pragma unroll
        for (int j = 0; j < 31; ++j) w[j] = *(const f32x2*)(a->in[I_CONVW] + ((size_t)l * 31 + j) * 512 + 2 * cp);
        const f32x2 cb = *(const f32x2*)(a->in[I_CONVB] + l * 512 + 2 * cp);
        __syncthreads();
        f32x2 y[16];
#pragma unroll
        for (int t = 0; t < 16; ++t) y[t] = cb;
#pragma unroll
        for (int r = 0; r < 46; ++r) { const f32x2 u = *(const LAS f32x2*)(ut + (th * 16 + r) * 512 + 2 * cp);
#pragma unroll
            for (int t = 0; t < 16; ++t) { const int j = r - t; if (j >= 0 && j < 31) y[t] += w[j] * u; } }
        __syncthreads();
#pragma unroll
        for (int t = 0; t < 16; ++t) *(LAS f32x2*)(ut + (th * 16 + t) * 512 + 2 * cp) = y[t];
        __syncthreads();
#pragma unroll
        for (int q = 0; q < 4; ++q) { const int t = wave * 4 + q;
            const f32x4 y0 = *(const LAS f32x4*)(ut + t * 512 + lane * 8), y1 = *(const LAS f32x4*)(ut + t * 512 + lane * 8 + 4);
            const float mu = wave_sum((y0.x + y0.y) + (y0.z + y0.w) + (y1.x + y1.y) + (y1.z + y1.w)) * (1.f / 512.f);
            const f32x4 d0 = y0 - mu, d1 = y1 - mu;
            const float var = wave_sum((d0.x * d0.x + d0.y * d0.y) + (d0.z * d0.z + d0.w * d0.w) + (d1.x * d1.x + d1.y * d1.y) + (d1.z * d1.z + d1.w * d1.w)) * (1.f / 512.f);
            const float rstd = rsqrtf(var + EPS);
            const f32x4 g0 = *(const f32x4*)(a->in[I_CLNG] + l * 512 + lane * 8), g1 = *(const f32x4*)(a->in[I_CLNG] + l * 512 + lane * 8 + 4);
            const f32x4 b0 = *(const f32x4*)(a->in[I_CLNB] + l * 512 + lane * 8), b1 = *(const f32x4*)(a->in[I_CLNB] + l * 512 + lane * 8 + 4);
            float o[8];
#pragma unroll
            for (int j = 0; j < 4; ++j) { o[j] = silu(d0[j] * rstd * g0[j] + b0[j]); o[4 + j] = silu(d1[j] * rstd * g1[j] + b1[j]); }
            u32x4 pk; pk.x = cvt_pk_bf16(o[0], o[1]); pk.y = cvt_pk_bf16(o[2], o[3]); pk.z = cvt_pk_bf16(o[4], o[5]); pk.w = cvt_pk_bf16(o[6], o[7]);
            *(u32x4*)(mix + (size_t)(b * SEQ + s0 + t) * DM + M_CONV + lane * 8) = pk; }
    }
    __syncthreads();
}

constexpr int GL_ALOW = 0, GL_TOT = 5120, GL_END0 = 5120 + 2048;
__device__ __forceinline__ void gla_cum(ArgP a, LAS unsigned char* lds, int l, int h, int t0, float (&cum)[16], float& last) {
    const int tid = opaque_tid(), d = tid & 127, cg = tid >> 7;
    const bf16_t* P = (const bf16_t*)(a->ws + WS_P);
    LAS float* alow = (LAS float*)(lds + GL_ALOW); LAS float* tot = (LAS float*)(lds + GL_TOT);
#pragma unroll
    for (int i = 0; i < 2; ++i) { const int idx = tid + i * 512, c = idx >> 4, r = idx & 15; alow[c * 20 + r] = bf2f(P[(size_t)(t0 + c) * DINP + C_GLOW + r]); }
    float w2[16];
#pragma unroll
    for (int r = 0; r < 16; ++r) w2[r] = a->in[I_GW2][((size_t)l * 16 + r) * 512 + h * 128 + d];
    const float b2 = a->in[I_GB2][l * 512 + h * 128 + d];
    __syncthreads();
    float run = 0.f;
#pragma unroll
    for (int j = 0; j < 16; ++j) { const int c = cg * 16 + j; float z = b2;
#pragma unroll
        for (int q = 0; q < 4; ++q) { const f32x4 av = *(const LAS f32x4*)(alow + c * 20 + q * 4); z += av.x * w2[q * 4] + av.y * w2[q * 4 + 1] + av.z * w2[q * 4 + 2] + av.w * w2[q * 4 + 3]; }
        run += log_sigmoid(z) * (1.f / 16.f); cum[j] = run; }
    tot[cg * 128 + d] = run;
    __syncthreads();
    float pre = 0.f, all = 0.f;
#pragma unroll
    for (int q = 0; q < 4; ++q) { const float tv = tot[q * 128 + d]; pre += (q < cg) ? tv : 0.f; all += tv; }
#pragma unroll
    for (int j = 0; j < 16; ++j) cum[j] += pre;
    last = all;
}
constexpr int GA_KT = GL_END0, GA_V = GA_KT + 128 * 144, GA_OUT = GA_V + 64 * 528, GA_END = GA_OUT + 256 * 256;
static_assert(GA_END <= MISC_OFF, "GLA-A LDS");
__device__ __forceinline__ void gla_a_phase(ArgP a, LAS unsigned char* lds, int l) {
    const int tid = opaque_tid(), lane = tid & 63, wave = tid >> 6, d = tid & 127, cg = tid >> 7, g = lane >> 4, li = lane & 15;
    const bf16_t* P = (const bf16_t*)(a->ws + WS_P);
    for (int item = blockIdx.x; item < 512; item += gridDim.x) {
        const int n = item & 31, h = (item >> 5) & 3, b = item >> 7, t0 = b * SEQ + n * 64;
        float cum[16], last;
        bf16_t kraw[16]; u32x4 vraw[4];
#pragma unroll
        for (int j = 0; j < 16; ++j) kraw[j] = P[(size_t)(t0 + cg * 16 + j) * DINP + C_GK + h * 128 + d];
#pragma unroll
        for (int i = 0; i < 4; ++i) { const int idx = tid + i * 512, c = idx >> 5, e8 = idx & 31; vraw[i] = *(const u32x4*)(P + (size_t)(t0 + c) * DINP + C_GV + h * 256 + e8 * 8); }
        __syncthreads();
        gla_cum(a, lds, l, h, t0, cum, last);
        { float* cg_ = (float*)(a->ws + WS_CUM) + (size_t)(t0 + cg * 16) * 512 + h * 128 + d;
#pragma unroll
          for (int j = 0; j < 16; ++j) cg_[j * 512] = cum[j]; }
        { unsigned pk[8];
#pragma unroll
          for (int j = 0; j < 16; j += 2) { const float k0 = bf2f(kraw[j]), k1 = bf2f(kraw[j + 1]);
              pk[j >> 1] = cvt_pk_bf16(k0 * __expf(last - cum[j]), k1 * __expf(last - cum[j + 1])); }
          LAS u32x4* dst = (LAS u32x4*)(lds + GA_KT + d * 144 + cg * 32);
          dst[0] = (u32x4){pk[0], pk[1], pk[2], pk[3]}; dst[1] = (u32x4){pk[4], pk[5], pk[6], pk[7]}; }
        if (cg == 0) ((float*)(a->ws + WS_DEC))[item * 128 + d] = __expf(last);
#pragma unroll
        for (int i = 0; i < 4; ++i) { const int idx = tid + i * 512, c = idx >> 5, e8 = idx & 31;
            *(LAS u32x4*)(lds + GA_V + c * 528 + e8 * 16) = vraw[i]; }
        __syncthreads();
        f32x4 acc[2][8];
#pragma unroll
        for (int i = 0; i < 2; ++i)
#pragma unroll
            for (int j = 0; j < 8; ++j) acc[i][j] = (f32x4){0.f, 0.f, 0.f, 0.f};
#pragma unroll
        for (int kk = 0; kk < 2; ++kk) {
            bf16x8 af[2], bfr[8];
#pragma unroll
            for (int i = 0; i < 2; ++i) { const LAS unsigned char* p = lds + GA_V + (kk * 32 + 8 * g + (li >> 2)) * 528 + ((wave * 2 + i) * 16 + 4 * (li & 3)) * 2;
                af[i] = cat8(vtr(p), vtr(p + 4 * 528)); }
#pragma unroll
            for (int j = 0; j < 8; ++j) bfr[j] = *(const LAS bf16x8*)(lds + GA_KT + (j * 16 + li) * 144 + (kk * 32 + 8 * g) * 2);
#pragma unroll
            for (int i = 0; i < 2; ++i)
#pragma unroll
                for (int j = 0; j < 8; ++j) acc[i][j] = mfma16(af[i], bfr[j], acc[i][j]);
        }
#pragma unroll
        for (int i = 0; i < 2; ++i)
#pragma unroll
            for (int j = 0; j < 8; ++j)
#pragma unroll
                for (int r = 0; r < 4; ++r) *(LAS bf16_t*)(lds + GA_OUT + (((wave * 2 + i) * 16 + 4 * g + r) * 128 + j * 16 + li) * 2) = f2bf(acc[i][j][r]);
        __syncthreads();
        bf16_t* kv = (bf16_t*)(a->ws + WS_KV) + (size_t)item * 32768;
#pragma unroll
        for (int i = 0; i < 8; ++i) { const int idx = tid + i * 512; *(u32x4*)(kv + idx * 8) = *(const LAS u32x4*)(lds + GA_OUT + idx * 16); }
    }
    __syncthreads();
}
__device__ __forceinline__ void gla_b_phase(ArgP a, LAS unsigned char* lds) {
    bf16_t* kvb = (bf16_t*)(a->ws + WS_KV); const float* dec = (const float*)(a->ws + WS_DEC);
    const int tid0 = opaque_tid();
    LAS float* dl = (LAS float*)lds;
    for (int base = blockIdx.x * NTHR; base < 16 * 8192; base += gridDim.x * NTHR) {
        const int idx = base + tid0, bh = base >> 13, off = (idx & 8191) * 4, d0 = off & 127;
        u32x2 kvv[32];
#pragma unroll
        for (int q = 0; q < 32; ++q) kvv[q] = *(const u32x2*)(kvb + (size_t)(bh * 32 + q) * 32768 + off);
        __syncthreads();
#pragma unroll
        for (int i = 0; i < 2; ++i) *(LAS f32x4*)(dl + (tid0 + i * 512) * 4) = *(const f32x4*)(dec + (size_t)bh * 32 * 128 + (tid0 + i * 512) * 4);
        __syncthreads();
        float st[4] = {0.f, 0.f, 0.f, 0.f};
#pragma unroll
        for (int q = 0; q < 32; ++q) { const f32x4 dc = *(const LAS f32x4*)(dl + q * 128 + d0);
            u32x2 o; o.x = cvt_pk_bf16(st[0], st[1]); o.y = cvt_pk_bf16(st[2], st[3]);
            *(u32x2*)(kvb + (size_t)(bh * 32 + q) * 32768 + off) = o;
            st[0] = dc.x * st[0] + bflo(kvv[q].x); st[1] = dc.y * st[1] + bfhi(kvv[q].x); st[2] = dc.z * st[2] + bflo(kvv[q].y); st[3] = dc.w * st[3] + bfhi(kvv[q].y); }
    }
    __syncthreads();
}
constexpr int GC_QD = GL_END0, GC_KI = GC_QD + 64 * 272, GC_ATT = GC_KI + 64 * 272, GC_V = GC_ATT + 64 * 144, GC_SS = GC_V + 64 * 528, GC_END = GC_SS + 64 * 8 * 4;
constexpr int GC_OST = GL_END0;
static_assert(GC_END <= MISC_OFF && GC_OST + 64 * 260 * 4 <= GC_SS, "GLA-C LDS");
__device__ __forceinline__ void gla_c_phase(ArgP a, LAS unsigned char* lds, int l) {
    const int tid = opaque_tid(), lane = tid & 63, wave = tid >> 6, d = tid & 127, cg = tid >> 7, g = lane >> 4, li = lane & 15;
    const bf16_t* P = (const bf16_t*)(a->ws + WS_P); bf16_t* mix = (bf16_t*)(a->ws + WS_MIX);
    for (int item = blockIdx.x; item < 512; item += gridDim.x) {
        const int n = item & 31, h = (item >> 5) & 3, b = item >> 7, t0 = b * SEQ + n * 64;
        float cum[16];
        { const float* cg_ = (const float*)(a->ws + WS_CUM) + (size_t)(t0 + cg * 16) * 512 + h * 128 + d;
#pragma unroll
          for (int j = 0; j < 16; ++j) cum[j] = cg_[j * 512]; }
        bf16_t qraw[16], kraw[16]; u32x4 vraw[4];
#pragma unroll
        for (int j = 0; j < 16; ++j) { const bf16_t* row = P + (size_t)(t0 + cg * 16 + j) * DINP + h * 128 + d; qraw[j] = row[C_GQ]; kraw[j] = row[C_GK]; }
#pragma unroll
        for (int i = 0; i < 4; ++i) { const int idx = tid + i * 512, c = idx >> 5, e8 = idx & 31; vraw[i] = *(const u32x4*)(P + (size_t)(t0 + c) * DINP + C_GV + h * 256 + e8 * 8); }
        __syncthreads();
        const bf16_t* ST = (const bf16_t*)(a->ws + WS_KV) + (size_t)item * 32768;
        bf16x8 sf[2][4];
#pragma unroll
        for (int i = 0; i < 2; ++i)
#pragma unroll
            for (int ks = 0; ks < 4; ++ks) sf[i][ks] = *(const bf16x8*)(ST + ((wave * 2 + i) * 16 + li) * 128 + ks * 32 + 8 * g);
#pragma unroll
        for (int j = 0; j < 16; ++j) { const int c = cg * 16 + j;
            const float qv = bf2f(qraw[j]) * 0.08838834764831845f * __expf(cum[j]), kv = bf2f(kraw[j]) * __expf(-cum[j]);
            *(LAS bf16_t*)(lds + GC_QD + c * 272 + d * 2) = f2bf(qv); *(LAS bf16_t*)(lds + GC_KI + c * 272 + d * 2) = f2bf(kv); }
#pragma unroll
        for (int i = 0; i < 4; ++i) { const int idx = tid + i * 512, c = idx >> 5, e8 = idx & 31;
            *(LAS u32x4*)(lds + GC_V + c * 528 + e8 * 16) = vraw[i]; }
        __syncthreads();
        { const int cb = wave >> 1;
#pragma unroll
          for (int i = 0; i < 2; ++i) { const int sb = 2 * (wave & 1) + i; f32x4 s = (f32x4){0.f, 0.f, 0.f, 0.f};
              if (sb <= cb) {
#pragma unroll
                  for (int ks = 0; ks < 4; ++ks) { const bf16x8 qa = *(const LAS bf16x8*)(lds + GC_QD + (cb * 16 + li) * 272 + (ks * 32 + 8 * g) * 2), kb = *(const LAS bf16x8*)(lds + GC_KI + (sb * 16 + li) * 272 + (ks * 32 + 8 * g) * 2);
                      s = mfma16(qa, kb, s); } }
#pragma unroll
              for (int r = 0; r < 4; ++r) { const int c = cb * 16 + 4 * g + r, sc = sb * 16 + li; *(LAS bf16_t*)(lds + GC_ATT + c * 144 + sc * 2) = f2bf(sc <= c ? s[r] : 0.f); } } }
        __syncthreads();
        f32x4 acc[4][2];
#pragma unroll
        for (int cb = 0; cb < 4; ++cb)
#pragma unroll
            for (int i = 0; i < 2; ++i) acc[cb][i] = (f32x4){0.f, 0.f, 0.f, 0.f};
#pragma unroll
        for (int ks = 0; ks < 2; ++ks) { bf16x8 vf[2];
#pragma unroll
            for (int i = 0; i < 2; ++i) { const LAS unsigned char* p = lds + GC_V + (ks * 32 + 8 * g + (li >> 2)) * 528 + ((wave * 2 + i) * 16 + 4 * (li & 3)) * 2; vf[i] = cat8(vtr(p), vtr(p + 4 * 528)); }
#pragma unroll
            for (int cb = 0; cb < 4; ++cb) { const bf16x8 af = *(const LAS bf16x8*)(lds + GC_ATT + (cb * 16 + li) * 144 + (ks * 32 + 8 * g) * 2);
#pragma unroll
                for (int i = 0; i < 2; ++i) acc[cb][i] = mfma16(af, vf[i], acc[cb][i]); } }
#pragma unroll
        for (int ks = 0; ks < 4; ++ks)
#pragma unroll
            for (int cb = 0; cb < 4; ++cb) { const bf16x8 qa = *(const LAS bf16x8*)(lds + GC_QD + (cb * 16 + li) * 272 + (ks * 32 + 8 * g) * 2);
#pragma unroll
                for (int i = 0; i < 2; ++i) acc[cb][i] = mfma16(qa, sf[i][ks], acc[cb][i]); }
        LAS float* ss = (LAS float*)(lds + GC_SS);
#pragma unroll
        for (int cb = 0; cb < 4; ++cb)
#pragma unroll
            for (int r = 0; r < 4; ++r) { float q = acc[cb][0][r] * acc[cb][0][r] + acc[cb][1][r] * acc[cb][1][r];
                q = row16_sum(q);
                if (li == 0) ss[(cb * 16 + 4 * g + r) * 8 + wave] = q; }
        __syncthreads();
        LAS float* ost = (LAS float*)(lds + GC_OST);
#pragma unroll
        for (int cb = 0; cb < 4; ++cb)
#pragma unroll
            for (int r = 0; r < 4; ++r) { const int c = cb * 16 + 4 * g + r; const f32x4 s0 = *(const LAS f32x4*)(ss + c * 8), s1 = *(const LAS f32x4*)(ss + c * 8 + 4);
                const float rstd = rsqrtf(((s0.x + s0.y) + (s0.z + s0.w) + (s1.x + s1.y) + (s1.z + s1.w)) * (1.f / 256.f) + EPS);
#pragma unroll
                for (int i = 0; i < 2; ++i) ost[c * 260 + (wave * 2 + i) * 16 + li] = acc[cb][i][r] * rstd; }
        __syncthreads();
        const float* ng = a->in[I_GNG] + l * 256;
#pragma unroll
        for (int i = 0; i < 4; ++i) { const int idx = tid + i * 512, c = idx >> 5, e8 = idx & 31;
            const f32x4 o0 = *(const LAS f32x4*)(ost + c * 260 + e8 * 8), o1 = *(const LAS f32x4*)(ost + c * 260 + e8 * 8 + 4);
            const f32x4 n0 = *(const f32x4*)(ng + e8 * 8), n1 = *(const f32x4*)(ng + e8 * 8 + 4);
            const u32x4 gg = *(const u32x4*)(P + (size_t)(t0 + c) * DINP + C_GG + h * 256 + e8 * 8);
            u32x4 pk;
            pk.x = cvt_pk_bf16(o0.x * n0.x * silu(bflo(gg.x)), o0.y * n0.y * silu(bfhi(gg.x))); pk.y = cvt_pk_bf16(o0.z * n0.z * silu(bflo(gg.y)), o0.w * n0.w * silu(bfhi(gg.y)));
            pk.z = cvt_pk_bf16(o1.x * n1.x * silu(bflo(gg.z)), o1.y * n1.y * silu(bfhi(gg.z))); pk.w = cvt_pk_bf16(o1.z * n1.z * silu(bflo(gg.w)), o1.w * n1.w * silu(bfhi(gg.w)));
            *(u32x4*)(mix + (size_t)(t0 + c) * DM + M_GLA + h * 256 + e8 * 8) = pk; }
    }
    __syncthreads();
}

typedef float f32x16 __attribute__((ext_vector_type(16)));
template <int OFF> __device__ __forceinline__ s16x4 vtr_a(unsigned addr) { s16x4 r; asm volatile("ds_read_b64_tr_b16 %0, %1 offset:%2" : "=v"(r) : "v"(addr), "n"(OFF)); return r; }
#define FX_LGKM0(x) asm volatile("s_waitcnt lgkmcnt(0)" : "+v"(x[0][0][0]), "+v"(x[0][0][1]), "+v"(x[0][1][0]), "+v"(x[0][1][1]), "+v"(x[1][0][0]), "+v"(x[1][0][1]), "+v"(x[1][1][0]), "+v"(x[1][1][1]) :: "memory")
constexpr int FX_F = 0, FX_K = 8192, FX_TILE = 32768, FX_V = FX_K + FX_TILE, FX_BUF = 2 * FX_TILE, FX_MG = FX_K  , FX_WS = FX_K + 2 * FX_BUF, FX_END = FX_WS + 64;
static_assert(FX_END <= MISC_OFF && 3 * 2 * 64 * 66 * 4 <= 2 * FX_BUF, "FoX LDS");
__device__ __forceinline__ void fox_phase(ArgP a, LAS unsigned char* lds, int l) {
    const int tid = opaque_tid(), lane = tid & 63, wave = tid >> 6, wv = __builtin_amdgcn_readfirstlane(tid >> 6), r32 = lane & 31, hh = lane >> 5, rg = wave & 1, kg = wave >> 1;
    const bf16_t* P = (const bf16_t*)(a->ws + WS_P); bf16_t* mix = (bf16_t*)(a->ws + WS_MIX);
    LAS float* Fs = (LAS float*)(lds + FX_F); LAS float* wsum = (LAS float*)(lds + FX_WS);
    constexpr float C1 = 0.08838834764831845f * LOG2E;
    const int k_off = (32 * kg + r32) * 256 + (((r32 & 15) ^ hh) << 4);
    const int v_off = (32 * kg + 4 * hh + ((lane >> 2) & 3)) * 256 + (((lane >> 2) & 3) << 6) + ((2 * ((lane >> 4) & 1) + ((lane & 3) >> 1)) << 4) + ((lane & 1) << 3);
    unsigned dk_o[4]; const unsigned dv_o = (unsigned)((lane >> 4) * (DINP * 2) + C_FV * 2 + (((lane & 15) ^ ((lane >> 4) << 2)) << 4));
#pragma unroll
    for (int j = 0; j < 4; ++j) dk_o[j] = (unsigned)((lane >> 4) * (DINP * 2) + C_FK * 2 + (((lane & 15) ^ (4 * j + (lane >> 4))) << 4));
#define FX_DMA(bo_, key0_) do { const char* _g = (const char*)(P + ((size_t)(b * SEQ + (key0_) + 16 * wv) * DINP + h * 128)); \
        _Pragma("unroll") for (int _j = 0; _j < 4; ++_j) { const char* _r = _g + (size_t)(4 * _j) * DINP * 2; \
            __builtin_amdgcn_global_load_lds((const unsigned*)(_r + dk_o[_j]), (LAS unsigned*)(lds + (bo_) + FX_K + wv * 4096 + _j * 1024), 16, 0, 0); \
            __builtin_amdgcn_global_load_lds((const unsigned*)(_r + dv_o), (LAS unsigned*)(lds + (bo_) + FX_V + wv * 4096 + _j * 1024), 16, 0, 0); } } while (0)
    for (int pr = blockIdx.x; pr < 256; pr += gridDim.x) {
        const int bh = pr & 15, b = bh >> 2, h = bh & 3, rr = pr >> 4;
        { const int t2 = opaque_tid(), ln = t2 & 63, wq = t2 >> 6;
          const f32x4 lf = *(const f32x4*)((const float*)(a->ws + WS_LF) + (b * 4 + h) * SEQ + t2 * 4);
          __syncthreads();
          float v[4]; float run = 0.f;
#pragma unroll
          for (int j = 0; j < 4; ++j) { run += lf[j]; v[j] = run; }
          float inc = run;
#pragma unroll
          for (int o = 1; o < 64; o <<= 1) { const float t = __shfl_up(inc, o); if (ln >= o) inc += t; }
          if (ln == 63) wsum[wq] = inc;
          __syncthreads();
          float pre = inc - run;
#pragma unroll
          for (int q = 0; q < 8; ++q) pre += (q < wq) ? wsum[q] : 0.f;
          *(LAS f32x4*)(Fs + t2 * 4) = (f32x4){-(v[0] + pre), -(v[1] + pre), -(v[2] + pre), -(v[3] + pre)}; }
        __syncthreads();
#pragma unroll 1
        for (int half = 0; half < 2; ++half) {
            const int qb = half == 0 ? 31 - rr : rr, q0 = qb * 64, qrow = q0 + rg * 32 + r32, nsteps = (qb + 2) >> 1;
            bf16x8 qf[8];
#pragma unroll
            for (int ks = 0; ks < 8; ++ks) { const u32x4 w = *(const u32x4*)(P + (size_t)(b * SEQ + qrow) * DINP + C_FQ + h * 128 + ks * 16 + 8 * hh); u32x4 o;
                o.x = cvt_pk_bf16(bflo(w.x) * C1, bfhi(w.x) * C1); o.y = cvt_pk_bf16(bflo(w.y) * C1, bfhi(w.y) * C1); o.z = cvt_pk_bf16(bflo(w.z) * C1, bfhi(w.z) * C1); o.w = cvt_pk_bf16(bflo(w.w) * C1, bfhi(w.w) * C1);
                qf[ks] = __builtin_bit_cast(bf16x8, o); }
            float m = -1e30f, lsum = 0.f; f32x16 O[4];
#pragma unroll
            for (int j = 0; j < 4; ++j)
#pragma unroll
                for (int r = 0; r < 16; ++r) O[j][r] = 0.f;
            __syncthreads();
            FX_DMA(0, 0);
            if (1 < nsteps) { FX_DMA(FX_BUF, 128); asm volatile("s_waitcnt vmcnt(8)" ::: "memory"); } else asm volatile("s_waitcnt vmcnt(0)" ::: "memory");
            __builtin_amdgcn_s_barrier();
#pragma unroll 1
            for (int st = 0; st < nsteps; ++st) {
                const int kb0 = st * 128, bo = (st & 1) * FX_BUF;
                const int kw0 = kb0 + 32 * kg;
                if (kw0 <= q0 + rg * 32 + 31) {
                    bf16x8 kf[8];
#pragma unroll
                    for (int ks = 0; ks < 8; ++ks) kf[ks] = *(const LAS bf16x8*)(lds + bo + FX_K + (k_off ^ (ks << 5)));
                    f32x16 sc;
#pragma unroll
                    for (int i = 0; i < 4; ++i) { const f32x4 fk = *(const LAS f32x4*)(Fs + kw0 + 8 * i + 4 * hh); sc[4 * i] = fk[0]; sc[4 * i + 1] = fk[1]; sc[4 * i + 2] = fk[2]; sc[4 * i + 3] = fk[3]; }
                    __builtin_amdgcn_sched_barrier(0);
#pragma unroll
                    for (int ks = 0; ks < 8; ++ks) sc = __builtin_amdgcn_mfma_f32_32x32x16_bf16(kf[ks], qf[ks], sc, 0, 0, 0);
                    s16x4 vf[2][2][2], vg[2][2][2];
#pragma unroll
                    for (int db = 0; db < 2; ++db) { const unsigned vp = (unsigned)(size_t)(lds + bo + FX_V) + (unsigned)(v_off ^ (db << 6));
                        vf[db][0][0] = vtr_a<0>(vp); vf[db][0][1] = vtr_a<2048>(vp); vf[db][1][0] = vtr_a<4096>(vp); vf[db][1][1] = vtr_a<6144>(vp); }
                    __builtin_amdgcn_sched_barrier(0);
                    FX_LGKM0(vf);
                    if (kw0 + 31 > q0 + rg * 32) {
#pragma unroll
                        for (int r = 0; r < 16; ++r) if (kw0 + (r & 3) + 8 * (r >> 2) + 4 * hh > qrow) sc[r] = -__builtin_inff(); }
                    float mx = sc[0];
#pragma unroll
                    for (int r = 1; r < 16; ++r) mx = fmaxf(mx, sc[r]);
                    mx = fmaxf(mx, __shfl_xor(mx, 32));
                    const float mn = fmaxf(m, mx), alpha = __builtin_amdgcn_exp2f(m - mn); m = mn;
                    float ps = 0.f;
#pragma unroll
                    for (int r = 0; r < 16; ++r) { sc[r] = __builtin_amdgcn_exp2f(sc[r] - mn); ps += sc[r]; }
                    bf16x8 pf[2];
#pragma unroll
                    for (int s2 = 0; s2 < 2; ++s2) { u32x4 w; w.x = cvt_pk_bf16(sc[8 * s2], sc[8 * s2 + 1]); w.y = cvt_pk_bf16(sc[8 * s2 + 2], sc[8 * s2 + 3]); w.z = cvt_pk_bf16(sc[8 * s2 + 4], sc[8 * s2 + 5]); w.w = cvt_pk_bf16(sc[8 * s2 + 6], sc[8 * s2 + 7]);
                        pf[s2] = __builtin_bit_cast(bf16x8, w); }
                    lsum = lsum * alpha + ps;
                    if (!__all(alpha == 1.f)) {
#pragma unroll
                        for (int db = 0; db < 4; ++db)
#pragma unroll
                            for (int r = 0; r < 16; ++r) O[db][r] *= alpha; }
                    __builtin_amdgcn_sched_barrier(0);
#pragma unroll
                    for (int db = 0; db < 2; ++db) { const unsigned vp = (unsigned)(size_t)(lds + bo + FX_V) + (unsigned)(v_off ^ ((db + 2) << 6));
                        vg[db][0][0] = vtr_a<0>(vp); vg[db][0][1] = vtr_a<2048>(vp); vg[db][1][0] = vtr_a<4096>(vp); vg[db][1][1] = vtr_a<6144>(vp); }
#pragma unroll
                    for (int db = 0; db < 2; ++db)
#pragma unroll
                        for (int s2 = 0; s2 < 2; ++s2) O[db] = __builtin_amdgcn_mfma_f32_32x32x16_bf16(cat8(vf[db][s2][0], vf[db][s2][1]), pf[s2], O[db], 0, 0, 0);
                    __builtin_amdgcn_sched_barrier(0);
                    FX_LGKM0(vg);
#pragma unroll
                    for (int db = 0; db < 2; ++db)
#pragma unroll
                        for (int s2 = 0; s2 < 2; ++s2) O[db + 2] = __builtin_amdgcn_mfma_f32_32x32x16_bf16(cat8(vg[db][s2][0], vg[db][s2][1]), pf[s2], O[db + 2], 0, 0, 0);
                }
                asm volatile("s_waitcnt vmcnt(0)" ::: "memory");
                __builtin_amdgcn_s_barrier();
                if (st + 2 < nsteps) FX_DMA(bo, kb0 + 256);
            }
            lsum += __shfl_xor(lsum, 32);
            LAS float* mg = (LAS float*)(lds + FX_MG);
            if (kg > 0) { LAS float* q = mg + (((kg - 1) * 2 + rg) * 64 + lane) * 66; q[0] = m; q[1] = lsum;
#pragma unroll
                for (int db = 0; db < 4; ++db)
#pragma unroll
                    for (int r = 0; r < 16; ++r) q[2 + db * 16 + r] = O[db][r]; }
            __syncthreads();
            if (kg == 0) { float mn = m;
#pragma unroll
                for (int j = 0; j < 3; ++j) mn = fmaxf(mn, mg[((j * 2 + rg) * 64 + lane) * 66]);
                float a0 = __builtin_amdgcn_exp2f(m - mn), lt = lsum * a0;
#pragma unroll
                for (int db = 0; db < 4; ++db)
#pragma unroll
                    for (int r = 0; r < 16; ++r) O[db][r] *= a0;
#pragma unroll
                for (int j = 0; j < 3; ++j) { const LAS float* q = mg + ((j * 2 + rg) * 64 + lane) * 66; const float aj = __builtin_amdgcn_exp2f(q[0] - mn); lt += q[1] * aj;
#pragma unroll
                    for (int db = 0; db < 4; ++db)
#pragma unroll
                        for (int r = 0; r < 16; ++r) O[db][r] += q[2 + db * 16 + r] * aj; }
                const float inv = 1.f / lt;
                bf16_t* orow = mix + (size_t)(b * SEQ + qrow) * DM + M_FOX + h * 128 + 4 * hh;
#pragma unroll
                for (int db = 0; db < 4; ++db)
#pragma unroll
                    for (int i = 0; i < 4; ++i) { u32x2 w; w.x = cvt_pk_bf16(O[db][4 * i] * inv, O[db][4 * i + 1] * inv); w.y = cvt_pk_bf16(O[db][4 * i + 2] * inv, O[db][4 * i + 3] * inv);
                        *(u32x2*)(orow + db * 32 + 8 * i) = w; } }
        }
    }
#undef FX_DMA
    __syncthreads();
}

constexpr int RT_RS = 0, RT_PART = 256, RT_END = RT_PART + 8 * 32 * 48 * 4;
__device__ __forceinline__ void router_phase(ArgP a, LAS unsigned char* lds, int l, const bf16_t* x1) {
    const int tid = opaque_tid(), lane = tid & 63, wave = tid >> 6, g = lane >> 4, li = lane & 15;
    LAS float* rsd = (LAS float*)(lds + RT_RS); LAS float* part = (LAS float*)(lds + RT_PART);
    float* rsb = (float*)(a->ws + WS_RSB);
    const bf16_t* wr = (const bf16_t*)(a->ws + WS_WR) + (size_t)l * 2 * 48 * DM;
    unsigned* cnt = (unsigned*)(a->ws + WS_CTL) + CW_CNT + l * 32 * 64; int* list = (int*)(a->ws + WS_LIST); float* gwb = (float*)(a->ws + WS_GW);
    for (int item = blockIdx.x; item < T / 32; item += gridDim.x) {
        const int tk0 = item * 32;
        __syncthreads();
        { u32x4 q[4][4];
#pragma unroll
          for (int r = 0; r < 4; ++r)
#pragma unroll
              for (int j = 0; j < 4; ++j) q[r][j] = ((const u32x4*)(x1 + (size_t)(tk0 + wave * 4 + r) * DM) + lane)[64 * j];
#pragma unroll
          for (int r = 0; r < 4; ++r) { const int row = wave * 4 + r; float s = 0.f;
#pragma unroll
              for (int j = 0; j < 4; ++j) { const u32x4 w = q[r][j]; s += (bflo(w.x) * bflo(w.x) + bfhi(w.x) * bfhi(w.x)) + (bflo(w.y) * bflo(w.y) + bfhi(w.y) * bfhi(w.y)) + (bflo(w.z) * bflo(w.z) + bfhi(w.z) * bfhi(w.z)) + (bflo(w.w) * bflo(w.w) + bfhi(w.w) * bfhi(w.w)); }
              const float rstd = rsqrtf(wave_sum(s) * (1.f / DM) + EPS);
              if (lane == 0) rsd[row] = rstd; } }
        __syncthreads();
        { const int kq = wave;
          f32x4 acc[2][3];
#pragma unroll
          for (int mb = 0; mb < 2; ++mb)
#pragma unroll
              for (int cb = 0; cb < 3; ++cb) acc[mb][cb] = (f32x4){0.f, 0.f, 0.f, 0.f};
          const bf16_t* xrow = x1 + (size_t)(tk0 + li) * DM + kq * 256 + 8 * g; const bf16_t* wq = wr + kq * 256 + 8 * g;
#pragma unroll 2
          for (int ks = 0; ks < 8; ++ks) {
              const bf16x8 ax0 = *(const bf16x8*)(xrow + ks * 32), ax1 = *(const bf16x8*)(xrow + (size_t)16 * DM + ks * 32);
#pragma unroll
              for (int cb = 0; cb < 3; ++cb) { const bf16x8 wh = *(const bf16x8*)(wq + (size_t)(cb * 16 + li) * DM + ks * 32), wl = *(const bf16x8*)(wq + (size_t)(48 + cb * 16 + li) * DM + ks * 32);
                  acc[0][cb] = mfma16(ax0, wh, acc[0][cb]); acc[0][cb] = mfma16(ax0, wl, acc[0][cb]); acc[1][cb] = mfma16(ax1, wh, acc[1][cb]); acc[1][cb] = mfma16(ax1, wl, acc[1][cb]); }
          }
#pragma unroll
          for (int mb = 0; mb < 2; ++mb)
#pragma unroll
              for (int cb = 0; cb < 3; ++cb)
#pragma unroll
                  for (int r = 0; r < 4; ++r) part[(kq * 32 + mb * 16 + 4 * g + r) * 48 + cb * 16 + li] = acc[mb][cb][r] * rsd[mb * 16 + 4 * g + r]; }
        __syncthreads();
        if (tid < 32) {
            const int tok = tk0 + tid; float lg[36];
#pragma unroll
            for (int c = 0; c < 36; ++c) lg[c] = 0.f;
#pragma unroll 1
            for (int q = 0; q < 8; ++q) {
#pragma unroll
                for (int c = 0; c < 36; ++c) lg[c] += part[(q * 32 + tid) * 48 + c]; }
            float gl[4]; int grp = 0; float gmx;
#pragma unroll
            for (int c = 0; c < 4; ++c) gl[c] = lg[c] + a->in[I_RGB][l * 4 + c];
            gmx = gl[0];
#pragma unroll
            for (int c = 1; c < 4; ++c) if (gl[c] > gmx) { gmx = gl[c]; grp = c; }
            float den = 0.f;
#pragma unroll
            for (int c = 0; c < 4; ++c) den += __expf(gl[c] - gmx);
            const float ptop = 1.f / den;
            float v1 = -__builtin_inff(), v2 = -__builtin_inff(); int i1 = 0, i2 = 0;
#pragma unroll
            for (int e = 0; e < 8; ++e) { float ev = 0.f;
#pragma unroll
                for (int q = 0; q < 4; ++q) ev = (grp == q) ? lg[4 + q * 8 + e] : ev;
                const float v = ev + a->in[I_REB][(l * 4 + grp) * 8 + e];
                if (v > v1) { v2 = v1; i2 = i1; v1 = v; i1 = e; } else if (v > v2) { v2 = v; i2 = e; } }
            const float w1 = ptop / (1.f + __expf(v2 - v1)), w2 = ptop - w1;
            const int E1 = grp * 8 + i1, E2 = grp * 8 + i2;
            const unsigned s1 = atomicAdd(cnt + E1 * 64, 1u), s2 = atomicAdd(cnt + E2 * 64, 1u);
            list[E1 * CAPE + s1] = tok * 2; gwb[E1 * CAPE + s1] = w1; rsb[E1 * CAPE + s1] = rsd[tid];
            list[E2 * CAPE + s2] = tok * 2 + 1; gwb[E2 * CAPE + s2] = w2; rsb[E2 * CAPE + s2] = rsd[tid];
        }
    }
    __syncthreads();
}
__device__ __forceinline__ void moe_setup(ArgP a, LAS int* tab, int l) {
    __syncthreads();
    if (threadIdx.x < 32) { unsigned* cnt = (unsigned*)(a->ws + WS_CTL) + CW_CNT + l * 32 * 64; tab[33 + threadIdx.x] = (int)__hip_atomic_load(cnt + threadIdx.x * 64, __ATOMIC_RELAXED, __HIP_MEMORY_SCOPE_AGENT); }
    __syncthreads();
    if (threadIdx.x == 0) { int ts = 0; for (int e = 0; e < 32; ++e) { tab[e] = ts; tab[65 + e] = ts * 256; ts += (tab[33 + e] + 255) >> 8; } tab[32] = ts; }
    __syncthreads();
}
__device__ __forceinline__ void combine_phase(ArgP a, int l, const bf16_t* x1, bf16_t* x2) {
    const int tid = opaque_tid(), lane = tid & 63, wave = tid >> 6;
    const int gw = blockIdx.x * NWAVES + wave, NGW = gridDim.x * NWAVES;
    const bf16_t* Y = (const bf16_t*)(a->ws + WS_Y);
    const float* g = (l + 1 < DEPTH) ? a->in[I_N1G] + (l + 1) * DM : a->in[I_FNG];
    u32x2 rx[8], ry0[8], ry1[8];
#define CB_LOAD(m_) do { const u32x2* xr = (const u32x2*)(x1 + (size_t)(m_) * DM) + lane; const u32x2* y0 = (const u32x2*)(Y + (size_t)(2 * (m_)) * DM) + lane; const u32x2* y1 = (const u32x2*)(Y + (size_t)(2 * (m_) + 1) * DM) + lane; \
        _Pragma("unroll") for (int j = 0; j < 8; ++j) { rx[j] = xr[64 * j]; ry0[j] = y0[64 * j]; ry1[j] = y1[64 * j]; } } while (0)
    if (gw < T) CB_LOAD(gw);
    for (int m = gw; m < T; m += NGW) {
        f32x4 v[8]; float s = 0.f;
#pragma unroll
        for (int j = 0; j < 8; ++j) { const u32x2 xx = rx[j], a0 = ry0[j], a1 = ry1[j];
            v[j] = (f32x4){bflo(xx.x) + (bflo(a0.x) + bflo(a1.x)), bfhi(xx.x) + (bfhi(a0.x) + bfhi(a1.x)), bflo(xx.y) + (bflo(a0.y) + bflo(a1.y)), bfhi(xx.y) + (bfhi(a0.y) + bfhi(a1.y))};
            s += (v[j].x * v[j].x + v[j].y * v[j].y) + (v[j].z * v[j].z + v[j].w * v[j].w); }
        if (m + NGW < T) CB_LOAD(m + NGW);
        const float rstd = rsqrtf(wave_sum(s) * (1.f / DM) + EPS);
        if (l + 1 < DEPTH) {
            u32x2* xo = (u32x2*)(x2 + (size_t)m * DM) + lane;
            if (lane == 0) ((float*)(a->ws + WS_RS))[m] = rstd;
#pragma unroll
            for (int j = 0; j < 8; ++j) { u32x2 xw; xw.x = cvt_pk_bf16(v[j].x, v[j].y); xw.y = cvt_pk_bf16(v[j].z, v[j].w); xo[64 * j] = xw; }
        } else {
            f32x4* oo = (f32x4*)(a->out + (size_t)m * DM) + lane;
#pragma unroll
            for (int j = 0; j < 8; ++j) { const f32x4 gg = ((const f32x4*)g)[lane + 64 * j]; oo[64 * j] = (f32x4){v[j].x * rstd * gg.x, v[j].y * rstd * gg.y, v[j].z * rstd * gg.z, v[j].w * rstd * gg.w}; }
        }
    }
}

constexpr int PH_PER_LAYER = 9, N_PHASES = 1 + DEPTH * PH_PER_LAYER;
#ifndef PH_MASK
#define PH_MASK 0x3ff
#endif
__global__ void __launch_bounds__(NTHR, 2) fwd(Args) {
    extern __shared__ __attribute__((aligned(16))) unsigned char lds_raw[];
    LAS unsigned char* lds = (LAS unsigned char*)lds_raw;
    volatile LAS unsigned* MISC = (volatile LAS unsigned*)(lds + MISC_OFF);
    LAS int* tab = (LAS int*)(lds + MISC_OFF + 64);
    if (threadIdx.x < 256) MISC[threadIdx.x] = 0u;
    __syncthreads();
    int lo, hi; XcdBarrier bar;
    { ArgP a = kargs(); lo = a->ph_lo; hi = a->ph_hi; bar.bar = (unsigned*)(a->ws + WS_CTL) + CW_BAR; bar.x = 0; bar.st = nullptr;
      if (!MK_PER_PHASE) bar = xcd_barrier_post((unsigned*)(a->ws + WS_CTL) + CW_BAR, MISC); }
#define IN(k) (lo <= (k) && (k) < hi)
#define EN(j) ((PH_MASK >> (j)) & 1)
#ifndef REP_MASK
#define REP_MASK 0
#endif
#define REP(j) for (int _rep = 0; _rep < 1 + ((REP_MASK >> (j)) & 1); ++_rep)
#define SEAM(k) do { if (!MK_PER_PHASE && IN(k) && IN((k) + 1)) xcd_barrier(bar); } while (0)
    if (EN(0) && IN(0)) REP(0) { p0_prologue(kargs(), lds); __syncthreads(); }
    SEAM(0);
#pragma unroll 1
    for (int l = 0; l < DEPTH; ++l) {
        const int p0 = 1 + l * PH_PER_LAYER;
        if (EN(1) && IN(p0 + 0)) REP(1) { ArgP a = kargs();
            pg::DenseSched<DM> S; S.init((const bf16_t*)(a->ws + WS_WIN) + (size_t)l * DINP * DM, T, DINP, gridDim.x, blockIdx.x);
            pg::EpiBf16 E{(bf16_t*)(a->ws + WS_P), DINP, (const float*)(a->ws + WS_RS)};
            pg::gemm_phase<DM, pg::EpiBf16, pg::DenseSched<DM>>(lds, (const char*)(a->ws + WS_XB), S, E);
            if (l == 0) { int rk, nr; idle_rank((T / 256) * (DINP / 256), gridDim.x, blockIdx.x, rk, nr); if (rk >= 0) cvt_range(kargs(), lds, CV_N_IN, CV_I_OUT, rk, nr); __syncthreads(); }
        }
        SEAM(p0 + 0);
        if (EN(2) && IN(p0 + 1)) { REP(2) conv_phase(kargs(), lds, l); REP(10) gla_a_phase(kargs(), lds, l); }
        SEAM(p0 + 1);
        if (EN(3) && IN(p0 + 2)) { gla_b_phase(kargs(), lds); REP(3) fox_phase(kargs(), lds, l); }
        SEAM(p0 + 2);
        if (EN(4) && IN(p0 + 3)) REP(4) { gla_c_phase(kargs(), lds, l); }
        SEAM(p0 + 3);
        if (EN(5) && IN(p0 + 4)) REP(5) { ArgP a = kargs();
            pg::DenseSched<DM> S; S.init((const bf16_t*)(a->ws + WS_WOUT) + (size_t)l * DM * DM, T, DM, gridDim.x, blockIdx.x);
            pg::EpiRes E{(const bf16_t*)(a->ws + WS_XB), (bf16_t*)(a->ws + WS_XA), DM};
            pg::gemm_phase<DM, pg::EpiRes, pg::DenseSched<DM>>(lds, (const char*)(a->ws + WS_MIX), S, E);
        }
        SEAM(p0 + 4);
        if (EN(6) && IN(p0 + 5)) { ArgP a = kargs(); router_phase(a, lds, l, (const bf16_t*)(a->ws + WS_XA)); }
        SEAM(p0 + 5);
        if (EN(7) && IN(p0 + 6)) REP(7) { ArgP a = kargs();
            moe_setup(a, tab, l);
            const int vcu = (gridDim.x % 8 == 0) ? (int)((blockIdx.x % 8) * (gridDim.x / 8) + blockIdx.x / 8) : (int)blockIdx.x;
            pg::MoeSchedRB<DM, 8, true> S{a->in[I_WG] + (size_t)l * NEX * DM * DE, a->in[I_WU] + (size_t)l * NEX * DM * DE, tab, (const int*)(a->ws + WS_LIST), (int)gridDim.x, vcu};
#ifndef RBP
#define RBP 0
#endif
            pg::EpiGateUpRB E{(bf16_t*)(a->ws + (_rep ? WS_WGU : WS_HB)), (const float*)(a->ws + WS_GW), (const float*)(a->ws + WS_RSB)};
            { const int t4 = opaque_tid(); ((LAS f32x4*)(lds + pg::RB_GK_OFF))[t4] = ((const f32x4*)(a->in[I_N2G] + l * DM))[t4]; __syncthreads(); }
            pg::gemm_rb<DM, DE, pg::EpiGateUpRB, pg::MoeSchedRB<DM, 8, true>, true>(lds, (const char*)(a->ws + WS_XA), S, E);
            if (l == 0) { int rk, nr; idle_rank(tab[32] * 8, gridDim.x, vcu, rk, nr); if (rk >= 0) { cvt_range(kargs(), lds, CV_I_IN, CV_I_IN, rk, nr); cvt_range(kargs(), lds, CV_N_IN + CV_I_OUT, CV_I_OUT, rk, nr); } __syncthreads(); }
        }
        SEAM(p0 + 6);
        if (EN(8) && IN(p0 + 7)) REP(8) { ArgP a = kargs();
            moe_setup(a, tab, l);
            const int vcu = (gridDim.x % 8 == 0) ? (int)((blockIdx.x % 8) * (gridDim.x / 8) + blockIdx.x / 8) : (int)blockIdx.x;
            pg::MoeSchedRB<DE, 16, false> S{a->in[I_WD] + (size_t)l * NEX * DE * DM, nullptr, tab, (const int*)(a->ws + WS_LIST), (int)gridDim.x, vcu};
            pg::EpiDownRB E{(bf16_t*)(a->ws + WS_Y), (const int*)(a->ws + WS_LIST)};
            pg::gemm_rb<DE, DM, pg::EpiDownRB, pg::MoeSchedRB<DE, 16, false>>(lds, (const char*)(a->ws + WS_HB), S, E);
        }
        SEAM(p0 + 7);
        if (EN(9) && IN(p0 + 8)) REP(9) { ArgP a = kargs(); combine_phase(a, l, (const bf16_t*)(a->ws + WS_XA), (bf16_t*)(a->ws + WS_XB)); }
        SEAM(p0 + 8);
    }
#undef IN
#undef EN
#undef SEAM
}

#ifdef DBG_STAGE
__global__ void dbg_dump(const unsigned char* ws, float* out, int kind) {
    for (size_t i = (size_t)blockIdx.x * blockDim.x + threadIdx.x; i < (size_t)T * DM; i += (size_t)gridDim.x * blockDim.x) {
        const size_t r = i / DM, c = i % DM; float v = 0.f;
        if (kind == 1) v = bf2f(((const bf16_t*)(ws + WS_P))[r * DINP + 2048 + c]);
        else if (kind == 2) v = bf2f(((const bf16_t*)(ws + WS_MIX))[i]);
        else if (kind == 7) v = c < 512 ? bf2f(((const bf16_t*)(ws + WS_MIX))[i]) : 0.f;
        else if (kind == 8) v = (c >= 512 && c < 1536) ? bf2f(((const bf16_t*)(ws + WS_MIX))[i]) : 0.f;
        else if (kind == 9) v = c >= 1536 ? bf2f(((const bf16_t*)(ws + WS_MIX))[i]) : 0.f;
        else if (kind == 10 || kind == 11) v = bf2f(((const bf16_t*)(ws + WS_KV))[i]);
        else if (kind == 12) v = ((const float*)(ws + WS_DEC))[i & 65535];
        else if (kind == 13) v = bf2f(((const bf16_t*)(ws + WS_P))[r * DINP + c]);
        else if (kind == 14) v = bf2f(((const bf16_t*)(ws + WS_P))[r * DINP + 3840 + c]);
        else if (kind == 3) v = bf2f(((const bf16_t*)(ws + WS_XA))[i]);
        else if (kind == 4) v = bf2f(((const bf16_t*)(ws + WS_XB))[i]);
        else if (kind == 5) v = bf2f(((const bf16_t*)(ws + WS_H))[i]);
        else if (kind == 6) v = ((const float*)(ws + WS_Y))[i] + ((const float*)(ws + WS_Y))[i + (size_t)T * DM];
        out[i] = v; }
}
#endif
extern "C" void kernel_launch(void* const* d_in, const int* in_sizes, int n_in, void* d_out, int out_size, void* d_ws, size_t ws_size, hipStream_t stream) {
    static int grid = 0;
    if (grid == 0) {
        if (n_in != 21 || ws_size < WS_END) { fprintf(stderr, "kernel_launch: need 21 inputs and %zu bytes of workspace (got %d, %zu)\n", (size_t)WS_END, n_in, ws_size); grid = -1; return; }
        int dev = 0, cus = 0, per_cu = 0;
        if (hipGetDevice(&dev) != hipSuccess || hipDeviceGetAttribute(&cus, hipDeviceAttributeMultiprocessorCount, dev) != hipSuccess) { grid = -1; return; }
        if (hipFuncSetAttribute((const void*)fwd, hipFuncAttributeMaxDynamicSharedMemorySize, LDS_BYTES) != hipSuccess) { fprintf(stderr, "kernel_launch: hipFuncSetAttribute failed\n"); grid = -1; return; }
        if (hipOccupancyMaxActiveBlocksPerMultiprocessor(&per_cu, (const void*)fwd, NTHR, LDS_BYTES) != hipSuccess || per_cu < 1) { fprintf(stderr, "kernel_launch: occupancy query says %d\n", per_cu); per_cu = 1; }
        (void)hipGetLastError();
        grid = cus;
    }
    if (grid < 0) return;
    (void)hipMemsetAsync((char*)d_ws + WS_CTL, 0, CTL_ZERO_BYTES, stream);
    Args a{};
    for (int i = 0; i < 21; ++i) a.in[i] = (const float*)d_in[i];
    a.out = (float*)d_out; a.ws = (unsigned char*)d_ws;
#ifdef DBG_STAGE
    { const int last[15] = {0, 1, 4, 5, 9, 6, 8, 4, 4, 4, 2, 3, 2, 1, 1}; for (int p = 0; p <= last[DBG_STAGE]; ++p) { a.ph_lo = p; a.ph_hi = p + 1; hipLaunchKernelGGL(fwd, dim3(grid), dim3(NTHR), LDS_BYTES, stream, a); }
      hipLaunchKernelGGL(dbg_dump, dim3(2048), dim3(256), 0, stream, (const unsigned char*)d_ws, (float*)d_out, DBG_STAGE); }
#elif MK_PER_PHASE
    for (int p = 0; p < N_PHASES; ++p) { a.ph_lo = p; a.ph_hi = p + 1; hipLaunchKernelGGL(fwd, dim3(grid), dim3(NTHR), LDS_BYTES, stream, a); }
#else
    a.ph_lo = 0; a.ph_hi = N_PHASES; hipLaunchKernelGGL(fwd, dim3(grid), dim3(NTHR), LDS_BYTES, stream, a);
#endif
}
```

```cpp
#include <hip/hip_runtime.h>
#include <cstdio>
#include <cstdint>

#ifndef MK_PER_PHASE
#define MK_PER_PHASE 0
#endif

#define LAS __attribute__((address_space(3)))
#define GAS __attribute__((address_space(1)))
typedef unsigned short bf16_t;
typedef short bf16x8 __attribute__((ext_vector_type(8)));
typedef short s16x4 __attribute__((ext_vector_type(4)));
typedef short v4i16_t __attribute__((ext_vector_type(4)));
typedef float f32x4 __attribute__((ext_vector_type(4)));
typedef float f32x2 __attribute__((ext_vector_type(2)));
typedef unsigned u32x4 __attribute__((ext_vector_type(4)));
typedef unsigned u32x2 __attribute__((ext_vector_type(2)));

constexpr int NB = 4, SEQ = 2048, T = NB * SEQ, DM = 2048, DEPTH = 2;
constexpr int DIN = 5652, DINP = 5888;
constexpr int C_CA = 0, C_CG = 512, C_GQ = 1024, C_GK = 1536, C_GV = 2048, C_GG = 3072, C_GLOW = 4096, C_FQ = 4112, C_FK = 4624, C_FV = 5136, C_FF = 5648;
constexpr int M_CONV = 0, M_GLA = 512, M_FOX = 1536;
constexpr int NEX = 32, DE = 512, CAPE = 8192, HROWS = 16384 + 32 * 256;
constexpr float EPS = 1e-6f;
constexpr float LOG2E = 1.4426950408889634f;

constexpr size_t MiB = 1u << 20;
constexpr size_t WS_CTL = 0, CTL_ZERO_BYTES = 64 * 1024;
constexpr size_t WS_WIN = 1 * MiB;
constexpr size_t WS_WOUT = 48 * MiB;
constexpr size_t WS_WGU = 64 * MiB;
constexpr size_t WS_WD = 320 * MiB;
constexpr size_t WS_WR = 448 * MiB;
constexpr size_t WS_XA = 449 * MiB;
constexpr size_t WS_XB = 513 * MiB;
constexpr size_t WS_H = 577 * MiB;
constexpr size_t WS_RSB = 577 * MiB;
constexpr size_t WS_P = 609 * MiB;
constexpr size_t WS_MIX = 701 * MiB;
constexpr size_t WS_KV = 733 * MiB;
constexpr size_t WS_DEC = 765 * MiB;
constexpr size_t WS_RS = 765 * MiB + 768 * 1024;
constexpr size_t WS_LF = 765 * MiB + 512 * 1024;
constexpr size_t WS_CUM = 64 * MiB;
constexpr size_t WS_LIST = 766 * MiB;
constexpr size_t WS_GW = 767 * MiB;
constexpr size_t WS_HB = 768 * MiB;
constexpr size_t WS_Y = 792 * MiB;
constexpr size_t WS_END = 920 * MiB;
constexpr int CW_BAR = 0;
constexpr int CW_CNT = 4096;

constexpr int LDS_BYTES = 163840, MISC_OFF = LDS_BYTES - 1024;
constexpr int NWAVES = 8, NTHR = 512;

typedef __bf16 bf2_t __attribute__((ext_vector_type(2)));
__device__ __forceinline__ unsigned cvt_pk_bf16(float lo, float hi) { const f32x2 v = {lo, hi}; return __builtin_bit_cast(unsigned, __builtin_convertvector(v, bf2_t)); }
__device__ __forceinline__ bf16_t f2bf(float f) { return __builtin_bit_cast(bf16_t, (__bf16)f); }
__device__ __forceinline__ float bf2f(bf16_t b) { return __uint_as_float(((unsigned)b) << 16); }
__device__ __forceinline__ float bflo(unsigned w) { return __uint_as_float(w << 16); }
__device__ __forceinline__ float bfhi(unsigned w) { return __uint_as_float(w & 0xffff0000u); }
template <int CTRL> __device__ __forceinline__ float dpp_f(float v) { return __int_as_float(__builtin_amdgcn_update_dpp(0, __float_as_int(v), CTRL, 0xf, 0xf, false)); }
__device__ __forceinline__ float row16_sum(float v) { v += dpp_f<0x128>(v); v += dpp_f<0x124>(v); v += dpp_f<0x122>(v); v += dpp_f<0x121>(v); return v; }
__device__ __forceinline__ float wave_sum(float v) {
    v = row16_sum(v);
    const int b = __float_as_int(v);
    return (__int_as_float(__builtin_amdgcn_readlane(b, 0)) + __int_as_float(__builtin_amdgcn_readlane(b, 16))) + (__int_as_float(__builtin_amdgcn_readlane(b, 32)) + __int_as_float(__builtin_amdgcn_readlane(b, 48)));
}
__device__ __forceinline__ float log_sigmoid(float x) { return fminf(x, 0.f) - __logf(1.f + __expf(-fabsf(x))); }
__device__ __forceinline__ float silu(float x) { return x * __builtin_amdgcn_rcpf(1.f + __expf(-x)); }
__device__ __forceinline__ s16x4 vtr(const LAS void* p) { return __builtin_bit_cast(s16x4, __builtin_amdgcn_ds_read_tr16_b64_v4i16((LAS v4i16_t*)p)); }
__device__ __forceinline__ bf16x8 cat8(s16x4 a, s16x4 b) { bf16x8 r; r[0] = a[0]; r[1] = a[1]; r[2] = a[2]; r[3] = a[3]; r[4] = b[0]; r[5] = b[1]; r[6] = b[2]; r[7] = b[3]; return r; }
__device__ __forceinline__ f32x4 mfma16(bf16x8 a, bf16x8 b, f32x4 c) { return __builtin_amdgcn_mfma_f32_16x16x32_bf16(a, b, c, 0, 0, 0); }
__device__ __forceinline__ int opaque_tid() { int t = threadIdx.x; asm volatile("" : "+v"(t)); return t; }
#define LDS_WAIT() asm volatile("s_waitcnt lgkmcnt(0)" ::: "memory")
#define VM_WAIT() asm volatile("s_waitcnt vmcnt(0)" ::: "memory")

#define XB_TMO      128
#define XB_XCNT(j)  (256  + 64 * (j))
#define XB_XSUB(j)  (1280 + 64 * (j))
#define XB_XGEN(j)  (2304 + 64 * (j))
#define XB_TOP      3328
#define XB_TOPGEN   3392
#define XCD_BAR_WORDS 3456
#define XL_SUB(j)   (8192 + 64 * (j))
#define XL_GEN(j)   (9216 + 64 * (j))
#define XB_SPIN_CAP (1u << 18)
__device__ __forceinline__ unsigned xb_ld(unsigned* p)              { return __hip_atomic_load(p, __ATOMIC_RELAXED, __HIP_MEMORY_SCOPE_AGENT); }
__device__ __forceinline__ unsigned xb_add(unsigned* p, unsigned v) { return __hip_atomic_fetch_add(p, v, __ATOMIC_RELAXED, __HIP_MEMORY_SCOPE_AGENT); }
__device__ __forceinline__ unsigned xb_xcc_id() { return (unsigned)__builtin_amdgcn_s_getreg((3 << 11) | 20) & 0xFu; }
#define XB_SPIN(cond, bar) do { unsigned _sp = 0; while (cond) { __builtin_amdgcn_s_sleep(1); \
    if ((++_sp & 255u) == 0u) { if (xb_ld(&(bar)[XB_TMO])) break; if (_sp > XB_SPIN_CAP) { atomicAdd(&(bar)[XB_TMO], 1u); break; } } } } while (0)
struct XcdBarrier { unsigned* bar; unsigned x; volatile LAS unsigned* st; };
__device__ __forceinline__ XcdBarrier xcd_barrier_post(unsigned* bar, volatile LAS unsigned* st) {
    XcdBarrier b; b.bar = bar; b.x = xb_xcc_id(); b.st = st;
    if (threadIdx.x == 0) st[3] = xb_add(&bar[XB_XCNT(b.x)], 1u);
    return b;
}
__device__ __forceinline__ void xcd_barrier_complete(unsigned* bar, unsigned x, unsigned& nloc, unsigned& nx, unsigned& uni) {
    const unsigned G = gridDim.x * gridDim.y * gridDim.z;
    unsigned sum, cnt, mine, n32, sp = 0u;
    for (;;) {
        sum = 0u; cnt = 0u; mine = 0u; n32 = 0u;
#pragma unroll
        for (unsigned j = 0; j < 16; ++j) { const unsigned c = xb_ld(&bar[XB_XCNT(j)]); sum += c; cnt += (c > 0u) ? 1u : 0u; mine = (j == x) ? c : mine; n32 += (j < 8u && c == 32u) ? 1u : 0u; }
        if (sum == G) break;
        __builtin_amdgcn_s_sleep(1);
        if ((++sp & 255u) == 0u) { if (xb_ld(&bar[XB_TMO])) break; if (sp > XB_SPIN_CAP) { atomicAdd(&bar[XB_TMO], 1u); break; } }
    }
    nloc = mine > 0u ? mine : 1u; nx = cnt > 0u ? cnt : 1u;
    uni = (sum == G && G == 256u && n32 == 8u) ? 1u : 0u;
}
__device__ __forceinline__ void xcd_barrier(const XcdBarrier& b) {
    asm volatile("s_waitcnt vmcnt(0)" ::: "memory");
    __syncthreads();
    if (threadIdx.x == 0) {
        unsigned* bar = b.bar;
        __builtin_amdgcn_s_waitcnt(0);
        unsigned nloc = b.st[0], nx = b.st[1];
        if (nloc == 0u) { unsigned uni; xcd_barrier_complete(bar, b.x, nloc, nx, uni); b.st[0] = nloc; b.st[1] = nx; b.st[2] = uni; }
        const unsigned old = xb_add(&bar[XB_XSUB(b.x)], 1u);
        const unsigned gen = old / nloc;
        if (old + 1u == (gen + 1u) * nloc) {
            __builtin_amdgcn_fence(__ATOMIC_RELEASE, "agent");
            asm volatile("s_waitcnt vmcnt(0)" ::: "memory");
            const unsigned og = xb_add(&bar[XB_TOP], 1u);
            const unsigned tg = og / nx;
            if (og + 1u == (tg + 1u) * nx) xb_add(&bar[XB_TOPGEN], 1u);
            else XB_SPIN(xb_ld(&bar[XB_TOPGEN]) == tg, bar);
            __builtin_amdgcn_fence(__ATOMIC_ACQUIRE, "agent");
            asm volatile("s_waitcnt vmcnt(0)" ::: "memory");
            xb_add(&bar[XB_XGEN(b.x)], 1u);
            asm volatile("s_waitcnt vmcnt(0)" ::: "memory");
        } else {
            XB_SPIN(xb_ld(&bar[XB_XGEN(b.x)]) == gen, bar);
            asm volatile("buffer_inv sc0\n\ts_waitcnt vmcnt(0)" ::: "memory");
        }
    }
    __syncthreads();
}

__device__ __forceinline__ void xcd_local_barrier(const XcdBarrier& b) {
    asm volatile("s_waitcnt vmcnt(0)" ::: "memory");
    __syncthreads();
    if (threadIdx.x == 0) {
        unsigned* bar = b.bar; const unsigned nloc = b.st[0];
        const unsigned old = xb_add(&bar[XL_SUB(b.x)], 1u), gen = old / nloc;
        if (old + 1u == (gen + 1u) * nloc) xb_add(&bar[XL_GEN(b.x)], 1u);
        else XB_SPIN(xb_ld(&bar[XL_GEN(b.x)]) == gen, bar);
        asm volatile("buffer_inv sc0\n\ts_waitcnt vmcnt(0)" ::: "memory");
    }
    __syncthreads();
}

namespace pg {
constexpr int BM = 256, BK = 64, HALF = 128, HTB = HALF * BK * 2, STAGE_BYTES = 8 * HTB, RB_GK_OFF = 131072;
__host__ __device__ __forceinline__ int lds_byte(int r, int c) { const int st = (r >> 4) * 2 + (c >> 5), rr = r & 15, cc = c & 31, ob = rr * 64 + cc * 2; return st * 1024 + (ob ^ (((ob >> 9) & 1) << 5)); }
__host__ __device__ __forceinline__ void stage_rc(int b, int& R, int& C) { const int st = b / 1024, sb = b % 1024, swz = sb ^ (((sb >> 9) & 1) << 5); R = (st >> 1) * 16 + swz / 64; C = (st & 1) * 32 + (swz % 64) / 2; }
__host__ __device__ __forceinline__ int perm32(int rho) { const int n = rho >> 4, i = rho & 15; return 8 * (i >> 2) + 4 * n + (i & 3); }

template <int K, class Epi, class Sched>
__device__ __forceinline__ void gemm_phase(LAS unsigned char* lds, const char* Abase, const Sched& S, const Epi& E) {
    typedef typename Sched::Unit Unit;
    const int tid = opaque_tid(), wid = __builtin_amdgcn_readfirstlane(tid >> 6), lane = tid & 63, wr = wid >> 2, wc = wid & 3, fr = lane & 15, fq = lane >> 4;
    constexpr int nt = K / BK;
    unsigned voffB[2]; int Rr[2], Cb;
#pragma unroll
    for (int i = 0; i < 2; ++i) { int R, C; stage_rc(tid * 16 + i * 8192, R, C); const int Rb = Epi::PERM ? ((R & ~31) + perm32(R & 31)) : R;
        Rr[i] = R; Cb = C * 2; voffB[i] = (unsigned)(Rb * K + C) * 2u; }
    constexpr size_t kstep = (size_t)(BK * 2);
    constexpr size_t hstep = (size_t)HALF * K * 2;
    const unsigned ldsw = (unsigned)wid * 1024u;
    const int aoff = lds_byte(wr * 64 + fr, fq * 8), boff = lds_byte(wc * 32 + fr, fq * 8);
#define PG_SA(b, h) (((b) * 2 + (h)) * HTB)
#define PG_SB(b, h) ((4 + (b) * 2 + (h)) * HTB)
#define PG_STAGE(bufoff, gbase, voff) do { _Pragma("unroll") for (int _i = 0; _i < 2; ++_i) \
        __builtin_amdgcn_global_load_lds((const unsigned*)((const char*)(gbase) + (voff)[_i]), (LAS unsigned*)(lds + (bufoff) + ldsw + _i * 8192), 16, 0, 0); } while (0)
#define PG_LDA(dst, b, h) do { _Pragma("unroll") for (int m = 0; m < 4; ++m) _Pragma("unroll") for (int k = 0; k < 2; ++k) dst[m][k] = *(const LAS bf16x8*)(lds + PG_SA(b, h) + aoff + m * 2048 + k * 1024); } while (0)
#define PG_LDB(dst, b, h) do { _Pragma("unroll") for (int n = 0; n < 2; ++n) _Pragma("unroll") for (int k = 0; k < 2; ++k) dst[n][k] = *(const LAS bf16x8*)(lds + PG_SB(b, h) + boff + n * 2048 + k * 1024); } while (0)
#define PG_MMA(ai, bj, At, Bt) do { __builtin_amdgcn_s_setprio(1); _Pragma("unroll") for (int m = 0; m < 4; ++m) _Pragma("unroll") for (int n = 0; n < 2; ++n) _Pragma("unroll") for (int k = 0; k < 2; ++k) \
        acc[ai][bj][m][n] = __builtin_amdgcn_mfma_f32_16x16x32_bf16(Bt[n][k], At[m][k], acc[ai][bj][m][n], 0, 0, 0); __builtin_amdgcn_s_setprio(0); } while (0)
#define PG_WAIT_V(n) asm volatile("s_waitcnt vmcnt(" #n ")" ::: "memory")
#define PG_WAIT_L(n) asm volatile("s_waitcnt lgkmcnt(" #n ")" ::: "memory")
#define PG_BAR __builtin_amdgcn_s_barrier()
#define PG_SCHED __builtin_amdgcn_sched_barrier(0)
    Unit cur, nxt; int ui = 0;
    if (!S.next(0, cur)) return;
    f32x4 acc[2][2][4][2];
#pragma unroll
    for (int a = 0; a < 2; ++a)
#pragma unroll
        for (int b = 0; b < 2; ++b)
#pragma unroll
            for (int m = 0; m < 4; ++m)
#pragma unroll
                for (int n = 0; n < 2; ++n) acc[a][b][m][n] = (f32x4){0.f, 0.f, 0.f, 0.f};
    bf16x8 At[4][2], B0[2][2], B1[2][2];
    unsigned cOff[2][2], nOff[2][2];
    S.aoff(cur, Rr[0], Rr[1], Cb, cOff);
    const char* cB = S.bptr(cur);
    PG_STAGE(PG_SB(0, 0), cB, voffB); PG_STAGE(PG_SB(0, 1), cB + hstep, voffB); PG_STAGE(PG_SA(0, 0), Abase, cOff[0]); PG_STAGE(PG_SA(0, 1), Abase, cOff[1]);
    if (wr == 1) PG_BAR;
    PG_WAIT_V(2); PG_BAR;
    PG_STAGE(PG_SB(1, 0), cB + kstep, voffB); PG_STAGE(PG_SA(1, 0), Abase + kstep, cOff[0]); PG_STAGE(PG_SB(1, 1), cB + hstep + kstep, voffB);
    PG_WAIT_V(6); PG_BAR;
    for (;;) {
        const bool has_next = S.next(ui + 1, nxt);
        const char* nB = cB;
        if (has_next) { S.aoff(nxt, Rr[0], Rr[1], Cb, nOff); nB = S.bptr(nxt); }
        else { nOff[0][0] = cOff[0][0]; nOff[0][1] = cOff[0][1]; nOff[1][0] = cOff[1][0]; nOff[1][1] = cOff[1][1]; }
        for (int t = 0; t < nt; t += 2) {
            const bool last = (t == nt - 2);
            const char* a1 = Abase + (size_t)(t + 1) * kstep;
            const char* a2 = last ? Abase : Abase + (size_t)(t + 2) * kstep; const char* b2 = last ? nB : cB + (size_t)(t + 2) * kstep;
            const char* a3 = a2 + kstep; const char* b3 = b2 + kstep;
            unsigned o2[2][2];
            o2[0][0] = last ? nOff[0][0] : cOff[0][0]; o2[0][1] = last ? nOff[0][1] : cOff[0][1]; o2[1][0] = last ? nOff[1][0] : cOff[1][0]; o2[1][1] = last ? nOff[1][1] : cOff[1][1];
            PG_LDB(B0, 0, 0); PG_LDB(B1, 0, 1); PG_SCHED; PG_LDA(At, 0, 0); PG_STAGE(PG_SA(1, 1), a1, cOff[1]);
            PG_WAIT_V(8); PG_WAIT_L(0); PG_BAR; PG_MMA(0, 0, At, B0); PG_MMA(0, 1, At, B1); PG_BAR; PG_SCHED;
            PG_LDA(At, 0, 1); PG_STAGE(PG_SB(0, 0), b2, voffB); PG_STAGE(PG_SB(0, 1), b2 + hstep, voffB); PG_STAGE(PG_SA(0, 0), a2, o2[0]);
            PG_WAIT_V(8); PG_WAIT_L(0); PG_BAR; PG_MMA(1, 0, At, B0); PG_MMA(1, 1, At, B1); PG_BAR; PG_SCHED;
            PG_LDB(B0, 1, 0); PG_LDB(B1, 1, 1); PG_SCHED; PG_LDA(At, 1, 0); PG_STAGE(PG_SA(0, 1), a2, o2[1]);
            PG_WAIT_V(8); PG_WAIT_L(0); PG_BAR; PG_MMA(0, 0, At, B0); PG_MMA(0, 1, At, B1); PG_BAR; PG_SCHED;
            PG_LDA(At, 1, 1); PG_STAGE(PG_SB(1, 0), b3, voffB); PG_STAGE(PG_SB(1, 1), b3 + hstep, voffB); PG_STAGE(PG_SA(1, 0), a3, o2[0]);
            PG_WAIT_V(8); PG_WAIT_L(0); PG_BAR; PG_MMA(1, 0, At, B0); PG_MMA(1, 1, At, B1); PG_BAR; PG_SCHED;
        }
        if (wr == 0) PG_BAR;
        E(acc, cur, wr, wc, fr, fq);
        if (!has_next) break;
#pragma unroll
        for (int a = 0; a < 2; ++a)
#pragma unroll
            for (int b = 0; b < 2; ++b)
#pragma unroll
                for (int m = 0; m < 4; ++m)
#pragma unroll
                    for (int n = 0; n < 2; ++n) acc[a][b][m][n] = (f32x4){0.f, 0.f, 0.f, 0.f};
        cur = nxt; cB = nB; ++ui;
        cOff[0][0] = nOff[0][0]; cOff[0][1] = nOff[0][1]; cOff[1][0] = nOff[1][0]; cOff[1][1] = nOff[1][1];
        if (wr == 1) PG_BAR;
    }
    PG_WAIT_V(0);
    PG_BAR;
#undef PG_SA
#undef PG_SB
#undef PG_STAGE
#undef PG_LDA
#undef PG_LDB
#undef PG_MMA
#undef PG_WAIT_V
#undef PG_WAIT_L
#undef PG_BAR
#undef PG_SCHED
}

struct DUnit { int pm, pn; };
#ifndef WGM
#define WGM 4
#endif
template <int K> struct DenseSched {
    typedef DUnit Unit;
    const char* Bt; int nM, nN, nwg, G, c;
    __device__ __forceinline__ void init(const void* Bt_, int M, int N, int G_, int c_) { Bt = (const char*)Bt_; nM = M / BM; nN = N / BM; nwg = nM * nN; G = G_; c = c_; }
    __device__ __forceinline__ bool next(int i, Unit& u) const {
        const long L = (long)i * G + c; if (L >= nwg) return false;
        int wgid = (int)L; { const int q = nwg / 8, r = nwg % 8, xcd = wgid % 8, off = wgid / 8; wgid = (xcd < r ? xcd * (q + 1) : r * (q + 1) + (xcd - r) * q) + off; }
        const int nig = WGM * nN, gid = wgid / nig, fm = gid * WGM, gsz = (nM - fm) < WGM ? (nM - fm) : WGM;
        u.pm = fm + ((wgid % nig) % gsz); u.pn = (wgid % nig) / gsz; return true;
    }
    __device__ __forceinline__ const char* bptr(const Unit& u) const { return Bt + (size_t)u.pn * BM * K * 2; }
    __device__ __forceinline__ void aoff(const Unit& u, int R0, int R1, int Cb, unsigned (&o)[2][2]) const {
#pragma unroll
        for (int h = 0; h < 2; ++h) { o[h][0] = (unsigned)((u.pm * BM + h * HALF + R0) * K) * 2u + Cb; o[h][1] = (unsigned)((u.pm * BM + h * HALF + R1) * K) * 2u + Cb; }
    }
};
struct MUnit { int E, mt, pn, cnt, rowbase, hf; };
template <int K, int NT, bool GATHER> struct MoeSched {
    typedef MUnit Unit;
    const char* W; const LAS int* tab; const int* list; int G, c;
    __device__ __forceinline__ bool next(int i, Unit& u) const {
        const int L = i * G + c; const int total = tab[32] * NT; if (L >= total) return false;
        const int mg = L / NT; u.pn = L % NT;
        int E = 0;
#pragma unroll 1
        for (int e = 1; e < 32; ++e) E = (tab[e] <= mg) ? e : E;
        E = __builtin_amdgcn_readfirstlane(E);
        u.E = E; u.mt = mg - tab[E]; u.cnt = tab[33 + E]; u.rowbase = tab[65 + E]; return true;
    }
    __device__ __forceinline__ const char* bptr(const Unit& u) const { return W + ((size_t)u.E * NT + u.pn) * BM * K * 2; }
    __device__ __forceinline__ void aoff(const Unit& u, int R0, int R1, int Cb, unsigned (&o)[2][2]) const {
#pragma unroll
        for (int h = 0; h < 2; ++h)
#pragma unroll
            for (int i = 0; i < 2; ++i) { const int slot = u.mt * BM + h * HALF + (i ? R1 : R0);
                if (GATHER) { const int tok = slot < u.cnt ? (list[u.E * CAPE + slot] >> 1) : 0; o[h][i] = (unsigned)(tok * K) * 2u + Cb; }
                else o[h][i] = (unsigned)((u.rowbase + slot) * K) * 2u + Cb; }
    }
};

struct EpiBf16 {
    static constexpr bool PERM = true;
    bf16_t* O; int ldc; const float* rs;
    __device__ __forceinline__ void operator()(const f32x4 (&acc)[2][2][4][2], const DUnit& u, int wr, int wc, int fr, int fq) const {
        const int row0 = u.pm * BM + wr * 64 + fr, col0 = u.pn * BM + wc * 32 + 8 * fq;
        float rr[2][4];
#pragma unroll
        for (int ai = 0; ai < 2; ++ai)
#pragma unroll
            for (int m = 0; m < 4; ++m) rr[ai][m] = rs[row0 + ai * HALF + m * 16];
        asm volatile("" : "+v"(rr[0][0]), "+v"(rr[0][1]), "+v"(rr[0][2]), "+v"(rr[0][3]), "+v"(rr[1][0]), "+v"(rr[1][1]), "+v"(rr[1][2]), "+v"(rr[1][3]) :: "memory");
#pragma unroll
        for (int ai = 0; ai < 2; ++ai)
#pragma unroll
            for (int m = 0; m < 4; ++m) { bf16_t* rowp = O + (size_t)(row0 + ai * HALF + m * 16) * ldc + col0; const float r = rr[ai][m];
                if (u.pn < 4) {
                    const f32x4 a0 = acc[ai][0][m][0] * r, a1 = acc[ai][0][m][1] * r, g0 = acc[ai][1][m][0] * r, g1 = acc[ai][1][m][1] * r; float o[8];
#pragma unroll
                    for (int j = 0; j < 4; ++j) { o[j] = a0[j] * __builtin_amdgcn_rcpf(1.f + __expf(-g0[j])); o[4 + j] = a1[j] * __builtin_amdgcn_rcpf(1.f + __expf(-g1[j])); }
                    u32x4 w; w.x = cvt_pk_bf16(o[0], o[1]); w.y = cvt_pk_bf16(o[2], o[3]); w.z = cvt_pk_bf16(o[4], o[5]); w.w = cvt_pk_bf16(o[6], o[7]);
                    *(u32x4*)(rowp - (size_t)u.pn * HALF) = w;
                } else {
#pragma unroll
                for (int bj = 0; bj < 2; ++bj) { const f32x4 v0 = acc[ai][bj][m][0] * r, v1 = acc[ai][bj][m][1] * r;
                    u32x4 w; w.x = cvt_pk_bf16(v0[0], v0[1]); w.y = cvt_pk_bf16(v0[2], v0[3]); w.z = cvt_pk_bf16(v1[0], v1[1]); w.w = cvt_pk_bf16(v1[2], v1[3]);
                    *(u32x4*)(rowp + bj * HALF) = w; } } }
    }
};
struct EpiRes {
    static constexpr bool PERM = true;
    const bf16_t* res; bf16_t* C; int ldc;
    __device__ __forceinline__ void operator()(const f32x4 (&acc)[2][2][4][2], const DUnit& u, int wr, int wc, int fr, int fq) const {
        const int row0 = u.pm * BM + wr * 64 + fr, col0 = u.pn * BM + wc * 32 + 8 * fq;
        u32x4 rv[2][4][2];
#pragma unroll
        for (int ai = 0; ai < 2; ++ai)
#pragma unroll
            for (int m = 0; m < 4; ++m)
#pragma unroll
                for (int bj = 0; bj < 2; ++bj) rv[ai][m][bj] = *(const u32x4*)(res + (size_t)(row0 + ai * HALF + m * 16) * ldc + col0 + bj * HALF);
        asm volatile("" ::: "memory");
#pragma unroll
        for (int ai = 0; ai < 2; ++ai)
#pragma unroll
            for (int m = 0; m < 4; ++m) { const size_t off = (size_t)(row0 + ai * HALF + m * 16) * ldc + col0;
#pragma unroll
                for (int bj = 0; bj < 2; ++bj) { const u32x4 r = rv[ai][m][bj]; const f32x4 v0 = acc[ai][bj][m][0], v1 = acc[ai][bj][m][1];
                    u32x4 w; w.x = cvt_pk_bf16(bflo(r.x) + v0[0], bfhi(r.x) + v0[1]); w.y = cvt_pk_bf16(bflo(r.y) + v0[2], bfhi(r.y) + v0[3]);
                    w.z = cvt_pk_bf16(bflo(r.z) + v1[0], bfhi(r.z) + v1[1]); w.w = cvt_pk_bf16(bflo(r.w) + v1[2], bfhi(r.w) + v1[3]);
                    *(u32x4*)(C + off + bj * HALF) = w; } }
    }
};
struct EpiGateUp {
    static constexpr bool PERM = true;
    bf16_t* H; const float* gw;
    __device__ __forceinline__ void operator()(const f32x4 (&acc)[2][2][4][2], const MUnit& u, int wr, int wc, int fr, int fq) const {
        const int col0 = u.pn * HALF + wc * 32 + 8 * fq;
#pragma unroll
        for (int ai = 0; ai < 2; ++ai)
#pragma unroll
            for (int m = 0; m < 4; ++m) { const int slot = u.mt * BM + ai * HALF + wr * 64 + m * 16 + fr;
                const float w = slot < u.cnt ? gw[u.E * CAPE + slot] : 0.f;
                const f32x4 g0 = acc[ai][0][m][0], g1 = acc[ai][0][m][1], u0 = acc[ai][1][m][0], u1 = acc[ai][1][m][1];
                float h[8];
#pragma unroll
                for (int j = 0; j < 4; ++j) { h[j] = silu(g0[j]) * u0[j] * w; h[4 + j] = silu(g1[j]) * u1[j] * w; }
                u32x4 o; o.x = cvt_pk_bf16(h[0], h[1]); o.y = cvt_pk_bf16(h[2], h[3]); o.z = cvt_pk_bf16(h[4], h[5]); o.w = cvt_pk_bf16(h[6], h[7]);
                *(u32x4*)(H + (size_t)(u.rowbase + slot) * DE + col0) = o; }
    }
};
struct EpiDown {
    static constexpr bool PERM = true;
    bf16_t* Y; const int* list;
    __device__ __forceinline__ void operator()(const f32x4 (&acc)[2][2][4][2], const MUnit& u, int wr, int wc, int fr, int fq) const {
        const int col0 = u.pn * BM + wc * 32 + 8 * fq;
#pragma unroll
        for (int ai = 0; ai < 2; ++ai)
#pragma unroll
            for (int m = 0; m < 4; ++m) { const int slot = u.mt * BM + ai * HALF + wr * 64 + m * 16 + fr;
                if (slot < u.cnt) { const int ent = list[u.E * CAPE + slot]; bf16_t* rowp = Y + (size_t)ent * DM + col0;
#pragma unroll
                    for (int bj = 0; bj < 2; ++bj) { const f32x4 v0 = acc[ai][bj][m][0], v1 = acc[ai][bj][m][1];
                        u32x4 w; w.x = cvt_pk_bf16(v0[0], v0[1]); w.y = cvt_pk_bf16(v0[2], v0[3]); w.z = cvt_pk_bf16(v1[0], v1[1]); w.w = cvt_pk_bf16(v1[2], v1[3]);
                        *(u32x4*)(rowp + bj * HALF) = w; } } }
    }
};

template <int K, int LDB, class Epi, class Sched, bool GK = false  , int NAI = 2  >
__device__ __forceinline__ void gemm_rb(LAS unsigned char* lds, const char* Abase, const Sched& S, const Epi& E) {
    typedef typename Sched::Unit Unit;
    const int tid = opaque_tid(), wid = __builtin_amdgcn_readfirstlane(tid >> 6), lane = tid & 63, wr = wid >> 2, wc = wid & 3, fr = lane & 15, fq = lane >> 4;
    constexpr int nt = K / BK;
    int Rr[2], Cb;
#pragma unroll
    for (int i = 0; i < 2; ++i) { int R, C; stage_rc(tid * 16 + i * 8192, R, C); Rr[i] = R; Cb = C * 2; }
    const unsigned ldsw = (unsigned)wid * 1024u;
    const int aoff = lds_byte(wr * 64 + fr, fq * 8);
    const int k4 = tid >> 5, n4 = tid & 31;
    int bw[4];
#pragma unroll
    for (int q = 0; q < 4; ++q) { const int row = Epi::PERM ? (32 * (n4 >> 3) + 16 * (n4 & 1) + 4 * ((n4 >> 1) & 3) + q) : (4 * n4 + q);
        bw[q] = row * 128 + (((k4 >> 1) ^ ((row >> 2) & 7)) * 16) + (k4 & 1) * 8; }
    int brd[2][2];
#pragma unroll
    for (int n = 0; n < 2; ++n)
#pragma unroll
        for (int k = 0; k < 2; ++k) { const int r = wc * 32 + n * 16 + fr; brd[n][k] = r * 128 + (((k * 4 + fq) ^ ((r >> 2) & 7)) * 16); }
#define RB_SB(b) (98304 + (b) * HTB)
#define RB_STAGE_A(sa, kt, OFF) do { _Pragma("unroll") for (int _h = 0; _h < NAI; ++_h) _Pragma("unroll") for (int _i = 0; _i < 2; ++_i) \
        __builtin_amdgcn_global_load_lds((const unsigned*)(Abase + (size_t)(kt) * (BK * 2) + OFF[_h][_i]), (LAS unsigned*)(lds + (sa) * 32768 + _h * HTB + ldsw + _i * 8192), 16, 0, 0); } while (0)
#define RB_LOAD_B(r0, r1, r2, r3, kt, BP) do { const float* _p = BP + (size_t)(kt) * BK * LDB; \
        asm volatile("global_load_dwordx4 %0, %4, off\n\tglobal_load_dwordx4 %1, %5, off\n\tglobal_load_dwordx4 %2, %6, off\n\tglobal_load_dwordx4 %3, %7, off" \
            : "=&v"(r0), "=&v"(r1), "=&v"(r2), "=&v"(r3) : "v"(_p), "v"(_p + LDB), "v"(_p + 2 * LDB), "v"(_p + 3 * LDB) : "memory"); } while (0)
#define RB_WAIT8(r0, r1, r2, r3) do { if (NAI == 2) asm volatile("s_waitcnt vmcnt(8)" : "+v"(r0), "+v"(r1), "+v"(r2), "+v"(r3) :: "memory"); else asm volatile("s_waitcnt vmcnt(6)" : "+v"(r0), "+v"(r1), "+v"(r2), "+v"(r3) :: "memory"); } while (0)
#define RB_WRITE_B(b, r0, r1, r2, r3, kw) do { f32x4 _g = {1.f, 1.f, 1.f, 1.f}; if (GK) _g = *(const LAS f32x4*)(lds + RB_GK_OFF + ((kw) * BK + 4 * k4) * 4); \
        _Pragma("unroll") for (int _q = 0; _q < 4; ++_q) { u32x2 _w; _w.x = GK ? cvt_pk_bf16(r0[_q] * _g.x, r1[_q] * _g.y) : cvt_pk_bf16(r0[_q], r1[_q]); _w.y = GK ? cvt_pk_bf16(r2[_q] * _g.z, r3[_q] * _g.w) : cvt_pk_bf16(r2[_q], r3[_q]); \
        *(LAS u32x2*)(lds + RB_SB(b) + bw[_q]) = _w; } } while (0)
#define RB_COMPUTE(sa, b) do { bf16x8 Bf[2][2]; _Pragma("unroll") for (int n = 0; n < 2; ++n) _Pragma("unroll") for (int k = 0; k < 2; ++k) Bf[n][k] = *(const LAS bf16x8*)(lds + RB_SB(b) + brd[n][k]); \
        _Pragma("unroll") for (int ai = 0; ai < NAI; ++ai) { bf16x8 At[4][2]; _Pragma("unroll") for (int m = 0; m < 4; ++m) _Pragma("unroll") for (int k = 0; k < 2; ++k) At[m][k] = *(const LAS bf16x8*)(lds + (sa) * 32768 + ai * HTB + aoff + m * 2048 + k * 1024); \
            __builtin_amdgcn_s_setprio(1); _Pragma("unroll") for (int m = 0; m < 4; ++m) _Pragma("unroll") for (int n = 0; n < 2; ++n) _Pragma("unroll") for (int k = 0; k < 2; ++k) acc[ai][m][n] = __builtin_amdgcn_mfma_f32_16x16x32_bf16(Bf[n][k], At[m][k], acc[ai][m][n], 0, 0, 0); __builtin_amdgcn_s_setprio(0); } } while (0)
#define RB_SYNC() do { asm volatile("s_waitcnt lgkmcnt(0)" ::: "memory"); __builtin_amdgcn_s_barrier(); asm volatile("" ::: "memory"); sa = sa == 2 ? 0 : sa + 1; } while (0)
#define RB_STEP(b, kt2, kw, OFF, BP, c0, c1, c2, c3, n0, n1, n2, n3) do { const int _s2 = sa >= 1 ? sa - 1 : 2; RB_STAGE_A(_s2, kt2, OFF); RB_LOAD_B(c0, c1, c2, c3, kt2, BP); \
        RB_COMPUTE(sa, b); RB_WAIT8(n0, n1, n2, n3); RB_WRITE_B((b) ^ 1, n0, n1, n2, n3, kw); RB_SYNC(); } while (0)
    Unit u, un;
    if (!S.next(0, u)) return;
    unsigned cOff[2][2], nOff[2][2]; int raw[2][2];
    S.aoff_ld(u, Rr[0], Rr[1], raw); asm volatile("" : "+v"(raw[0][0]), "+v"(raw[0][1]), "+v"(raw[1][0]), "+v"(raw[1][1])); S.aoff_fin(u, Rr[0], Rr[1], Cb, raw, cOff);
    const float* bp = S.bsrc(u, 4 * n4) + (size_t)(4 * k4) * LDB; const float* nbp = bp;
    f32x4 e0, e1, e2, e3, o0, o1, o2, o3;
    asm volatile("s_waitcnt vmcnt(0)" ::: "memory");
    RB_STAGE_A(0, 0, cOff); RB_LOAD_B(e0, e1, e2, e3, 0, bp);
    RB_STAGE_A(1, 1, cOff); RB_LOAD_B(o0, o1, o2, o3, 1, bp);
    RB_WAIT8(e0, e1, e2, e3); RB_WRITE_B(0, e0, e1, e2, e3, 0);
    asm volatile("s_waitcnt lgkmcnt(0)" ::: "memory"); __builtin_amdgcn_s_barrier(); asm volatile("" ::: "memory");
    int sa = 0;
    for (int ui = 0;; ++ui) {
        const bool has_next = S.next(ui + 1, un);
        if (!has_next) un = u;
        S.aoff_ld(un, Rr[0], Rr[1], raw); nbp = S.bsrc(un, 4 * n4) + (size_t)(4 * k4) * LDB;
        f32x4 acc[NAI][4][2];
#pragma unroll
        for (int a = 0; a < NAI; ++a)
#pragma unroll
            for (int m = 0; m < 4; ++m)
#pragma unroll
                for (int n = 0; n < 2; ++n) acc[a][m][n] = (f32x4){0.f, 0.f, 0.f, 0.f};
        unsigned pv[NAI][4], pr[NAI][4]; E.pre(u, wr, fr, pv, pr);
#pragma unroll 1
        for (int t = 0; t < nt - 2; t += 2) { RB_STEP(0, t + 2, t + 1, cOff, bp, e0, e1, e2, e3, o0, o1, o2, o3); RB_STEP(1, t + 3, t + 2, cOff, bp, o0, o1, o2, o3, e0, e1, e2, e3); }
        asm volatile("" : "+v"(raw[0][0]), "+v"(raw[0][1]), "+v"(raw[1][0]), "+v"(raw[1][1])); S.aoff_fin(un, Rr[0], Rr[1], Cb, raw, nOff);
        RB_STEP(0, 0, nt - 1, nOff, nbp, e0, e1, e2, e3, o0, o1, o2, o3); RB_STEP(1, 1, 0, nOff, nbp, o0, o1, o2, o3, e0, e1, e2, e3);
        E(acc, u, wr, wc, fr, fq, pv, pr);
        if (!has_next) break;
        u = un; bp = nbp; cOff[0][0] = nOff[0][0]; cOff[0][1] = nOff[0][1]; cOff[1][0] = nOff[1][0]; cOff[1][1] = nOff[1][1];
    }
    asm volatile("s_waitcnt vmcnt(0)" ::: "memory"); __builtin_amdgcn_s_barrier();
#undef RB_SB
#undef RB_STAGE_A
#undef RB_LOAD_B
#undef RB_WAIT8
#undef RB_WRITE_B
#undef RB_COMPUTE
#undef RB_STEP
#undef RB_SYNC
}
template <int K, int NT, bool GATHER> struct MoeSchedRB {
    typedef MUnit Unit;
    const float* W0; const float* W1; const LAS int* tab; const int* list; int G, c;
    int L0 = 0, L1 = -1; bool halves = false;
    int xl = -1;
    __device__ __forceinline__ bool next(int i, Unit& u) const {
        int L = L0 + i * G + c; u.hf = 0; if (halves) { const int Lh = i * G + c; L = L0 + (Lh >> 1); u.hf = Lh & 1; }
        int E = 0, tb0;
        if (xl >= 0) { const LAS int* lp = tab + 196 + 5 * xl; const int total = lp[4] * NT, lim = (L1 >= 0 && L1 < total) ? L1 : total; if (L >= lim) return false;
            const int mg = L / NT; int p_ = 0;
#pragma unroll
            for (int k = 1; k < 4; ++k) p_ = (lp[k] <= mg) ? k : p_;
            E = __builtin_amdgcn_readfirstlane(tab[164 + 4 * xl + p_]); tb0 = lp[p_]; }
        else { const int total = tab[32] * NT, lim = (L1 >= 0 && L1 < total) ? L1 : total; if (L >= lim) return false;
            const int mg = L / NT;
#pragma unroll 1
            for (int e = 1; e < 32; ++e) E = (tab[e] <= mg) ? e : E;
            E = __builtin_amdgcn_readfirstlane(E); tb0 = tab[E]; }
#ifndef ORDER_MT_FAST
#define ORDER_MT_FAST 1
#endif
        { const int nte = tab[E + 1] - tab[E], loc = L - tb0 * NT; u.pn = loc / nte; u.mt = loc - u.pn * nte; }
        u.E = E; u.cnt = tab[33 + E]; u.rowbase = tab[65 + E]; return true;
    }
    __device__ __forceinline__ const float* bsrc(const Unit& u, int c4) const {
        if (GATHER) { const long dW = ((c4 >> 4) & 1) ? (long)(W1 - W0) : 0l; return W0 + dW + (size_t)u.E * DM * DE + 64 * u.pn + 16 * (c4 >> 5) + (c4 & 15); }
        else return W0 + (size_t)u.E * DE * DM + 128 * u.pn + c4;
    }
    __device__ __forceinline__ void aoff_ld(const Unit& u, int R0, int R1, int (&raw)[2][2]) const {
#pragma unroll
        for (int h = 0; h < 2; ++h)
#pragma unroll
            for (int i = 0; i < 2; ++i) { const int slot = u.mt * BM + ((u.hf + h) & 1) * HALF + (i ? R1 : R0); raw[h][i] = GATHER ? list[u.E * CAPE + slot] : 0; }
    }
    __device__ __forceinline__ void aoff_fin(const Unit& u, int R0, int R1, int Cb, const int (&raw)[2][2], unsigned (&o)[2][2]) const {
#pragma unroll
        for (int h = 0; h < 2; ++h)
#pragma unroll
            for (int i = 0; i < 2; ++i) { const int slot = u.mt * BM + ((u.hf + h) & 1) * HALF + (i ? R1 : R0);
                if (GATHER) { const int tok = slot < u.cnt ? (raw[h][i] >> 1) : 0; o[h][i] = (unsigned)(tok * K) * 2u + Cb; }
                else o[h][i] = (unsigned)((u.rowbase + slot) * K) * 2u + Cb; }
    }
};
struct EpiGateUpRB {
    static constexpr bool PERM = false;
    bf16_t* H; const float* gw; const float* rsb;
    template <int NA> __device__ __forceinline__ void pre(const MUnit& u, int wr, int fr, unsigned (&pv)[NA][4], unsigned (&pr)[NA][4]) const {
#pragma unroll
        for (int ai = 0; ai < NA; ++ai)
#pragma unroll
            for (int m = 0; m < 4; ++m) { const int sl = u.E * CAPE + u.mt * BM + (u.hf + ai) * HALF + wr * 64 + m * 16 + fr; pv[ai][m] = __float_as_uint(gw[sl]); pr[ai][m] = __float_as_uint(rsb[sl]); }
    }
    template <int NA> __device__ __forceinline__ void operator()(const f32x4 (&acc)[NA][4][2], const MUnit& u, int wr, int wc, int fr, int fq, const unsigned (&pv)[NA][4], const unsigned (&pr)[NA][4]) const {
        const int col0 = u.pn * 64 + wc * 16 + 4 * fq;
#pragma unroll
        for (int ai = 0; ai < NA; ++ai)
#pragma unroll
            for (int m = 0; m < 4; ++m) { const int slot = u.mt * BM + (u.hf + ai) * HALF + wr * 64 + m * 16 + fr;
                const bool ok = slot < u.cnt; const float rs = ok ? __uint_as_float(pr[ai][m]) : 0.f, w = ok ? __uint_as_float(pv[ai][m]) * rs : 0.f;
                const f32x4 g = acc[ai][m][0] * rs, up = acc[ai][m][1];
                u32x2 o; o.x = cvt_pk_bf16(silu(g[0]) * up[0] * w, silu(g[1]) * up[1] * w); o.y = cvt_pk_bf16(silu(g[2]) * up[2] * w, silu(g[3]) * up[3] * w);
                *(u32x2*)(H + (size_t)(u.rowbase + slot) * DE + col0) = o; }
    }
};
struct EpiDownRB {
    static constexpr bool PERM = true;
    bf16_t* Y; const int* list;
    __device__ __forceinline__ void pre(const MUnit& u, int wr, int fr, unsigned (&pv)[2][4], unsigned (&)[2][4]) const {
#pragma unroll
        for (int ai = 0; ai < 2; ++ai)
#pragma unroll
            for (int m = 0; m < 4; ++m) pv[ai][m] = (unsigned)list[u.E * CAPE + u.mt * BM + ai * HALF + wr * 64 + m * 16 + fr];
    }
    __device__ __forceinline__ void operator()(const f32x4 (&acc)[2][4][2], const MUnit& u, int wr, int wc, int fr, int fq, const unsigned (&pv)[2][4], const unsigned (&)[2][4]) const {
        const int col0 = u.pn * HALF + wc * 32 + 8 * fq;
        unsigned pw[2][4];
#pragma unroll
        for (int ai = 0; ai < 2; ++ai)
#pragma unroll
            for (int m = 0; m < 4; ++m) pw[ai][m] = pv[ai][m];
        asm volatile("" : "+v"(pw[0][0]), "+v"(pw[0][1]), "+v"(pw[0][2]), "+v"(pw[0][3]), "+v"(pw[1][0]), "+v"(pw[1][1]), "+v"(pw[1][2]), "+v"(pw[1][3]));
#pragma unroll
        for (int ai = 0; ai < 2; ++ai)
#pragma unroll
            for (int m = 0; m < 4; ++m) { const int slot = u.mt * BM + ai * HALF + wr * 64 + m * 16 + fr;
                if (slot < u.cnt) { const f32x4 v0 = acc[ai][m][0], v1 = acc[ai][m][1];
                    u32x4 o; o.x = cvt_pk_bf16(v0[0], v0[1]); o.y = cvt_pk_bf16(v0[2], v0[3]); o.z = cvt_pk_bf16(v1[0], v1[1]); o.w = cvt_pk_bf16(v1[2], v1[3]);
                    *(u32x4*)(Y + (size_t)pw[ai][m] * DM + col0) = o; } }
    }
};
}

struct Args { const float* in[21]; float* out; unsigned char* ws; int ph_lo, ph_hi; };
#define CAS __attribute__((address_space(4)))
typedef const CAS Args* ArgP;
__device__ __forceinline__ ArgP kargs() { ArgP p = (ArgP)__builtin_amdgcn_kernarg_segment_ptr(); asm volatile("" : "+s"(p)); return p; }

enum { I_X = 0, I_N1G, I_WIN, I_CONVW, I_CONVB, I_CLNG, I_CLNB, I_GW2, I_GB2, I_GNG, I_FFB, I_WOUT, I_N2G, I_RGW, I_RGB, I_REW, I_REB, I_WG, I_WU, I_WD, I_FNG };

template <int MAP  >
__device__ __forceinline__ void cvt_item(const float* W, int K, int N, int nblk, bf16_t* WT, LAS float* scr, int item, int lane, const float* gk = nullptr  ) {
    const int kb = item / nblk, nb = item % nblk, k0 = 64 * kb, n0 = 32 * nb;
    const int n4 = lane & 7, kr = lane >> 3;
    const bool nok = (n0 + 4 * n4) < N;
    f32x4 v[8];
#pragma unroll
    for (int i = 0; i < 8; ++i) v[i] = nok ? *(const f32x4*)(W + (size_t)(k0 + 8 * i + kr) * N + n0 + 4 * n4) : (f32x4){0.f, 0.f, 0.f, 0.f};
    if (gk) { float gs[8];
#pragma unroll
        for (int i = 0; i < 8; ++i) gs[i] = gk[k0 + 8 * i + kr];
#pragma unroll
        for (int i = 0; i < 8; ++i) v[i] = v[i] * gs[i]; }
#pragma unroll
    for (int i = 0; i < 8; ++i) { LAS float* d = scr + (8 * i + kr) * 33 + 4 * n4; d[0] = v[i].x; d[1] = v[i].y; d[2] = v[i].z; d[3] = v[i].w; }
    LDS_WAIT(); asm volatile("" ::: "memory");
    const int c = lane & 7;
#pragma unroll
    for (int j = 0; j < 4; ++j) { const int n = (lane >> 3) + 8 * j; const LAS float* s = scr + (8 * c) * 33 + n;
        u32x4 o; o.x = cvt_pk_bf16(s[0 * 33], s[1 * 33]); o.y = cvt_pk_bf16(s[2 * 33], s[3 * 33]); o.z = cvt_pk_bf16(s[4 * 33], s[5 * 33]); o.w = cvt_pk_bf16(s[6 * 33], s[7 * 33]);
        const int nn = n0 + n; const int row = MAP == 0 ? nn : MAP == 3 ? (nn < 512 ? ((nn >> 7) * 256 + (nn & 127)) : nn < 1024 ? ((((nn - 512) >> 7) * 256) + ((nn - 512) & 127) + 128) : nn) : ((nn >> 7) * 256 + (nn & 127) + (MAP == 2 ? 128 : 0));
        *(u32x4*)(WT + (size_t)row * K + k0 + 8 * c) = o; }
    LDS_WAIT(); asm volatile("" ::: "memory");
}
constexpr int CV_I_IN = 32 * 184, CV_I_OUT = 32 * 64, CV_N_IN = 2 * CV_I_IN;
__device__ __forceinline__ void cvt_range(ArgP a, LAS unsigned char* lds, int first, int count, int rank, int nranks) {
    const int tid = opaque_tid(), lane = tid & 63, wave = tid >> 6;
    LAS float* scr = (LAS float*)(lds + wave * 16384);
    for (int it = first + rank * NWAVES + wave; it < first + count; it += nranks * NWAVES) {
        int r = it;
        if (r < CV_N_IN) { const int l = r / CV_I_IN; cvt_item<3>(a->in[I_WIN] + (size_t)l * DM * DIN, DM, DIN, 184, (bf16_t*)(a->ws + WS_WIN) + (size_t)l * DINP * DM, scr, r % CV_I_IN, lane, a->in[I_N1G] + l * DM); continue; } r -= CV_N_IN;
        { const int l = r / CV_I_OUT; cvt_item<0>(a->in[I_WOUT] + (size_t)l * DM * DM, DM, DM, 64, (bf16_t*)(a->ws + WS_WOUT) + (size_t)l * DM * DM, scr, r % CV_I_OUT, lane); }
    }
}
__device__ __forceinline__ void idle_rank(int nunits, int G, int c, int& rank, int& nranks) {
    const int maxu = (nunits + G - 1) / G, nidle = maxu * G - nunits, first = nunits - (maxu - 1) * G;
    if (nidle >= 16) { nranks = nidle; rank = c >= first ? c - first : -1; } else { nranks = G; rank = c; }
}
__device__ __forceinline__ void p0_prologue(ArgP a, LAS unsigned char* lds) {
    const int tid = opaque_tid(), lane = tid & 63, wave = tid >> 6;
    LAS float* scr = (LAS float*)(lds + wave * 16384);
    const int gw = blockIdx.x * NWAVES + wave, NGW = gridDim.x * NWAVES;
    constexpr int I_IN = CV_I_IN;
    cvt_range(a, lds, 0, I_IN, blockIdx.x, gridDim.x);
    for (int idx = blockIdx.x * NTHR + tid; idx < DEPTH * 48 * DM; idx += gridDim.x * NTHR) {
        const int k = idx % DM, c = (idx / DM) % 48, l = idx / (DM * 48);
        float w = 0.f;
        if (c < 4) w = a->in[I_RGW][((size_t)l * DM + k) * 4 + c];
        else if (c < 36) w = a->in[I_REW][(((size_t)l * 4 + ((c - 4) >> 3)) * DM + k) * 8 + ((c - 4) & 7)];
        w *= a->in[I_N2G][l * DM + k];
        const bf16_t hi = f2bf(w), lo = f2bf(w - bf2f(hi));
        bf16_t* wr = (bf16_t*)(a->ws + WS_WR);
        wr[((size_t)(l * 2 + 0) * 48 + c) * DM + k] = hi; wr[((size_t)(l * 2 + 1) * 48 + c) * DM + k] = lo;
    }
    f32x4 nx[8];
    if (gw < T) {
#pragma unroll
        for (int j = 0; j < 8; ++j) nx[j] = ((const f32x4*)(a->in[I_X] + (size_t)gw * DM) + lane)[64 * j]; }
    for (int m = gw; m < T; m += NGW) {
        f32x4 v[8]; float s = 0.f;
#pragma unroll
        for (int j = 0; j < 8; ++j) { v[j] = nx[j]; s += (v[j].x * v[j].x + v[j].y * v[j].y) + (v[j].z * v[j].z + v[j].w * v[j].w); }
        if (m + NGW < T) {
#pragma unroll
            for (int j = 0; j < 8; ++j) nx[j] = ((const f32x4*)(a->in[I_X] + (size_t)(m + NGW) * DM) + lane)[64 * j]; }
        const float rstd = rsqrtf(wave_sum(s) * (1.f / DM) + EPS);
        if (lane == 0) ((float*)(a->ws + WS_RS))[m] = rstd;
        u32x2* xb = (u32x2*)((bf16_t*)(a->ws + WS_XB) + (size_t)m * DM) + lane;
#pragma unroll
        for (int j = 0; j < 8; ++j) { u32x2 xw; xw.x = cvt_pk_bf16(v[j].x, v[j].y); xw.y = cvt_pk_bf16(v[j].z, v[j].w); xb[64 * j] = xw; }
    }
}

__device__ __forceinline__ void conv_phase(ArgP a, LAS unsigned char* lds, int l) {
    const int tid = opaque_tid(), lane = tid & 63, wave = tid >> 6, cp = tid & 255, th = tid >> 8;
    const bf16_t* P = (const bf16_t*)(a->ws + WS_P); bf16_t* mix = (bf16_t*)(a->ws + WS_MIX);
    LAS float* ut = (LAS float*)lds;
    for (int item = blockIdx.x; item < NB * (SEQ / 32); item += gridDim.x) {
        const int vi = (item % 8) * (NB * (SEQ / 32) / 8) + item / 8;
        const int b = vi / (SEQ / 32), s0 = (vi % (SEQ / 32)) * 32;
        __syncthreads();
        u32x4 avv[8];
#pragma unroll
        for (int i = 0; i < 8; ++i) { const int idx = tid + i * 512, r = idx >> 6, c8 = idx & 63; int sq = s0 - 30 + (r < 62 ? r : 61); sq = sq < 0 ? 0 : sq;
            avv[i] = *(const u32x4*)(P + (size_t)(b * SEQ + sq) * DINP + C_CA + c8 * 8); }
#pragma unroll
        for (int i = 0; i < 8; ++i) { const int idx = tid + i * 512, r = idx >> 6, c8 = idx & 63, sq = s0 - 30 + r;
            if (r < 62) { const unsigned msk = sq >= 0 ? 0xffffffffu : 0u; u32x4 av = avv[i]; av.x &= msk; av.y &= msk; av.z &= msk; av.w &= msk;
                const f32x4 u0 = (f32x4){bflo(av.x), bfhi(av.x), bflo(av.y), bfhi(av.y)}, u1 = (f32x4){bflo(av.z), bfhi(av.z), bflo(av.w), bfhi(av.w)};
                *(LAS f32x4*)(ut + r * 512 + c8 * 8) = u0; *(LAS f32x4*)(ut + r * 512 + c8 * 8 + 4) = u1; } }
        f32x2 w[31];
#pragma unroll
        for (int j = 0; j < 31; ++j) w[j] = *(const f32x2*)(a->in[I_CONVW] + ((size_t)l * 31 + j) * 512 + 2 * cp);
        const f32x2 cb = *(const f32x2*)(a->in[I_CONVB] + l * 512 + 2 * cp);
        __syncthreads();
        f32x2 y[16];
#pragma unroll
        for (int t = 0; t < 16; ++t) y[t] = cb;
#pragma unroll
        for (int r = 0; r < 46; ++r) { const f32x2 u = *(const LAS f32x2*)(ut + (th * 16 + r) * 512 + 2 * cp);
#pragma unroll
            for (int t = 0; t < 16; ++t) { const int j = r - t; if (j >= 0 && j < 31) y[t] += w[j] * u; } }
        __syncthreads();
#pragma unroll
        for (int t = 0; t < 16; ++t) *(LAS f32x2*)(ut + (th * 16 + t) * 512 + 2 * cp) = y[t];
        __syncthreads();
        const f32x4 g0 = *(const f32x4*)(a->in[I_CLNG] + l * 512 + lane * 8), g1 = *(const f32x4*)(a->in[I_CLNG] + l * 512 + lane * 8 + 4);
        const f32x4 b0 = *(const f32x4*)(a->in[I_CLNB] + l * 512 + lane * 8), b1 = *(const f32x4*)(a->in[I_CLNB] + l * 512 + lane * 8 + 4);
#pragma unroll
        for (int q = 0; q < 4; ++q) { const int t = wave * 4 + q;
            const f32x4 y0 = *(const LAS f32x4*)(ut + t * 512 + lane * 8), y1 = *(const LAS f32x4*)(ut + t * 512 + lane * 8 + 4);
            const float mu = wave_sum((y0.x + y0.y) + (y0.z + y0.w) + (y1.x + y1.y) + (y1.z + y1.w)) * (1.f / 512.f);
            const f32x4 d0 = y0 - mu, d1 = y1 - mu;
            const float var = wave_sum((d0.x * d0.x + d0.y * d0.y) + (d0.z * d0.z + d0.w * d0.w) + (d1.x * d1.x + d1.y * d1.y) + (d1.z * d1.z + d1.w * d1.w)) * (1.f / 512.f);
            const float rstd = rsqrtf(var + EPS);
            float o[8];
#pragma unroll
            for (int j = 0; j < 4; ++j) { o[j] = silu(d0[j] * rstd * g0[j] + b0[j]); o[4 + j] = silu(d1[j] * rstd * g1[j] + b1[j]); }
            u32x4 pk; pk.x = cvt_pk_bf16(o[0], o[1]); pk.y = cvt_pk_bf16(o[2], o[3]); pk.z = cvt_pk_bf16(o[4], o[5]); pk.w = cvt_pk_bf16(o[6], o[7]);
            *(u32x4*)(mix + (size_t)(b * SEQ + s0 + t) * DM + M_CONV + lane * 8) = pk; }
    }
    __syncthreads();
}

constexpr int GL_ALOW = 0, GL_TOT = 5120, GL_END0 = 5120 + 2048;
__device__ __forceinline__ void gla_cum(ArgP a, LAS unsigned char* lds, int l, int h, int t0, float (&cum)[16], float& last) {
    const int tid = opaque_tid(), d = tid & 127, cg = tid >> 7;
    const bf16_t* P = (const bf16_t*)(a->ws + WS_P);
    LAS float* alow = (LAS float*)(lds + GL_ALOW); LAS float* tot = (LAS float*)(lds + GL_TOT);
#pragma unroll
    for (int i = 0; i < 2; ++i) { const int idx = tid + i * 512, c = idx >> 4, r = idx & 15; alow[c * 20 + r] = bf2f(P[(size_t)(t0 + c) * DINP + C_GLOW + r]); }
    float w2[16];
#pragma unroll
    for (int r = 0; r < 16; ++r) w2[r] = a->in[I_GW2][((size_t)l * 16 + r) * 512 + h * 128 + d];
    const float b2 = a->in[I_GB2][l * 512 + h * 128 + d];
    __syncthreads();
    float run = 0.f;
#pragma unroll
    for (int j = 0; j < 16; ++j) { const int c = cg * 16 + j; float z = b2;
#pragma unroll
        for (int q = 0; q < 4; ++q) { const f32x4 av = *(const LAS f32x4*)(alow + c * 20 + q * 4); z += av.x * w2[q * 4] + av.y * w2[q * 4 + 1] + av.z * w2[q * 4 + 2] + av.w * w2[q * 4 + 3]; }
        run += log_sigmoid(z) * (1.f / 16.f); cum[j] = run; }
    tot[cg * 128 + d] = run;
    __syncthreads();
    float pre = 0.f, all = 0.f;
#pragma unroll
    for (int q = 0; q < 4; ++q) { const float tv = tot[q * 128 + d]; pre += (q < cg) ? tv : 0.f; all += tv; }
#pragma unroll
    for (int j = 0; j < 16; ++j) cum[j] += pre;
    last = all;
}
constexpr int GA_KT = GL_END0, GA_V = GA_KT + 128 * 144, GA_OUT = GA_V + 64 * 528, GA_END = GA_OUT + 256 * 256;
static_assert(GA_END <= MISC_OFF, "GLA-A LDS");
__device__ __forceinline__ int gla_item(int it, int uni) { if (!uni) return it; const int j = it >> 8, v = it & 255; return (2 * (v >> 5) + j) * 32 + (v & 31); }
__device__ __forceinline__ void gla_a_phase(ArgP a, LAS unsigned char* lds, int l, int vid, int uni) {
    const int tid = opaque_tid(), lane = tid & 63, wave = tid >> 6, d = tid & 127, cg = tid >> 7, g = lane >> 4, li = lane & 15;
    const bf16_t* P = (const bf16_t*)(a->ws + WS_P);
    for (int it_ = vid; it_ < 512; it_ += gridDim.x) { const int item = gla_item(it_, uni);
        const int n = item & 31, h = (item >> 5) & 3, b = item >> 7, t0 = b * SEQ + n * 64;
        if (tid < 64) ((float*)(a->ws + WS_LF))[(b * 4 + h) * SEQ + n * 64 + tid] = log_sigmoid(bf2f(P[(size_t)(t0 + tid) * DINP + C_FF + h]) + a->in[I_FFB][l * 4 + h]) * LOG2E;
        float cum[16], last;
        bf16_t kraw[16]; u32x4 vraw[4];
#pragma unroll
        for (int j = 0; j < 16; ++j) kraw[j] = P[(size_t)(t0 + cg * 16 + j) * DINP + C_GK + h * 128 + d];
#pragma unroll
        for (int i = 0; i < 4; ++i) { const int idx = tid + i * 512, c = idx >> 5, e8 = idx & 31; vraw[i] = *(const u32x4*)(P + (size_t)(t0 + c) * DINP + C_GV + h * 256 + e8 * 8); }
        __syncthreads();
        gla_cum(a, lds, l, h, t0, cum, last);
        { float* cg_ = (float*)(a->ws + WS_CUM) + (size_t)(t0 + cg * 16) * 512 + h * 128 + d;
#pragma unroll
          for (int j = 0; j < 16; ++j) cg_[j * 512] = cum[j]; }
        { unsigned pk[8];
#pragma unroll
          for (int j = 0; j < 16; j += 2) { const float k0 = bf2f(kraw[j]), k1 = bf2f(kraw[j + 1]);
              pk[j >> 1] = cvt_pk_bf16(k0 * __expf(last - cum[j]), k1 * __expf(last - cum[j + 1])); }
          LAS u32x4* dst = (LAS u32x4*)(lds + GA_KT + d * 144 + cg * 32);
          dst[0] = (u32x4){pk[0], pk[1], pk[2], pk[3]}; dst[1] = (u32x4){pk[4], pk[5], pk[6], pk[7]}; }
        if (cg == 0) ((float*)(a->ws + WS_DEC))[item * 128 + d] = __expf(last);
#pragma unroll
        for (int i = 0; i < 4; ++i) { const int idx = tid + i * 512, c = idx >> 5, e8 = idx & 31;
            *(LAS u32x4*)(lds + GA_V + c * 528 + e8 * 16) = vraw[i]; }
        __syncthreads();
        f32x4 acc[2][8];
#pragma unroll
        for (int i = 0; i < 2; ++i)
#pragma unroll
            for (int j = 0; j < 8; ++j) acc[i][j] = (f32x4){0.f, 0.f, 0.f, 0.f};
#pragma unroll
        for (int kk = 0; kk < 2; ++kk) {
            bf16x8 af[2], bfr[8];
#pragma unroll
            for (int i = 0; i < 2; ++i) { const LAS unsigned char* p = lds + GA_V + (kk * 32 + 8 * g + (li >> 2)) * 528 + ((wave * 2 + i) * 16 + 4 * (li & 3)) * 2;
                af[i] = cat8(vtr(p), vtr(p + 4 * 528)); }
#pragma unroll
            for (int j = 0; j < 8; ++j) bfr[j] = *(const LAS bf16x8*)(lds + GA_KT + (j * 16 + li) * 144 + (kk * 32 + 8 * g) * 2);
#pragma unroll
            for (int i = 0; i < 2; ++i)
#pragma unroll
                for (int j = 0; j < 8; ++j) acc[i][j] = mfma16(af[i], bfr[j], acc[i][j]);
        }
#pragma unroll
        for (int i = 0; i < 2; ++i)
#pragma unroll
            for (int j = 0; j < 8; ++j)
#pragma unroll
                for (int r = 0; r < 4; ++r) *(LAS bf16_t*)(lds + GA_OUT + (((wave * 2 + i) * 16 + 4 * g + r) * 128 + j * 16 + li) * 2) = f2bf(acc[i][j][r]);
        __syncthreads();
        bf16_t* kv = (bf16_t*)(a->ws + WS_KV) + (size_t)item * 32768;
#pragma unroll
        for (int i = 0; i < 8; ++i) { const int idx = tid + i * 512; *(u32x4*)(kv + idx * 8) = *(const LAS u32x4*)(lds + GA_OUT + idx * 16); }
    }
    __syncthreads();
}
__device__ __forceinline__ void gla_b_phase(ArgP a, LAS unsigned char* lds, int vid, int uni) {
    bf16_t* kvb = (bf16_t*)(a->ws + WS_KV); const float* dec = (const float*)(a->ws + WS_DEC);
    const int tid0 = opaque_tid();
    LAS float* dl = (LAS float*)lds;
    for (int k_ = vid; k_ < 256; k_ += gridDim.x) { const int base = (uni ? (2 * (k_ >> 5) + ((k_ >> 4) & 1)) * 16 + (k_ & 15) : k_) * NTHR;
        const int idx = base + tid0, bh = base >> 13, off = (idx & 8191) * 4, d0 = off & 127;
        u32x2 kvv[32];
#pragma unroll
        for (int q = 0; q < 32; ++q) kvv[q] = *(const u32x2*)(kvb + (size_t)(bh * 32 + q) * 32768 + off);
        __syncthreads();
#pragma unroll
        for (int i = 0; i < 2; ++i) *(LAS f32x4*)(dl + (tid0 + i * 512) * 4) = *(const f32x4*)(dec + (size_t)bh * 32 * 128 + (tid0 + i * 512) * 4);
        __syncthreads();
        float st[4] = {0.f, 0.f, 0.f, 0.f};
#pragma unroll
        for (int q = 0; q < 32; ++q) { const f32x4 dc = *(const LAS f32x4*)(dl + q * 128 + d0);
            u32x2 o; o.x = cvt_pk_bf16(st[0], st[1]); o.y = cvt_pk_bf16(st[2], st[3]);
            *(u32x2*)(kvb + (size_t)(bh * 32 + q) * 32768 + off) = o;
            st[0] = dc.x * st[0] + bflo(kvv[q].x); st[1] = dc.y * st[1] + bfhi(kvv[q].x); st[2] = dc.z * st[2] + bflo(kvv[q].y); st[3] = dc.w * st[3] + bfhi(kvv[q].y); }
    }
    __syncthreads();
}
constexpr int GC_QD = GL_END0, GC_KI = GC_QD + 64 * 272, GC_ATT = GC_KI + 64 * 272, GC_V = GC_ATT + 64 * 144, GC_SS = GC_V + 64 * 528, GC_END = GC_SS + 64 * 8 * 4;
constexpr int GC_OST = GL_END0;
static_assert(GC_END <= MISC_OFF && GC_OST + 64 * 260 * 4 <= GC_SS, "GLA-C LDS");
__device__ __forceinline__ void gla_c_phase(ArgP a, LAS unsigned char* lds, int l, int vid, int uni) {
    const int tid = opaque_tid(), lane = tid & 63, wave = tid >> 6, d = tid & 127, cg = tid >> 7, g = lane >> 4, li = lane & 15;
    const bf16_t* P = (const bf16_t*)(a->ws + WS_P); bf16_t* mix = (bf16_t*)(a->ws + WS_MIX);
    for (int it_ = vid; it_ < 512; it_ += gridDim.x) { const int item = gla_item(it_, uni);
        const int n = item & 31, h = (item >> 5) & 3, b = item >> 7, t0 = b * SEQ + n * 64;
        float cum[16];
        { const float* cg_ = (const float*)(a->ws + WS_CUM) + (size_t)(t0 + cg * 16) * 512 + h * 128 + d;
#pragma unroll
          for (int j = 0; j < 16; ++j) cum[j] = cg_[j * 512]; }
        bf16_t qraw[16], kraw[16]; u32x4 vraw[4];
#pragma unroll
        for (int j = 0; j < 16; ++j) { const bf16_t* row = P + (size_t)(t0 + cg * 16 + j) * DINP + h * 128 + d; qraw[j] = row[C_GQ]; kraw[j] = row[C_GK]; }
#pragma unroll
        for (int i = 0; i < 4; ++i) { const int idx = tid + i * 512, c = idx >> 5, e8 = idx & 31; vraw[i] = *(const u32x4*)(P + (size_t)(t0 + c) * DINP + C_GV + h * 256 + e8 * 8); }
        __syncthreads();
        const bf16_t* ST = (const bf16_t*)(a->ws + WS_KV) + (size_t)item * 32768;
        bf16x8 sf[2][4];
#pragma unroll
        for (int i = 0; i < 2; ++i)
#pragma unroll
            for (int ks = 0; ks < 4; ++ks) sf[i][ks] = *(const bf16x8*)(ST + ((wave * 2 + i) * 16 + li) * 128 + ks * 32 + 8 * g);
#pragma unroll
        for (int j = 0; j < 16; ++j) { const int c = cg * 16 + j;
            const float qv = bf2f(qraw[j]) * 0.08838834764831845f * __expf(cum[j]), kv = bf2f(kraw[j]) * __expf(-cum[j]);
            *(LAS bf16_t*)(lds + GC_QD + c * 272 + d * 2) = f2bf(qv); *(LAS bf16_t*)(lds + GC_KI + c * 272 + d * 2) = f2bf(kv); }
#pragma unroll
        for (int i = 0; i < 4; ++i) { const int idx = tid + i * 512, c = idx >> 5, e8 = idx & 31;
            *(LAS u32x4*)(lds + GC_V + c * 528 + e8 * 16) = vraw[i]; }
        __syncthreads();
        { const int cb = wave >> 1;
#pragma unroll
          for (int i = 0; i < 2; ++i) { const int sb = 2 * (wave & 1) + i; f32x4 s = (f32x4){0.f, 0.f, 0.f, 0.f};
              if (sb <= cb) {
#pragma unroll
                  for (int ks = 0; ks < 4; ++ks) { const bf16x8 qa = *(const LAS bf16x8*)(lds + GC_QD + (cb * 16 + li) * 272 + (ks * 32 + 8 * g) * 2), kb = *(const LAS bf16x8*)(lds + GC_KI + (sb * 16 + li) * 272 + (ks * 32 + 8 * g) * 2);
                      s = mfma16(qa, kb, s); } }
#pragma unroll
              for (int r = 0; r < 4; ++r) { const int c = cb * 16 + 4 * g + r, sc = sb * 16 + li; *(LAS bf16_t*)(lds + GC_ATT + c * 144 + sc * 2) = f2bf(sc <= c ? s[r] : 0.f); } } }
        __syncthreads();
        f32x4 acc[4][2];
#pragma unroll
        for (int cb = 0; cb < 4; ++cb)
#pragma unroll
            for (int i = 0; i < 2; ++i) acc[cb][i] = (f32x4){0.f, 0.f, 0.f, 0.f};
#pragma unroll
        for (int ks = 0; ks < 2; ++ks) { bf16x8 vf[2];
#pragma unroll
            for (int i = 0; i < 2; ++i) { const LAS unsigned char* p = lds + GC_V + (ks * 32 + 8 * g + (li >> 2)) * 528 + ((wave * 2 + i) * 16 + 4 * (li & 3)) * 2; vf[i] = cat8(vtr(p), vtr(p + 4 * 528)); }
#pragma unroll
            for (int cb = 0; cb < 4; ++cb) { const bf16x8 af = *(const LAS bf16x8*)(lds + GC_ATT + (cb * 16 + li) * 144 + (ks * 32 + 8 * g) * 2);
#pragma unroll
                for (int i = 0; i < 2; ++i) acc[cb][i] = mfma16(af, vf[i], acc[cb][i]); } }
#pragma unroll
        for (int ks = 0; ks < 4; ++ks)
#pragma unroll
            for (int cb = 0; cb < 4; ++cb) { const bf16x8 qa = *(const LAS bf16x8*)(lds + GC_QD + (cb * 16 + li) * 272 + (ks * 32 + 8 * g) * 2);
#pragma unroll
                for (int i = 0; i < 2; ++i) acc[cb][i] = mfma16(qa, sf[i][ks], acc[cb][i]); }
        LAS float* ss = (LAS float*)(lds + GC_SS);
#pragma unroll
        for (int cb = 0; cb < 4; ++cb)
#pragma unroll
            for (int r = 0; r < 4; ++r) { float q = acc[cb][0][r] * acc[cb][0][r] + acc[cb][1][r] * acc[cb][1][r];
                q = row16_sum(q);
                if (li == 0) ss[(cb * 16 + 4 * g + r) * 8 + wave] = q; }
        __syncthreads();
        LAS float* ost = (LAS float*)(lds + GC_OST);
#pragma unroll
        for (int cb = 0; cb < 4; ++cb)
#pragma unroll
            for (int r = 0; r < 4; ++r) { const int c = cb * 16 + 4 * g + r; const f32x4 s0 = *(const LAS f32x4*)(ss + c * 8), s1 = *(const LAS f32x4*)(ss + c * 8 + 4);
                const float rstd = rsqrtf(((s0.x + s0.y) + (s0.z + s0.w) + (s1.x + s1.y) + (s1.z + s1.w)) * (1.f / 256.f) + EPS);
#pragma unroll
                for (int i = 0; i < 2; ++i) ost[c * 260 + (wave * 2 + i) * 16 + li] = acc[cb][i][r] * rstd; }
        __syncthreads();
        const float* ng = a->in[I_GNG] + l * 256;
        const f32x4 n0 = *(const f32x4*)(ng + (tid & 31) * 8), n1 = *(const f32x4*)(ng + (tid & 31) * 8 + 4);
        u32x4 ggv[4];
#pragma unroll
        for (int i = 0; i < 4; ++i) { const int idx = tid + i * 512, c = idx >> 5, e8 = idx & 31; ggv[i] = *(const u32x4*)(P + (size_t)(t0 + c) * DINP + C_GG + h * 256 + e8 * 8); }
#pragma unroll
        for (int i = 0; i < 4; ++i) { const int idx = tid + i * 512, c = idx >> 5, e8 = idx & 31;
            const f32x4 o0 = *(const LAS f32x4*)(ost + c * 260 + e8 * 8), o1 = *(const LAS f32x4*)(ost + c * 260 + e8 * 8 + 4);
            const u32x4 gg = ggv[i];
            u32x4 pk;
            pk.x = cvt_pk_bf16(o0.x * n0.x * silu(bflo(gg.x)), o0.y * n0.y * silu(bfhi(gg.x))); pk.y = cvt_pk_bf16(o0.z * n0.z * silu(bflo(gg.y)), o0.w * n0.w * silu(bfhi(gg.y)));
            pk.z = cvt_pk_bf16(o1.x * n1.x * silu(bflo(gg.z)), o1.y * n1.y * silu(bfhi(gg.z))); pk.w = cvt_pk_bf16(o1.z * n1.z * silu(bflo(gg.w)), o1.w * n1.w * silu(bfhi(gg.w)));
            *(u32x4*)(mix + (size_t)(t0 + c) * DM + M_GLA + h * 256 + e8 * 8) = pk; }
    }
    __syncthreads();
}

typedef float f32x16 __attribute__((ext_vector_type(16)));
template <int OFF> __device__ __forceinline__ s16x4 vtr_a(unsigned addr) { s16x4 r; asm volatile("ds_read_b64_tr_b16 %0, %1 offset:%2" : "=v"(r) : "v"(addr), "n"(OFF)); return r; }
#define FX_LGKM0(x) asm volatile("s_waitcnt lgkmcnt(0)" : "+v"(x[0][0][0]), "+v"(x[0][0][1]), "+v"(x[0][1][0]), "+v"(x[0][1][1]), "+v"(x[1][0][0]), "+v"(x[1][0][1]), "+v"(x[1][1][0]), "+v"(x[1][1][1]) :: "memory")
constexpr int FX_F = 0, FX_K = 8192, FX_TILE = 32768, FX_V = FX_K + FX_TILE, FX_BUF = 2 * FX_TILE, FX_MG = FX_K  , FX_WS = FX_K + 2 * FX_BUF, FX_END = FX_WS + 64, FX_OST = FX_MG + 3 * 2 * 64 * 66 * 4  ;
static_assert(FX_END <= MISC_OFF && FX_OST + 64 * 272 <= FX_WS, "FoX LDS");
__device__ __forceinline__ void fox_phase(ArgP a, LAS unsigned char* lds, int l, int vid, int uni) {
    const int tid = opaque_tid(), lane = tid & 63, wave = tid >> 6, wv = __builtin_amdgcn_readfirstlane(tid >> 6), r32 = lane & 31, hh = lane >> 5, rg = wave & 1, kg = wave >> 1;
    const bf16_t* P = (const bf16_t*)(a->ws + WS_P); bf16_t* mix = (bf16_t*)(a->ws + WS_MIX);
    LAS float* Fs = (LAS float*)(lds + FX_F); LAS float* wsum = (LAS float*)(lds + FX_WS);
    constexpr float C1 = 0.08838834764831845f * LOG2E;
    const int k_off = (32 * kg + r32) * 256 + (((r32 & 15) ^ hh) << 4);
    const int v_off = (32 * kg + 4 * hh + ((lane >> 2) & 3)) * 256 + (((lane >> 2) & 3) << 6) + ((2 * ((lane >> 4) & 1) + ((lane & 3) >> 1)) << 4) + ((lane & 1) << 3);
    unsigned dk_o[4]; const unsigned dv_o = (unsigned)((lane >> 4) * (DINP * 2) + C_FV * 2 + (((lane & 15) ^ ((lane >> 4) << 2)) << 4));
#pragma unroll
    for (int j = 0; j < 4; ++j) dk_o[j] = (unsigned)((lane >> 4) * (DINP * 2) + C_FK * 2 + (((lane & 15) ^ (4 * j + (lane >> 4))) << 4));
#define FX_DMA(bo_, key0_) do { const char* _g = (const char*)(P + ((size_t)(b * SEQ + (key0_) + 16 * wv) * DINP + h * 128)); \
        _Pragma("unroll") for (int _j = 0; _j < 4; ++_j) { const char* _r = _g + (size_t)(4 * _j) * DINP * 2; \
            __builtin_amdgcn_global_load_lds((const unsigned*)(_r + dk_o[_j]), (LAS unsigned*)(lds + (bo_) + FX_K + wv * 4096 + _j * 1024), 16, 0, 0); \
            __builtin_amdgcn_global_load_lds((const unsigned*)(_r + dv_o), (LAS unsigned*)(lds + (bo_) + FX_V + wv * 4096 + _j * 1024), 16, 0, 0); } } while (0)
    for (int pr_ = vid; pr_ < 256; pr_ += gridDim.x) { const int pr = uni ? (pr_ & 15) * 16 + 2 * (pr_ >> 5) + ((pr_ >> 4) & 1) : pr_;
        const int bh = pr & 15, b = bh >> 2, h = bh & 3, rr = pr >> 4;
        { const int t2 = opaque_tid(), ln = t2 & 63, wq = t2 >> 6;
          const f32x4 lf = *(const f32x4*)((const float*)(a->ws + WS_LF) + (b * 4 + h) * SEQ + t2 * 4);
          __syncthreads();
          float v[4]; float run = 0.f;
#pragma unroll
          for (int j = 0; j < 4; ++j) { run += lf[j]; v[j] = run; }
          float inc = run;
#pragma unroll
          for (int o = 1; o < 64; o <<= 1) { const float t = __shfl_up(inc, o); if (ln >= o) inc += t; }
          if (ln == 63) wsum[wq] = inc;
          __syncthreads();
          float pre = inc - run;
#pragma unroll
          for (int q = 0; q < 8; ++q) pre += (q < wq) ? wsum[q] : 0.f;
          *(LAS f32x4*)(Fs + t2 * 4) = (f32x4){-(v[0] + pre), -(v[1] + pre), -(v[2] + pre), -(v[3] + pre)}; }
        __syncthreads();
#pragma unroll 1
        for (int half = 0; half < 2; ++half) {
            const int qb = half == 0 ? 31 - rr : rr, q0 = qb * 64, qrow = q0 + rg * 32 + r32, nsteps = (qb + 2) >> 1;
            bf16x8 qf[8];
#pragma unroll
            for (int ks = 0; ks < 8; ++ks) { const u32x4 w = *(const u32x4*)(P + (size_t)(b * SEQ + qrow) * DINP + C_FQ + h * 128 + ks * 16 + 8 * hh); u32x4 o;
                o.x = cvt_pk_bf16(bflo(w.x) * C1, bfhi(w.x) * C1); o.y = cvt_pk_bf16(bflo(w.y) * C1, bfhi(w.y) * C1); o.z = cvt_pk_bf16(bflo(w.z) * C1, bfhi(w.z) * C1); o.w = cvt_pk_bf16(bflo(w.w) * C1, bfhi(w.w) * C1);
                qf[ks] = __builtin_bit_cast(bf16x8, o); }
            float m = -1e30f, lsum = 0.f; f32x16 O[4];
#pragma unroll
            for (int j = 0; j < 4; ++j)
#pragma unroll
                for (int r = 0; r < 16; ++r) O[j][r] = 0.f;
            __syncthreads();
            FX_DMA(0, 0);
            if (1 < nsteps) { FX_DMA(FX_BUF, 128); asm volatile("s_waitcnt vmcnt(8)" ::: "memory"); } else asm volatile("s_waitcnt vmcnt(0)" ::: "memory");
            __builtin_amdgcn_s_barrier();
#pragma unroll 1
            for (int st = 0; st < nsteps; ++st) {
                const int kb0 = st * 128, bo = (st & 1) * FX_BUF;
                const int kw0 = kb0 + 32 * kg;
                if (kw0 <= q0 + rg * 32 + 31) {
                    bf16x8 kf[8];
#pragma unroll
                    for (int ks = 0; ks < 8; ++ks) kf[ks] = *(const LAS bf16x8*)(lds + bo + FX_K + (k_off ^ (ks << 5)));
                    f32x16 sc;
#pragma unroll
                    for (int i = 0; i < 4; ++i) { const f32x4 fk = *(const LAS f32x4*)(Fs + kw0 + 8 * i + 4 * hh); sc[4 * i] = fk[0]; sc[4 * i + 1] = fk[1]; sc[4 * i + 2] = fk[2]; sc[4 * i + 3] = fk[3]; }
                    __builtin_amdgcn_sched_barrier(0);
#pragma unroll
                    for (int ks = 0; ks < 8; ++ks) sc = __builtin_amdgcn_mfma_f32_32x32x16_bf16(kf[ks], qf[ks], sc, 0, 0, 0);
                    s16x4 vf[2][2][2], vg[2][2][2];
#pragma unroll
                    for (int db = 0; db < 2; ++db) { const unsigned vp = (unsigned)(size_t)(lds + bo + FX_V) + (unsigned)(v_off ^ (db << 6));
                        vf[db][0][0] = vtr_a<0>(vp); vf[db][0][1] = vtr_a<2048>(vp); vf[db][1][0] = vtr_a<4096>(vp); vf[db][1][1] = vtr_a<6144>(vp); }
                    __builtin_amdgcn_sched_barrier(0);
                    FX_LGKM0(vf);
                    if (kw0 + 31 > q0 + rg * 32) {
#pragma unroll
                        for (int r = 0; r < 16; ++r) if (kw0 + (r & 3) + 8 * (r >> 2) + 4 * hh > qrow) sc[r] = -__builtin_inff(); }
                    float mx = sc[0];
#pragma unroll
                    for (int r = 1; r < 16; ++r) mx = fmaxf(mx, sc[r]);
                    mx = fmaxf(mx, __shfl_xor(mx, 32));
                    const float mn = fmaxf(m, mx), alpha = __builtin_amdgcn_exp2f(m - mn); m = mn;
                    float ps = 0.f;
#pragma unroll
                    for (int r = 0; r < 16; ++r) { sc[r] = __builtin_amdgcn_exp2f(sc[r] - mn); ps += sc[r]; }
                    bf16x8 pf[2];
#pragma unroll
                    for (int s2 = 0; s2 < 2; ++s2) { u32x4 w; w.x = cvt_pk_bf16(sc[8 * s2], sc[8 * s2 + 1]); w.y = cvt_pk_bf16(sc[8 * s2 + 2], sc[8 * s2 + 3]); w.z = cvt_pk_bf16(sc[8 * s2 + 4], sc[8 * s2 + 5]); w.w = cvt_pk_bf16(sc[8 * s2 + 6], sc[8 * s2 + 7]);
                        pf[s2] = __builtin_bit_cast(bf16x8, w); }
                    lsum = lsum * alpha + ps;
                    if (!__all(alpha == 1.f)) {
#pragma unroll
                        for (int db = 0; db < 4; ++db)
#pragma unroll
                            for (int r = 0; r < 16; ++r) O[db][r] *= alpha; }
                    __builtin_amdgcn_sched_barrier(0);
#pragma unroll
                    for (int db = 0; db < 2; ++db) { const unsigned vp = (unsigned)(size_t)(lds + bo + FX_V) + (unsigned)(v_off ^ ((db + 2) << 6));
                        vg[db][0][0] = vtr_a<0>(vp); vg[db][0][1] = vtr_a<2048>(vp); vg[db][1][0] = vtr_a<4096>(vp); vg[db][1][1] = vtr_a<6144>(vp); }
#pragma unroll
                    for (int db = 0; db < 2; ++db)
#pragma unroll
                        for (int s2 = 0; s2 < 2; ++s2) O[db] = __builtin_amdgcn_mfma_f32_32x32x16_bf16(cat8(vf[db][s2][0], vf[db][s2][1]), pf[s2], O[db], 0, 0, 0);
                    __builtin_amdgcn_sched_barrier(0);
                    FX_LGKM0(vg);
#pragma unroll
                    for (int db = 0; db < 2; ++db)
#pragma unroll
                        for (int s2 = 0; s2 < 2; ++s2) O[db + 2] = __builtin_amdgcn_mfma_f32_32x32x16_bf16(cat8(vg[db][s2][0], vg[db][s2][1]), pf[s2], O[db + 2], 0, 0, 0);
                }
                asm volatile("s_waitcnt vmcnt(0)" ::: "memory");
                __builtin_amdgcn_s_barrier();
                if (st + 2 < nsteps) FX_DMA(bo, kb0 + 256);
            }
            lsum += __shfl_xor(lsum, 32);
            LAS float* mg = (LAS float*)(lds + FX_MG);
            if (kg > 0) { LAS float* q = mg + (((kg - 1) * 2 + rg) * 64 + lane) * 66; q[0] = m; q[1] = lsum;
#pragma unroll
                for (int db = 0; db < 4; ++db)
#pragma unroll
                    for (int r = 0; r < 16; ++r) q[2 + db * 16 + r] = O[db][r]; }
            __syncthreads();
            if (kg == 0) { float mn = m;
#pragma unroll
                for (int j = 0; j < 3; ++j) mn = fmaxf(mn, mg[((j * 2 + rg) * 64 + lane) * 66]);
                float a0 = __builtin_amdgcn_exp2f(m - mn), lt = lsum * a0;
#pragma unroll
                for (int db = 0; db < 4; ++db)
#pragma unroll
                    for (int r = 0; r < 16; ++r) O[db][r] *= a0;
#pragma unroll
                for (int j = 0; j < 3; ++j) { const LAS float* q = mg + ((j * 2 + rg) * 64 + lane) * 66; const float aj = __builtin_amdgcn_exp2f(q[0] - mn); lt += q[1] * aj;
#pragma unroll
                    for (int db = 0; db < 4; ++db)
#pragma unroll
                        for (int r = 0; r < 16; ++r) O[db][r] += q[2 + db * 16 + r] * aj; }
                const float inv = 1.f / lt;
                LAS unsigned char* orow = lds + FX_OST + (rg * 32 + r32) * 272 + 8 * hh;
#pragma unroll
                for (int db = 0; db < 4; ++db)
#pragma unroll
                    for (int i = 0; i < 4; ++i) { u32x2 w; w.x = cvt_pk_bf16(O[db][4 * i] * inv, O[db][4 * i + 1] * inv); w.y = cvt_pk_bf16(O[db][4 * i + 2] * inv, O[db][4 * i + 3] * inv);
                        *(LAS u32x2*)(orow + db * 64 + 16 * i) = w; } }
            __syncthreads();
            { const int t3 = opaque_tid(), row = t3 >> 3, ch = t3 & 7;
#pragma unroll
              for (int i = 0; i < 2; ++i) *(u32x4*)(mix + (size_t)(b * SEQ + q0 + row) * DM + M_FOX + h * 128 + (ch + 8 * i) * 8) = *(const LAS u32x4*)(lds + FX_OST + row * 272 + (ch + 8 * i) * 16); }
        }
    }
#undef FX_DMA
    __syncthreads();
}

constexpr int RT_SS = 0, RT_LG = 1024, RT_PART = RT_LG + 32 * 49 * 4, RT_END = RT_PART + 8 * 32 * 49 * 4, RT_BIAS = RT_END;
__device__ __forceinline__ float sumsq8(bf16x8 v) { const u32x4 w = __builtin_bit_cast(u32x4, v);
    return ((bflo(w.x) * bflo(w.x) + bfhi(w.x) * bfhi(w.x)) + (bflo(w.y) * bflo(w.y) + bfhi(w.y) * bfhi(w.y))) + ((bflo(w.z) * bflo(w.z) + bfhi(w.z) * bfhi(w.z)) + (bflo(w.w) * bflo(w.w) + bfhi(w.w) * bfhi(w.w))); }
__device__ __forceinline__ void router_phase(ArgP a, LAS unsigned char* lds, int l, const bf16_t* x1, int vid) {
    const int tid = opaque_tid(), lane = tid & 63, wave = tid >> 6, g = lane >> 4, li = lane & 15;
    LAS float* pss = (LAS float*)(lds + RT_SS); LAS float* lgs = (LAS float*)(lds + RT_LG); LAS float* part = (LAS float*)(lds + RT_PART);
    float* rsb = (float*)(a->ws + WS_RSB);
    const bf16_t* wr = (const bf16_t*)(a->ws + WS_WR) + (size_t)l * 2 * 48 * DM;
    unsigned* cnt = (unsigned*)(a->ws + WS_CTL) + CW_CNT + l * 32 * 64; int* list = (int*)(a->ws + WS_LIST); float* gwb = (float*)(a->ws + WS_GW);
    LAS float* bias = (LAS float*)(lds + RT_BIAS);
    if (tid < 36) bias[tid] = tid < 4 ? a->in[I_RGB][l * 4 + tid] : a->in[I_REB][l * 32 + tid - 4];
    for (int item = vid; item < T / 32; item += gridDim.x) {
        const int tk0 = item * 32;
        __syncthreads();
        { const int kq = __builtin_amdgcn_readfirstlane(tid >> 6);
          f32x4 acc[2][3];
#pragma unroll
          for (int mb = 0; mb < 2; ++mb)
#pragma unroll
              for (int cb = 0; cb < 3; ++cb) acc[mb][cb] = (f32x4){0.f, 0.f, 0.f, 0.f};
          float ss0 = 0.f, ss1 = 0.f;
          const char* xb_ = (const char*)(x1 + (size_t)tk0 * DM + kq * 256); const char* wb_ = (const char*)(wr + kq * 256); const unsigned vo = (unsigned)((li * DM + 8 * g) * 2);
          bf16x8 xa[2][2], wa[2][6], xb[2][2], wb[2][6];
#define RT_LOAD(X, W, k0) do { _Pragma("unroll") for (int _k = 0; _k < 2; ++_k) { X[_k][0] = *(const bf16x8*)(xb_ + ((k0) + _k) * 64 + vo); X[_k][1] = *(const bf16x8*)(xb_ + 16 * DM * 2 + ((k0) + _k) * 64 + vo); \
              _Pragma("unroll") for (int _c = 0; _c < 3; ++_c) { W[_k][2 * _c] = *(const bf16x8*)(wb_ + (_c * 16) * DM * 2 + ((k0) + _k) * 64 + vo); } } } while (0)
#define RT_MMA(X, W) do { _Pragma("unroll") for (int _k = 0; _k < 2; ++_k) { ss0 += sumsq8(X[_k][0]); ss1 += sumsq8(X[_k][1]); \
              _Pragma("unroll") for (int _c = 0; _c < 3; ++_c) { acc[0][_c] = mfma16(X[_k][0], W[_k][2 * _c], acc[0][_c]); \
                  acc[1][_c] = mfma16(X[_k][1], W[_k][2 * _c], acc[1][_c]); } } } while (0)
          RT_LOAD(xa, wa, 0); RT_LOAD(xb, wb, 2); __builtin_amdgcn_sched_barrier(0);
          RT_MMA(xa, wa); __builtin_amdgcn_sched_barrier(0); RT_LOAD(xa, wa, 4); __builtin_amdgcn_sched_barrier(0);
          RT_MMA(xb, wb); __builtin_amdgcn_sched_barrier(0); RT_LOAD(xb, wb, 6); __builtin_amdgcn_sched_barrier(0);
          RT_MMA(xa, wa); __builtin_amdgcn_sched_barrier(0);
          RT_MMA(xb, wb);
#undef RT_LOAD
#undef RT_MMA
          ss0 += __shfl_xor(ss0, 16); ss0 += __shfl_xor(ss0, 32); ss1 += __shfl_xor(ss1, 16); ss1 += __shfl_xor(ss1, 32);
          if (g == 0) { pss[kq * 32 + li] = ss0; pss[kq * 32 + 16 + li] = ss1; }
#pragma unroll
          for (int mb = 0; mb < 2; ++mb)
#pragma unroll
              for (int cb = 0; cb < 3; ++cb)
#pragma unroll
                  for (int r = 0; r < 4; ++r) part[(kq * 32 + mb * 16 + 4 * g + r) * 49 + cb * 16 + li] = acc[mb][cb][r]; }
        __syncthreads();
        { const int tk = tid & 31, cg = tid >> 5;
          float s3[3] = {0.f, 0.f, 0.f};
#pragma unroll
          for (int q = 0; q < 8; ++q)
#pragma unroll
              for (int j = 0; j < 3; ++j) s3[j] += part[(q * 32 + tk) * 49 + cg * 3 + j];
#pragma unroll
          for (int j = 0; j < 3; ++j) lgs[tk * 49 + cg * 3 + j] = s3[j]; }
        __syncthreads();
        if (tid < 32) {
            const int tok = tk0 + tid; float lg[36];
            float ssq = 0.f;
#pragma unroll
            for (int q = 0; q < 8; ++q) ssq += pss[q * 32 + tid];
            const float rstd = rsqrtf(ssq * (1.f / DM) + EPS);
#pragma unroll
            for (int c = 0; c < 36; ++c) lg[c] = lgs[tid * 49 + c] * rstd;
            float gl[4]; int grp = 0; float gmx;
#pragma unroll
            for (int c = 0; c < 4; ++c) gl[c] = lg[c] + bias[c];
            gmx = gl[0];
#pragma unroll
            for (int c = 1; c < 4; ++c) if (gl[c] > gmx) { gmx = gl[c]; grp = c; }
            float den = 0.f;
#pragma unroll
            for (int c = 0; c < 4; ++c) den += __expf(gl[c] - gmx);
            const float ptop = 1.f / den;
            float v1 = -__builtin_inff(), v2 = -__builtin_inff(); int i1 = 0, i2 = 0;
#pragma unroll
            for (int e = 0; e < 8; ++e) { float ev = 0.f;
#pragma unroll
                for (int q = 0; q < 4; ++q) ev = (grp == q) ? lg[4 + q * 8 + e] : ev;
                const float v = ev + bias[4 + grp * 8 + e];
                if (v > v1) { v2 = v1; i2 = i1; v1 = v; i1 = e; } else if (v > v2) { v2 = v; i2 = e; } }
            const float w1 = ptop / (1.f + __expf(v2 - v1)), w2 = ptop - w1;
            const int E1 = grp * 8 + i1, E2 = grp * 8 + i2;
            const unsigned s1 = atomicAdd(cnt + E1 * 64, 1u), s2 = atomicAdd(cnt + E2 * 64, 1u);
            list[E1 * CAPE + s1] = tok * 2; gwb[E1 * CAPE + s1] = w1; rsb[E1 * CAPE + s1] = rstd;
            list[E2 * CAPE + s2] = tok * 2 + 1; gwb[E2 * CAPE + s2] = w2; rsb[E2 * CAPE + s2] = rstd;
        }
    }
    __syncthreads();
}
__device__ __forceinline__ void moe_setup(ArgP a, LAS int* tab, int l) {
    __syncthreads();
    if (threadIdx.x < 32) { unsigned* cnt = (unsigned*)(a->ws + WS_CTL) + CW_CNT + l * 32 * 64; tab[33 + threadIdx.x] = (int)__hip_atomic_load(cnt + threadIdx.x * 64, __ATOMIC_RELAXED, __HIP_MEMORY_SCOPE_AGENT); }
    __syncthreads();
    if (threadIdx.x == 0) { int ts = 0; for (int e = 0; e < 32; ++e) { tab[e] = ts; tab[65 + e] = ts * 256; ts += (tab[33 + e] + 255) >> 8; } tab[32] = ts; }
    __syncthreads();
    if (threadIdx.x < 32) { const int e = threadIdx.x, nt_ = tab[e + 1] - tab[e]; int rk = 0;
#pragma unroll 1
        for (int o = 0; o < 32; ++o) { const int no = tab[o + 1] - tab[o]; rk += (no > nt_ || (no == nt_ && o < e)) ? 1 : 0; }
        const int rnd = rk >> 3, x = (rnd & 1) ? 7 - (rk & 7) : (rk & 7); tab[164 + 4 * x + rnd] = e; }
    __syncthreads();
    if (threadIdx.x < 8) { const int x = threadIdx.x; int ts = 0;
#pragma unroll 1
        for (int k = 0; k < 4; ++k) { tab[196 + 5 * x + k] = ts; const int e = tab[164 + 4 * x + k]; ts += tab[e + 1] - tab[e]; } tab[196 + 5 * x + 4] = ts; }
    __syncthreads();
}
__device__ __forceinline__ void combine_phase(ArgP a, int l, const bf16_t* x1, bf16_t* x2, int vid, int uni) {
    const int tid = opaque_tid(), lane = tid & 63, wave = tid >> 6;
    const int gw = blockIdx.x * NWAVES + wave, NGW = gridDim.x * NWAVES;
    const bf16_t* Y = (const bf16_t*)(a->ws + WS_Y);
    const float* g = (l + 1 < DEPTH) ? a->in[I_N1G] + (l + 1) * DM : a->in[I_FNG];
    u32x2 rx[8], ry0[8], ry1[8];
#define CB_LOAD(m_) do { const u32x2* xr = (const u32x2*)(x1 + (size_t)(m_) * DM) + lane; const u32x2* y0 = (const u32x2*)(Y + (size_t)(2 * (m_)) * DM) + lane; const u32x2* y1 = (const u32x2*)(Y + (size_t)(2 * (m_) + 1) * DM) + lane; \
        _Pragma("unroll") for (int j = 0; j < 8; ++j) { rx[j] = xr[64 * j]; ry0[j] = y0[64 * j]; ry1[j] = y1[64 * j]; } } while (0)
    f32x4 gg[8];
#pragma unroll
    for (int j = 0; j < 8; ++j) gg[j] = ((const f32x4*)g)[lane + 64 * j];
#define CB_ROW(m_) (uni ? vid * 32 + wave + 8 * ((m_) / NGW) : (m_))
    if (gw < T) CB_LOAD(CB_ROW(gw));
    for (int m_ = gw; m_ < T; m_ += NGW) { const int m = CB_ROW(m_);
        f32x4 v[8]; float s = 0.f;
#pragma unroll
        for (int j = 0; j < 8; ++j) { const u32x2 xx = rx[j], a0 = ry0[j], a1 = ry1[j];
            v[j] = (f32x4){bflo(xx.x) + (bflo(a0.x) + bflo(a1.x)), bfhi(xx.x) + (bfhi(a0.x) + bfhi(a1.x)), bflo(xx.y) + (bflo(a0.y) + bflo(a1.y)), bfhi(xx.y) + (bfhi(a0.y) + bfhi(a1.y))};
            s += (v[j].x * v[j].x + v[j].y * v[j].y) + (v[j].z * v[j].z + v[j].w * v[j].w); }
        if (m_ + NGW < T) CB_LOAD(CB_ROW(m_ + NGW));
        const float rstd = rsqrtf(wave_sum(s) * (1.f / DM) + EPS);
        if (l + 1 < DEPTH) {
            u32x2* xo = (u32x2*)(x2 + (size_t)m * DM) + lane;
            if (lane == 0) ((float*)(a->ws + WS_RS))[m] = rstd;
#pragma unroll
            for (int j = 0; j < 8; ++j) { u32x2 xw; xw.x = cvt_pk_bf16(v[j].x, v[j].y); xw.y = cvt_pk_bf16(v[j].z, v[j].w); xo[64 * j] = xw; }
        } else {
            f32x4* oo = (f32x4*)(a->out + (size_t)m * DM) + lane;
#pragma unroll
            for (int j = 0; j < 8; ++j) oo[64 * j] = (f32x4){v[j].x * rstd * gg[j].x, v[j].y * rstd * gg[j].y, v[j].z * rstd * gg[j].z, v[j].w * rstd * gg[j].w};
        }
    }
}

constexpr int PH_PER_LAYER = 9, N_PHASES = 1 + DEPTH * PH_PER_LAYER;
#ifndef PH_MASK
#define PH_MASK 0x3ff
#endif
__global__ void __launch_bounds__(NTHR, 2) fwd(Args) {
    extern __shared__ __attribute__((aligned(16))) unsigned char lds_raw[];
    LAS unsigned char* lds = (LAS unsigned char*)lds_raw;
    volatile LAS unsigned* MISC = (volatile LAS unsigned*)(lds + MISC_OFF);
    LAS int* tab = (LAS int*)(lds + MISC_OFF + 64);
    if (threadIdx.x < 256) MISC[threadIdx.x] = 0u;
    __syncthreads();
    int lo, hi; XcdBarrier bar;
    { ArgP a = kargs(); lo = a->ph_lo; hi = a->ph_hi; bar.bar = (unsigned*)(a->ws + WS_CTL) + CW_BAR; bar.x = 0; bar.st = nullptr;
      if (!MK_PER_PHASE) bar = xcd_barrier_post((unsigned*)(a->ws + WS_CTL) + CW_BAR, MISC); }
#define IN(k) (lo <= (k) && (k) < hi)
#define EN(j) ((PH_MASK >> (j)) & 1)
#ifndef REP_MASK
#define REP_MASK 0
#endif
#define REP(j) for (int _rep = 0; _rep < 1 + ((REP_MASK >> (j)) & 1); ++_rep)
#define SEAM(k) do { if (!MK_PER_PHASE && IN(k) && IN((k) + 1)) xcd_barrier(bar); } while (0)
    if (EN(0) && IN(0)) REP(0) { p0_prologue(kargs(), lds); __syncthreads(); }
    SEAM(0);
    int uni = 0, vid = blockIdx.x;
    if (!MK_PER_PHASE && IN(0) && IN(1)) { uni = __builtin_amdgcn_readfirstlane((int)MISC[2]); if (uni) vid = __builtin_amdgcn_readfirstlane((int)(bar.x * 32u + MISC[3])); }
#define SEAM_X(k) do { if (!MK_PER_PHASE && IN(k) && IN((k) + 1)) { if (uni) xcd_local_barrier(bar); else xcd_barrier(bar); } } while (0)
#pragma unroll 1
    for (int l = 0; l < DEPTH; ++l) {
        const int p0 = 1 + l * PH_PER_LAYER;
        if (EN(1) && IN(p0 + 0)) REP(1) { ArgP a = kargs();
            const int cden = uni ? (vid & 31) * 8 + (vid >> 5) : (int)blockIdx.x;
            pg::DenseSched<DM> S; S.init((const bf16_t*)(a->ws + WS_WIN) + (size_t)l * DINP * DM, T, DINP, gridDim.x, cden);
            pg::EpiBf16 E{(bf16_t*)(a->ws + WS_P), DINP, (const float*)(a->ws + WS_RS)};
            pg::gemm_phase<DM, pg::EpiBf16, pg::DenseSched<DM>>(lds, (const char*)(a->ws + WS_XB), S, E);
            if (l == 0) { int rk, nr; idle_rank((T / 256) * (DINP / 256), gridDim.x, cden, rk, nr); if (rk >= 0) cvt_range(kargs(), lds, CV_N_IN, CV_I_OUT, rk, nr); __syncthreads(); }
        }
        SEAM(p0 + 0);
        if (EN(2) && IN(p0 + 1)) { REP(2) conv_phase(kargs(), lds, l); REP(10) gla_a_phase(kargs(), lds, l, vid, uni); }
        SEAM_X(p0 + 1);
        if (EN(3) && IN(p0 + 2)) { gla_b_phase(kargs(), lds, vid, uni); REP(3) fox_phase(kargs(), lds, l, vid, uni); }
        SEAM_X(p0 + 2);
        if (EN(4) && IN(p0 + 3)) REP(4) { gla_c_phase(kargs(), lds, l, vid, uni); }
        SEAM(p0 + 3);
        if (EN(5) && IN(p0 + 4)) REP(5) { ArgP a = kargs();
            pg::DenseSched<DM> S; S.init((const bf16_t*)(a->ws + WS_WOUT) + (size_t)l * DM * DM, T, DM, gridDim.x, uni ? (vid & 31) * 8 + (vid >> 5) : (int)blockIdx.x);
            pg::EpiRes E{(const bf16_t*)(a->ws + WS_XB), (bf16_t*)(a->ws + WS_XA), DM};
            pg::gemm_phase<DM, pg::EpiRes, pg::DenseSched<DM>>(lds, (const char*)(a->ws + WS_MIX), S, E);
        }
        SEAM_X(p0 + 4);
        if (EN(6) && IN(p0 + 5)) { ArgP a = kargs(); router_phase(a, lds, l, (const bf16_t*)(a->ws + WS_XA), vid); }
        SEAM(p0 + 5);
        if (EN(7) && IN(p0 + 6)) REP(7) { ArgP a = kargs();
            moe_setup(a, tab, l);
            const int vcu = (gridDim.x % 8 == 0) ? (int)((blockIdx.x % 8) * (gridDim.x / 8) + blockIdx.x / 8) : (int)blockIdx.x;
            pg::MoeSchedRB<DM, 8, true> S{a->in[I_WG] + (size_t)l * NEX * DM * DE, a->in[I_WU] + (size_t)l * NEX * DM * DE, tab, (const int*)(a->ws + WS_LIST), uni ? 32 : (int)gridDim.x, uni ? (vid & 31) : vcu};
            if (uni) S.xl = vid >> 5;
#ifndef RBP
#define RBP 0
#endif
            pg::EpiGateUpRB E{(bf16_t*)(a->ws + (_rep ? WS_WGU : WS_HB)), (const float*)(a->ws + WS_GW), (const float*)(a->ws + WS_RSB)};
            { const int t4 = opaque_tid(); ((LAS f32x4*)(lds + pg::RB_GK_OFF))[t4] = ((const f32x4*)(a->in[I_N2G] + l * DM))[t4]; __syncthreads(); }
            const int G_ = S.G, nun = (uni ? tab[196 + 5 * (vid >> 5) + 4] : tab[32]) * 8, whole = (nun / G_) * G_, rem = nun - whole;
            if (l == 0 || rem == 0 || 2 * rem > G_) pg::gemm_rb<DM, DE, pg::EpiGateUpRB, pg::MoeSchedRB<DM, 8, true>, true>(lds, (const char*)(a->ws + WS_XA), S, E);
            else {
                S.L1 = whole; pg::gemm_rb<DM, DE, pg::EpiGateUpRB, pg::MoeSchedRB<DM, 8, true>, true>(lds, (const char*)(a->ws + WS_XA), S, E);
                S.L0 = whole; S.L1 = -1; S.halves = true; pg::gemm_rb<DM, DE, pg::EpiGateUpRB, pg::MoeSchedRB<DM, 8, true>, true, 1>(lds, (const char*)(a->ws + WS_XA), S, E); }
            if (l == 0) { int rk, nr; idle_rank(nun, G_, S.c, rk, nr);
                const int xi = uni ? (vid >> 5) : 0, nx_ = uni ? 8 : 1;
                if (rk >= 0) { cvt_range(kargs(), lds, CV_I_IN + xi * (CV_I_IN / nx_), CV_I_IN / nx_, rk, nr); cvt_range(kargs(), lds, CV_N_IN + CV_I_OUT + xi * (CV_I_OUT / nx_), CV_I_OUT / nx_, rk, nr); } __syncthreads(); }
        }
        SEAM_X(p0 + 6);
        if (EN(8) && IN(p0 + 7)) REP(8) { ArgP a = kargs();
            moe_setup(a, tab, l);
            const int vcu = (gridDim.x % 8 == 0) ? (int)((blockIdx.x % 8) * (gridDim.x / 8) + blockIdx.x / 8) : (int)blockIdx.x;
            pg::MoeSchedRB<DE, 16, false> S{a->in[I_WD] + (size_t)l * NEX * DE * DM, nullptr, tab, (const int*)(a->ws + WS_LIST), uni ? 32 : (int)gridDim.x, uni ? (vid & 31) : vcu};
            if (uni) S.xl = vid >> 5;
            pg::EpiDownRB E{(bf16_t*)(a->ws + WS_Y), (const int*)(a->ws + WS_LIST)};
            pg::gemm_rb<DE, DM, pg::EpiDownRB, pg::MoeSchedRB<DE, 16, false>>(lds, (const char*)(a->ws + WS_HB), S, E);
        }
        SEAM(p0 + 7);
        if (EN(9) && IN(p0 + 8)) REP(9) { ArgP a = kargs(); combine_phase(a, l, (const bf16_t*)(a->ws + WS_XA), (bf16_t*)(a->ws + WS_XB), vid, uni); }
        SEAM_X(p0 + 8);
    }
#undef IN
#undef EN
#undef SEAM
}

#ifdef DBG_STAGE
__global__ void dbg_dump(const unsigned char* ws, float* out, int kind) {
    for (size_t i = (size_t)blockIdx.x * blockDim.x + threadIdx.x; i < (size_t)T * DM; i += (size_t)gridDim.x * blockDim.x) {
        const size_t r = i / DM, c = i % DM; float v = 0.f;
        if (kind == 1) v = bf2f(((const bf16_t*)(ws + WS_P))[r * DINP + 2048 + c]);
        else if (kind == 2) v = bf2f(((const bf16_t*)(ws + WS_MIX))[i]);
        else if (kind == 7) v = c < 512 ? bf2f(((const bf16_t*)(ws + WS_MIX))[i]) : 0.f;
        else if (kind == 8) v = (c >= 512 && c < 1536) ? bf2f(((const bf16_t*)(ws + WS_MIX))[i]) : 0.f;
        else if (kind == 9) v = c >= 1536 ? bf2f(((const bf16_t*)(ws + WS_MIX))[i]) : 0.f;
        else if (kind == 10 || kind == 11) v = bf2f(((const bf16_t*)(ws + WS_KV))[i]);
        else if (kind == 12) v = ((const float*)(ws + WS_DEC))[i & 65535];
        else if (kind == 13) v = bf2f(((const bf16_t*)(ws + WS_P))[r * DINP + c]);
        else if (kind == 14) v = bf2f(((const bf16_t*)(ws + WS_P))[r * DINP + 3840 + c]);
        else if (kind == 3) v = bf2f(((const bf16_t*)(ws + WS_XA))[i]);
        else if (kind == 4) v = bf2f(((const bf16_t*)(ws + WS_XB))[i]);
        else if (kind == 5) v = bf2f(((const bf16_t*)(ws + WS_H))[i]);
        else if (kind == 6) v = ((const float*)(ws + WS_Y))[i] + ((const float*)(ws + WS_Y))[i + (size_t)T * DM];
        out[i] = v; }
}
#endif
extern "C" void kernel_launch(void* const* d_in, const int* in_sizes, int n_in, void* d_out, int out_size, void* d_ws, size_t ws_size, hipStream_t stream) {
    static int grid = 0;
    if (grid == 0) {
        if (n_in != 21 || ws_size < WS_END) { fprintf(stderr, "kernel_launch: need 21 inputs and %zu bytes of workspace (got %d, %zu)\n", (size_t)WS_END, n_in, ws_size); grid = -1; return; }
        int dev = 0, cus = 0, per_cu = 0;
        if (hipGetDevice(&dev) != hipSuccess || hipDeviceGetAttribute(&cus, hipDeviceAttributeMultiprocessorCount, dev) != hipSuccess) { grid = -1; return; }
        if (hipFuncSetAttribute((const void*)fwd, hipFuncAttributeMaxDynamicSharedMemorySize, LDS_BYTES) != hipSuccess) { fprintf(stderr, "kernel_launch: hipFuncSetAttribute failed\n"); grid = -1; return; }
        if (hipOccupancyMaxActiveBlocksPerMultiprocessor(&per_cu, (const void*)fwd, NTHR, LDS_BYTES) != hipSuccess || per_cu < 1) { fprintf(stderr, "kernel_launch: occupancy query says %d\n", per_cu); per_cu = 1; }
        (void)hipGetLastError();
        grid = cus;
    }
    if (grid < 0) return;
    (void)hipMemsetAsync((char*)d_ws + WS_CTL, 0, CTL_ZERO_BYTES, stream);
    Args a{};
    for (int i = 0; i < 21; ++i) a.in[i] = (const float*)d_in[i];
    a.out = (float*)d_out; a.ws = (unsigned char*)d_ws;
#ifdef DBG_STAGE
    { const int last[15] = {0, 1, 4, 5, 9, 6, 8, 4, 4, 4, 2, 3, 2, 1, 1}; for (int p = 0; p <= last[DBG_STAGE]; ++p) { a.ph_lo = p; a.ph_hi = p + 1; hipLaunchKernelGGL(fwd, dim3(grid), dim3(NTHR), LDS_BYTES, stream, a); }
      hipLaunchKernelGGL(dbg_dump, dim3(2048), dim3(256), 0, stream, (const unsigned char*)d_ws, (float*)d_out, DBG_STAGE); }
#elif MK_PER_PHASE
    for (int p = 0; p < N_PHASES; ++p) { a.ph_lo = p; a.ph_hi = p + 1; hipLaunchKernelGGL(fwd, dim3(grid), dim3(NTHR), LDS_BYTES, stream, a); }
#else
    a.ph_lo = 0; a.ph_hi = N_PHASES; hipLaunchKernelGGL(fwd, dim3(grid), dim3(NTHR), LDS_BYTES, stream, a);
#endif
}
```
